# Optimizing an MI355X kernel written in HIP

```python
import math
import jax, jax.numpy as jnp
from jax import lax
import numpy as np

D_MODEL = 1024
BATCH = 16
SEQ = 4096
DEPTH = 4

N_MIXERS = 3
GRID_W = 64
DEEPNORM_ALPHA = (2 * DEPTH) ** 0.25
DEEPNORM_BETA = (8 * DEPTH) ** -0.25
LN_EPS = 1e-5

GLA_HEADS = 4
GLA_KEY_DIM = D_MODEL // 2
GLA_VAL_DIM = D_MODEL
GLA_HEAD_K = GLA_KEY_DIM // GLA_HEADS
GLA_HEAD_V = GLA_VAL_DIM // GLA_HEADS
GLA_GATE_RANK = 16
GLA_TAU = 16.0
GLA_CHUNK = 64
GLA_NORM_EPS = 1e-6
GLA_IN_WIDTH = 2 * GLA_KEY_DIM + 2 * GLA_VAL_DIM + 2 * GLA_GATE_RANK

HYENA_ORDER = 2
HYENA_POS_EMB = 33
HYENA_FILTER_HIDDEN = 64
HYENA_DECAY_TARGET = 1e-2
HYENA_FAST_DECAY = 0.3
HYENA_SLOW_DECAY = 1.5
HYENA_WINDOW_SHIFT = 0.05
HYENA_FILTER_INIT = 0.05

NA_HEAD_DIM = 32
NA_HEADS = D_MODEL // NA_HEAD_DIM
NA_WIN_ROWS = 8
NA_WIN_COLS = 16
NA_QUERY_COLS = 16
NA_BAND_COLS = NA_WIN_COLS + NA_QUERY_COLS

N_EXPERTS = 32
TOP_K = 4
MOE_D_FF = D_MODEL
SWIGLU_ALPHA = 1.702
SWIGLU_LIMIT = 7.0

N_GLA_LAYERS = len(range(0, DEPTH, N_MIXERS))
N_HYENA_LAYERS = len(range(1, DEPTH, N_MIXERS))
N_NA_LAYERS = len(range(2, DEPTH, N_MIXERS))

kernel_name = "hybrid_gla_hyena_natten_moe_encoder"


def _layer_norm(x, g, b):
    xf = x.astype(jnp.float32)
    mu = jnp.mean(xf, axis=-1, keepdims=True)
    var = jnp.mean(jnp.square(xf - mu), axis=-1, keepdims=True)
    return ((xf - mu) * lax.rsqrt(var + LN_EPS)).astype(x.dtype) * g + b


def _gla_scan(q, k, v, log_a, strict):
    B, L, H, dk = q.shape
    dv = v.shape[-1]
    C = GLA_CHUNK
    N = L // C

    def chunks(t):
        return t.astype(jnp.float32).reshape(B, N, C, H, t.shape[-1]).transpose(1, 0, 3, 2, 4)

    qc, kc, vc = chunks(q), chunks(k), chunks(v)
    bc = jnp.cumsum(chunks(log_a), axis=3)
    mask = jnp.tril(jnp.ones((C, C), dtype=bool), k=-1 if strict else 0)

    def step(state, inp):
        q_, k_, v_, b_ = inp
        diff = b_[:, :, :, None, :] - b_[:, :, None, :, :]
        decay = jnp.exp(jnp.where(mask[:, :, None], diff, -jnp.inf))
        scores = jnp.einsum('bhijd,bhjd->bhij', q_[:, :, :, None, :] * decay, k_)
        b_last = b_[:, :, -1:, :]
        out = (jnp.einsum('bhij,bhje->bhie', scores, v_)
               + jnp.einsum('bhid,bhde->bhie', q_ * jnp.exp(b_), state))
        state = (jnp.exp(b_last[:, :, 0, :])[..., None] * state
                 + jnp.einsum('bhjd,bhje->bhde', k_ * jnp.exp(b_last - b_), v_))
        return state, out

    s0 = jnp.zeros((B, H, dk, dv), jnp.float32)
    _, o = lax.scan(step, s0, (qc, kc, vc, bc))
    return o.transpose(1, 0, 3, 2, 4).reshape(B, L, H, dv)


def _gla_mixer(x, w_in, gate_w2, gate_b, norm_g, w_out):
    B, L, _ = x.shape
    H, dk, dv, r = GLA_HEADS, GLA_HEAD_K, GLA_HEAD_V, GLA_GATE_RANK
    proj = x @ w_in
    q, k, v, og, glow = jnp.split(
        proj, [GLA_KEY_DIM, 2 * GLA_KEY_DIM, 2 * GLA_KEY_DIM + GLA_VAL_DIM,
               2 * GLA_KEY_DIM + 2 * GLA_VAL_DIM], axis=-1)
    glow = glow.reshape(B, L, 2, r)
    logits = jnp.einsum('blnr,nrk->blnk', glow, gate_w2) + gate_b
    log_a = jax.nn.log_sigmoid(logits.astype(jnp.float32)) / GLA_TAU
    q = q.reshape(B, L, H, dk) * dk ** -0.5
    k = k.reshape(B, L, H, dk)
    v = v.reshape(B, L, H, dv)
    la_f = log_a[:, :, 0].reshape(B, L, H, dk)
    la_b = log_a[:, :, 1].reshape(B, L, H, dk)
    o_f = _gla_scan(q, k, v, la_f, strict=False)
    flip = lambda t: jnp.flip(t, axis=1)
    o_b = flip(_gla_scan(flip(q), flip(k), flip(v), flip(la_b), strict=True))
    o = o_f + o_b
    o = o * lax.rsqrt(jnp.mean(jnp.square(o), axis=-1, keepdims=True) + GLA_NORM_EPS)
    o = (o * norm_g.astype(jnp.float32)).astype(x.dtype).reshape(B, L, GLA_VAL_DIM)
    return (o * jax.nn.silu(og)) @ w_out


def _short_conv3(u, w, b):
    up = jnp.pad(u, ((0, 0), (1, 1), (0, 0)))
    return up[:, :-2] * w[0] + up[:, 1:-1] * w[1] + up[:, 2:] * w[2] + b


def _hyena_filters(L, w1, b1, sin_freq, w2, b2, w3):
    f32 = jnp.float32
    w1, b1, sin_freq, w2, b2, w3 = (a.astype(f32) for a in (w1, b1, sin_freq, w2, b2, w3))
    d = w3.shape[-1] // (2 * HYENA_ORDER)
    t = jnp.arange(L, dtype=f32)
    t_norm = t / max(L - 1, 1)
    bands = (HYENA_POS_EMB - 1) // 2
    freqs = jnp.linspace(1e-4, bands - 1, bands, dtype=f32)
    ang = (2.0 * math.pi / L) * t[:, None] * freqs[None, :]
    pe = jnp.concatenate([t_norm[:, None], jnp.cos(ang), -jnp.sin(ang)], axis=-1)
    h = jnp.sin(sin_freq[0] * (pe @ w1 + b1))
    h = jnp.sin(sin_freq[1] * (h @ w2 + b2))
    h = (h @ w3).reshape(L, HYENA_ORDER, 2, d)
    min_decay = math.log(HYENA_DECAY_TARGET) / HYENA_SLOW_DECAY
    max_decay = math.log(HYENA_DECAY_TARGET) / HYENA_FAST_DECAY
    deltas = jnp.abs(jnp.linspace(min_decay, max_decay, d, dtype=f32))
    window = jnp.exp(-t_norm[:, None] * deltas[None, :]) + HYENA_WINDOW_SHIFT
    h = h * window[:, None, None, :]
    h_fwd, h_bwd = h[:, :, 0], h[:, :, 1]
    two_sided = jnp.concatenate([h_fwd, jnp.zeros_like(h_fwd[:1]), h_bwd[:0:-1]], axis=0)
    return jnp.fft.rfft(two_sided, axis=0)


def _fft_long_conv(z, filt_f, bias):
    L = z.shape[1]
    Z = jnp.fft.rfft(z, n=2 * L, axis=1)
    y = jnp.fft.irfft(Z * filt_f[None], n=2 * L, axis=1)[:, :L]
    return y + z * bias.astype(jnp.float32)


def _hyena_mixer(x, w_in, b_in, conv_w, conv_b, ffn_w1, ffn_b1, sin_freq, ffn_w2, ffn_b2,
                 ffn_w3, filt_bias, w_out, b_out):
    L = x.shape[1]
    u = _short_conv3(x @ w_in + b_in, conv_w, conv_b)
    v, x1, x2 = jnp.split(u.astype(jnp.float32), 3, axis=-1)
    filt = _hyena_filters(L, ffn_w1, ffn_b1, sin_freq, ffn_w2, ffn_b2, ffn_w3)
    z = x1 * _fft_long_conv(v, filt[:, 0], filt_bias[0])
    z = x2 * _fft_long_conv(z, filt[:, 1], filt_bias[1])
    return z.astype(x.dtype) @ w_out + b_out


def _na_mixer(x, w_in, b_in, rpb, w_out, b_out):
    B, L, D = x.shape
    H, dh = NA_HEADS, D // NA_HEADS
    R = L // GRID_W
    KH = min(NA_WIN_ROWS, R)
    KW, QW, BW = NA_WIN_COLS, NA_QUERY_COLS, NA_BAND_COLS
    NCB = GRID_W // QW
    q, k, v = jnp.split(x @ w_in + b_in, 3, axis=-1)
    q = (q * dh ** -0.5).reshape(B, R, GRID_W, H, dh)
    k = k.reshape(B, R, GRID_W, H, dh)
    v = v.reshape(B, R, GRID_W, H, dh)
    rows = jnp.arange(R)
    row_start = jnp.clip(rows - KH // 2, 0, R - KH)
    key_rows = row_start[:, None] + jnp.arange(KH)[None, :]
    dr_idx = key_rows - rows[:, None] + (NA_WIN_ROWS - 1)
    q_cols = jnp.arange(NCB)[:, None] * QW + jnp.arange(QW)[None, :]
    col_start = jnp.clip(q_cols - KW // 2, 0, GRID_W - KW)
    band_start = jnp.clip(jnp.arange(NCB) * QW - KW // 2, 0, GRID_W - BW)
    band_cols = band_start[:, None] + jnp.arange(BW)[None, :]
    in_win = ((band_cols[:, None, :] >= col_start[..., None])
              & (band_cols[:, None, :] < col_start[..., None] + KW))
    dc_idx = jnp.clip(band_cols[:, None, :] - q_cols[..., None] + (KW - 1), 0, 2 * KW - 2)
    rpb32 = rpb.astype(jnp.float32)

    def row_block(inp):
        q_r, rows_r, dr_r = inp
        q_r = q_r.reshape(B, NCB, QW, H, dh)
        k_r = jnp.take(jnp.take(k, rows_r, axis=1), band_cols, axis=2)
        v_r = jnp.take(jnp.take(v, rows_r, axis=1), band_cols, axis=2)
        s = jnp.einsum('bcqhd,bacjhd->bhcqaj', q_r, k_r).astype(jnp.float32)
        bias = rpb32[:, dr_r][:, :, dc_idx].transpose(0, 2, 3, 1, 4)
        s = jnp.where(in_win[None, None, :, :, None, :], s + bias[None], -jnp.inf)
        p = jax.nn.softmax(s.reshape(B, H, NCB, QW, KH * BW), axis=-1)
        p = p.reshape(s.shape).astype(v.dtype)
        o = jnp.einsum('bhcqaj,bacjhd->bcqhd', p, v_r)
        return o.reshape(B, GRID_W, D)

    o = lax.map(row_block, (q.transpose(1, 0, 2, 3, 4), key_rows, dr_idx))
    o = o.transpose(1, 0, 2, 3).reshape(B, L, D)
    return o @ w_out + b_out


def _clamped_swiglu(h):
    glu, lin = jnp.split(h, 2, axis=-1)
    glu = jnp.minimum(glu, SWIGLU_LIMIT)
    lin = jnp.clip(lin, -SWIGLU_LIMIT, SWIGLU_LIMIT)
    return glu * jax.nn.sigmoid(SWIGLU_ALPHA * glu) * (lin + 1.0)


def _moe(x, router_w, router_b, w_gu, b_gu, w_down, b_down):
    B, L, D = x.shape
    xt = x.reshape(B * L, D)
    logits = (xt @ router_w + router_b).astype(jnp.float32)
    top_v, top_i = lax.top_k(logits, TOP_K)
    gates = jax.nn.softmax(top_v, axis=-1)
    combine = jnp.sum(jax.nn.one_hot(top_i, N_EXPERTS, dtype=jnp.float32) * gates[..., None],
                      axis=1).astype(x.dtype)
    out = jnp.zeros_like(xt)
    for e in range(N_EXPERTS):
        y = _clamped_swiglu(xt @ w_gu[e] + b_gu[e]) @ w_down[e] + b_down[e]
        out = out + combine[:, e:e + 1] * y
    return out.reshape(B, L, D)


def setup_inputs(seed: int = 0) -> dict:
    key = jax.random.key(seed)
    ks = iter(jax.random.split(key, 40))
    D, F = D_MODEL, MOE_D_FF
    nA, nB, nC = N_GLA_LAYERS, N_HYENA_LAYERS, N_NA_LAYERS

    def nrm(shape, scale):
        return scale * jax.random.normal(next(ks), shape, jnp.float32)

    return {
        "x": nrm((BATCH, SEQ, D), 1.0),
        "ln1_g": 1.0 + nrm((DEPTH, D), 0.02),
        "ln1_b": nrm((DEPTH, D), 0.02),
        "ln2_g": 1.0 + nrm((DEPTH, D), 0.02),
        "ln2_b": nrm((DEPTH, D), 0.02),
        "gla_w_in": nrm((nA, D, GLA_IN_WIDTH), D ** -0.5),
        "gla_gate_w2": nrm((nA, 2, GLA_GATE_RANK, GLA_KEY_DIM), GLA_GATE_RANK ** -0.5),
        "gla_gate_b": nrm((nA, 2, GLA_KEY_DIM), 0.1),
        "gla_norm_g": 1.0 + nrm((nA, GLA_HEAD_V), 0.02),
        "gla_w_out": nrm((nA, GLA_VAL_DIM, D), GLA_VAL_DIM ** -0.5 * DEEPNORM_BETA),
        "hy_w_in": nrm((nB, D, 3 * D), D ** -0.5),
        "hy_b_in": nrm((nB, 3 * D), 0.02),
        "hy_conv_w": nrm((nB, 3, 3 * D), 3 ** -0.5),
        "hy_conv_b": nrm((nB, 3 * D), 0.02),
        "hy_ffn_w1": nrm((nB, HYENA_POS_EMB, HYENA_FILTER_HIDDEN), HYENA_POS_EMB ** -0.5),
        "hy_ffn_b1": nrm((nB, HYENA_FILTER_HIDDEN), 0.5),
        "hy_sin_freq": 1.0 + nrm((nB, 2, HYENA_FILTER_HIDDEN), 0.02),
        "hy_ffn_w2": nrm((nB, HYENA_FILTER_HIDDEN, HYENA_FILTER_HIDDEN), HYENA_FILTER_HIDDEN ** -0.5),
        "hy_ffn_b2": nrm((nB, HYENA_FILTER_HIDDEN), 0.5),
        "hy_ffn_w3": nrm((nB, HYENA_FILTER_HIDDEN, 2 * HYENA_ORDER * D),
                          HYENA_FILTER_HIDDEN ** -0.5 * HYENA_FILTER_INIT),
        "hy_filt_bias": nrm((nB, HYENA_ORDER, D), 0.5),
        "hy_w_out": nrm((nB, D, D), D ** -0.5 * DEEPNORM_BETA),
        "hy_b_out": nrm((nB, D), 0.02),
        "na_w_in": nrm((nC, D, 3 * D), D ** -0.5),
        "na_b_in": nrm((nC, 3 * D), 0.02),
        "na_rpb": nrm((nC, NA_HEADS, 2 * NA_WIN_ROWS - 1, 2 * NA_WIN_COLS - 1), 0.02),
        "na_w_out": nrm((nC, D, D), D ** -0.5 * DEEPNORM_BETA),
        "na_b_out": nrm((nC, D), 0.02),
        "moe_router_w": nrm((DEPTH, D, N_EXPERTS), D ** -0.5),
        "moe_router_b": nrm((DEPTH, N_EXPERTS), 0.01),
        "moe_w_gu": nrm((DEPTH, N_EXPERTS, D, 2 * F), D ** -0.5),
        "moe_b_gu": nrm((DEPTH, N_EXPERTS, 2 * F), 0.01),
        "moe_w_down": nrm((DEPTH, N_EXPERTS, F, D), F ** -0.5 * DEEPNORM_BETA),
        "moe_b_down": nrm((DEPTH, N_EXPERTS, D), 0.01),
    }


def reference(x, ln1_g, ln1_b, ln2_g, ln2_b,
              gla_w_in, gla_gate_w2, gla_gate_b, gla_norm_g, gla_w_out,
              hy_w_in, hy_b_in, hy_conv_w, hy_conv_b, hy_ffn_w1, hy_ffn_b1, hy_sin_freq,
              hy_ffn_w2, hy_ffn_b2, hy_ffn_w3, hy_filt_bias, hy_w_out, hy_b_out,
              na_w_in, na_b_in, na_rpb, na_w_out, na_b_out,
              moe_router_w, moe_router_b, moe_w_gu, moe_b_gu, moe_w_down, moe_b_down):
    for i in range(DEPTH):
        m, j = i % N_MIXERS, i // N_MIXERS
        if m == 0:
            h = _gla_mixer(x, gla_w_in[j], gla_gate_w2[j], gla_gate_b[j], gla_norm_g[j], gla_w_out[j])
        elif m == 1:
            h = _hyena_mixer(x, hy_w_in[j], hy_b_in[j], hy_conv_w[j], hy_conv_b[j], hy_ffn_w1[j],
                             hy_ffn_b1[j], hy_sin_freq[j], hy_ffn_w2[j], hy_ffn_b2[j], hy_ffn_w3[j],
                             hy_filt_bias[j], hy_w_out[j], hy_b_out[j])
        else:
            h = _na_mixer(x, na_w_in[j], na_b_in[j], na_rpb[j], na_w_out[j], na_b_out[j])
        x = _layer_norm(DEEPNORM_ALPHA * x + h, ln1_g[i], ln1_b[i])
        f = _moe(x, moe_router_w[i], moe_router_b[i], moe_w_gu[i], moe_b_gu[i],
                 moe_w_down[i], moe_b_down[i])
        x = _layer_norm(DEEPNORM_ALPHA * x + f, ln2_g[i], ln2_b[i])
    return x
```

```cpp
#include <hip/hip_runtime.h>
#include <cstdio>
#include <cstdint>

#ifndef PHASE_MASK
#define PHASE_MASK 0xFFFFFFFFu
#endif
#define PEN(k) ((PHASE_MASK >> (k)) & 1u)
#ifndef REPEAT_MASK
#define REPEAT_MASK 0u
#endif
#define REP(k) for (int rep_ = 0; rep_ < 1 + (int)((REPEAT_MASK >> (k)) & 1u); ++rep_)
#ifndef GLA_NAIVE
#define GLA_NAIVE 0
#endif
#ifndef NA_NAIVE
#define NA_NAIVE 0
#endif
#ifndef FP8_GLA
#define FP8_GLA 0
#endif
#ifndef FP8_NAOUT
#define FP8_NAOUT 1
#endif
#ifndef FP8_HY
#define FP8_HY 0
#endif
#ifndef FP8_NA
#define FP8_NA 1
#endif
#ifndef MK_ONE_LAUNCH
#define MK_ONE_LAUNCH 1
#endif

#define GAS __attribute__((address_space(1)))
#define LAS __attribute__((address_space(3)))
#define HD __device__ __forceinline__
typedef unsigned short bf16;
typedef unsigned v4u __attribute__((ext_vector_type(4)));
typedef unsigned v2u __attribute__((ext_vector_type(2)));
typedef float f32x4 __attribute__((ext_vector_type(4)));
typedef float f32x2 __attribute__((ext_vector_type(2)));
typedef short bf16x8 __attribute__((ext_vector_type(8)));
typedef short s16x4 __attribute__((ext_vector_type(4)));
typedef int i32x8 __attribute__((ext_vector_type(8)));
typedef int i32x4 __attribute__((ext_vector_type(4)));

constexpr int D = 1024, NB = 16, SEQ = 4096, M = NB * SEQ, DEPTH = 4;
constexpr int NEXP = 32, TOPK = 4;
constexpr int GLA_NIN = 3104, GLA_NPAD = 3328;
constexpr float LN_EPS = 1e-5f;
constexpr float DN_ALPHA = 1.6817928305074290f;
constexpr int NWAVES = 8, NT = 512;
constexpr int MAXTILES = 1088;
constexpr int MOE_ROWS = MAXTILES * 256;

constexpr size_t MiB = 1ull << 20;
constexpr size_t WS_CTL = 0, CTL_ZERO_BYTES = 1 * MiB;
constexpr size_t WS_WGIN = 2 * MiB;
constexpr size_t WS_WGOUT = WS_WGIN + 14 * MiB;
constexpr size_t WS_WHIN = WS_WGOUT + 4 * MiB;
constexpr size_t WS_WHOUT = WS_WHIN + 6 * MiB;
constexpr size_t WS_WNIN = WS_WHOUT + 2 * MiB;
constexpr size_t WS_WNOUT = WS_WNIN + 6 * MiB;
constexpr size_t WS_WR = WS_WNOUT + 2 * MiB;
constexpr size_t WS_WGU = WS_WR + 2 * MiB;
constexpr size_t WS_WDN = WS_WGU + 512 * MiB;
constexpr size_t WS_HFB = WS_WDN + 256 * MiB;
constexpr size_t WS_HSPEC = WS_HFB + 64 * MiB;
constexpr size_t WS_XA = WS_HSPEC + 128 * MiB;
constexpr size_t WS_XB = WS_XA + 256 * MiB;
constexpr size_t WS_XAB = WS_XB + 256 * MiB;
constexpr size_t WS_XBB = WS_XAB + 128 * MiB;
constexpr size_t WS_HPRE = WS_XBB + 128 * MiB;
constexpr size_t WS_AB = WS_HPRE + 128 * MiB;
constexpr size_t WS_BIG = WS_AB + 128 * MiB;
constexpr size_t WS_QKVG = WS_BIG;
constexpr size_t WS_GLOW = WS_QKVG + 384 * MiB;
constexpr size_t WS_OF = WS_GLOW + 8 * MiB;
constexpr size_t WS_OB = WS_OF + 256 * MiB;
constexpr size_t WS_QT2 = WS_OF + 128 * MiB;
constexpr size_t WS_KT2 = WS_OB + 128 * MiB;
constexpr size_t WS_GS2 = WS_OB + 256 * MiB;
constexpr size_t WS_PT = WS_BIG;
constexpr size_t WS_OUTT = WS_PT + 384 * MiB;
constexpr size_t WS_QH = WS_BIG, WS_KH = WS_QH + 128 * MiB, WS_VH = WS_KH + 128 * MiB;
constexpr size_t WS_HBUF = WS_BIG;
constexpr size_t WS_YBUF = WS_HBUF + (size_t)MOE_ROWS * 2048;
constexpr size_t WS_TOKL = WS_YBUF + (size_t)MOE_ROWS * 2048;
constexpr size_t WS_SEL = WS_TOKL + 8 * MiB;
constexpr size_t WS_GATE = WS_SEL + 2 * MiB;
constexpr size_t WS_LOGIT = WS_GATE + 1 * MiB;
constexpr size_t WS_X8 = WS_LOGIT + 8 * MiB;
constexpr size_t WS_XS = WS_X8 + 64 * MiB;
constexpr size_t WS_END = WS_XS + (size_t)MOE_ROWS * 1024;
static_assert(WS_OB + 256 * MiB <= WS_END + 64 * MiB, "map");
constexpr size_t WS_NEED = (WS_END > WS_OB + 256 * MiB ? WS_END : WS_OB + 256 * MiB);
constexpr int CW_TMO = 0;
constexpr int CW_CNT = 64;
constexpr int CW_BAR = 4096;

constexpr int RING_BYTES = 131072;
constexpr int LDS_MISC = RING_BYTES;
constexpr int LDS_WTAB = LDS_MISC + 1024;
constexpr int LDS_ECNT = LDS_MISC + 1280;
constexpr int LDS_TBASE = LDS_ECNT + 128;
constexpr int LDS_TEXP = LDS_TBASE + 144;
constexpr int LDS_BYTES = 147456;
static_assert(LDS_TEXP + MAXTILES * 2 <= LDS_BYTES && LDS_MISC == 131072 && LDS_WTAB == 131072 + 1024, "lds");

#define LDS_WAIT() asm volatile("s_waitcnt lgkmcnt(0)" ::: "memory")
#define VM_WAIT() asm volatile("s_waitcnt vmcnt(0)" ::: "memory")
typedef __bf16 hwbf16x2 __attribute__((ext_vector_type(2)));
HD unsigned pk2(float lo, float hi) { const hwbf16x2 r = __builtin_convertvector((f32x2){lo, hi}, hwbf16x2); return __builtin_bit_cast(unsigned, r); }
HD unsigned f2bf(float f) { return pk2(f, 0.f) & 0xffffu; }
HD float clamp8(float v) { return fminf(fmaxf(v, -448.f), 448.f); }
HD unsigned pk4_fp8(float a, float b, float c, float d) { int w = 0; w = __builtin_amdgcn_cvt_pk_fp8_f32(clamp8(a), clamp8(b), w, false); w = __builtin_amdgcn_cvt_pk_fp8_f32(clamp8(c), clamp8(d), w, true); return (unsigned)w; }
HD float bf2f(unsigned b) { return __builtin_bit_cast(float, b << 16); }
HD float bflo(unsigned w) { return __builtin_bit_cast(float, w << 16); }
HD float bfhi(unsigned w) { return __builtin_bit_cast(float, w & 0xffff0000u); }
HD float sin_rev(float r) { r -= rintf(r); return __builtin_amdgcn_sinf(r); }
HD float cos_rev(float r) { r -= rintf(r); return __builtin_amdgcn_cosf(r); }
HD float sin_rad(float x) { return sin_rev(x * 0.15915494309189535f); }
HD int hw_slot() { const unsigned h = (unsigned)__builtin_amdgcn_s_getreg((6 << 11) | 4); return (int)(h & 0x3fu); }
HD int my_tid(const LAS unsigned char* lds_) {
    const int lane = (int)__builtin_amdgcn_mbcnt_hi(~0u, __builtin_amdgcn_mbcnt_lo(~0u, 0u));
    const int wv = __builtin_amdgcn_readfirstlane(((const LAS int*)(lds_ + 131072 + 1024))[hw_slot()]);
    return wv * 64 + lane;
}
template <int CTRL> HD float dpp_add(float v) { const int t = __builtin_amdgcn_update_dpp(0, __builtin_bit_cast(int, v), CTRL, 0xf, 0xf, true); return v + __builtin_bit_cast(float, t); }
HD float wave_sum(float v) {
    v = dpp_add<0xB1>(v); v = dpp_add<0x4E>(v); v = dpp_add<0x141>(v); v = dpp_add<0x140>(v);
    const int iv = __builtin_bit_cast(int, v);
    return (__builtin_bit_cast(float, __builtin_amdgcn_readlane(iv, 0)) + __builtin_bit_cast(float, __builtin_amdgcn_readlane(iv, 16)))
         + (__builtin_bit_cast(float, __builtin_amdgcn_readlane(iv, 32)) + __builtin_bit_cast(float, __builtin_amdgcn_readlane(iv, 48)));
}

#define XB_TMO      128
#define XB_XCNT(j)  (256  + 64 * (j))
#define XB_XSUB(j)  (1280 + 64 * (j))
#define XB_XGEN(j)  (2304 + 64 * (j))
#define XB_TOP      3328
#define XB_TOPGEN   3392
#define XCD_BAR_WORDS 3456
#define XB_SPIN_CAP (1u << 18)
__device__ __forceinline__ unsigned xb_ld(unsigned* p)              { return __hip_atomic_load(p, __ATOMIC_RELAXED, __HIP_MEMORY_SCOPE_AGENT); }
__device__ __forceinline__ unsigned xb_add(unsigned* p, unsigned v) { return __hip_atomic_fetch_add(p, v, __ATOMIC_RELAXED, __HIP_MEMORY_SCOPE_AGENT); }
__device__ __forceinline__ unsigned xb_xcc_id() { return (unsigned)__builtin_amdgcn_s_getreg((3 << 11) | 20) & 0xFu; }
#define XB_SPIN(cond, bar) do { unsigned _sp = 0; while (cond) { __builtin_amdgcn_s_sleep(1); \
    if ((++_sp & 255u) == 0u) { if (xb_ld(&(bar)[XB_TMO])) break; if (_sp > XB_SPIN_CAP) { atomicAdd(&(bar)[XB_TMO], 1u); break; } } } } while (0)
struct XcdBarrier { unsigned* bar; unsigned x; volatile LAS unsigned* st; };
__device__ __forceinline__ XcdBarrier xcd_barrier_post(unsigned* bar, volatile LAS unsigned* st) {
    XcdBarrier b; b.bar = bar; b.x = xb_xcc_id(); b.st = st;
    if (my_tid((const LAS unsigned char*)st - (131072 + 32)) == 0) (void)xb_add(&bar[XB_XCNT(b.x)], 1u);
    return b;
}
__device__ __forceinline__ void xcd_barrier_complete(unsigned* bar, unsigned x, unsigned& nloc, unsigned& nx) {
    const unsigned G = gridDim.x * gridDim.y * gridDim.z;
    unsigned sum, cnt, mine, sp = 0u;
    for (;;) {
        sum = 0u; cnt = 0u; mine = 0u;
#pragma unroll
        for (unsigned j = 0; j < 16; ++j) { const unsigned c = xb_ld(&bar[XB_XCNT(j)]); sum += c; cnt += (c > 0u) ? 1u : 0u; mine = (j == x) ? c : mine; }
        if (sum == G) break;
        __builtin_amdgcn_s_sleep(1);
        if ((++sp & 255u) == 0u) { if (xb_ld(&bar[XB_TMO])) break; if (sp > XB_SPIN_CAP) { atomicAdd(&bar[XB_TMO], 1u); break; } }
    }
    nloc = mine > 0u ? mine : 1u; nx = cnt > 0u ? cnt : 1u;
}
__device__ __forceinline__ void xcd_barrier(const XcdBarrier& b) {
    asm volatile("s_waitcnt vmcnt(0)" ::: "memory");
    __syncthreads();
    if (my_tid((const LAS unsigned char*)b.st - (131072 + 32)) == 0) {
        unsigned* bar = b.bar;
        __builtin_amdgcn_s_waitcnt(0);
        unsigned nloc = b.st[0], nx = b.st[1];
        if (nloc == 0u) { xcd_barrier_complete(bar, b.x, nloc, nx); b.st[0] = nloc; b.st[1] = nx; }
        const unsigned old = xb_add(&bar[XB_XSUB(b.x)], 1u);
        const unsigned gen = old / nloc;
        if (old + 1u == (gen + 1u) * nloc) {
            __builtin_amdgcn_fence(__ATOMIC_RELEASE, "agent");
            asm volatile("s_waitcnt vmcnt(0)" ::: "memory");
            const unsigned og = xb_add(&bar[XB_TOP], 1u);
            const unsigned tg = og / nx;
            if (og + 1u == (tg + 1u) * nx) xb_add(&bar[XB_TOPGEN], 1u);
            else XB_SPIN(xb_ld(&bar[XB_TOPGEN]) == tg, bar);
            __builtin_amdgcn_fence(__ATOMIC_ACQUIRE, "agent");
            xb_add(&bar[XB_XGEN(b.x)], 1u);
            asm volatile("s_waitcnt vmcnt(0)" ::: "memory");
        } else {
            XB_SPIN(xb_ld(&bar[XB_XGEN(b.x)]) == gen, bar);
            __builtin_amdgcn_fence(__ATOMIC_ACQUIRE, "agent");
            asm volatile("s_waitcnt vmcnt(0)" ::: "memory");
        }
    }
    __syncthreads();
}

namespace g8 {
constexpr int BM = 256, BK = 64, HALF = 128, HTB = HALF * BK * 2, STAGE_BYTES = 8 * HTB, NXCD = 8, WGM = 8, K = 1024;
HD int lds_byte(int r, int c) { const int st = (r >> 4) * 2 + (c >> 5), rr = r & 15, cc = c & 31, ob = rr * 64 + cc * 2; return st * 1024 + (ob ^ (((ob >> 9) & 1) << 5)); }
HD void stage_rc(int b, int& R, int& C) { const int st = b / 1024, sb = b % 1024, swz = sb ^ (((sb >> 9) & 1) << 5); R = (st >> 1) * 16 + swz / 64; C = (st & 1) * 32 + (swz % 64) / 2; }
HD int perm32(int rho) { const int n = rho >> 4, i = rho & 15; return 8 * (i >> 2) + 4 * n + (i & 3); }
struct UnitD { const char* A; const char* B; int pm, pn, e, mt, cnt, rowbase; };
HD int fdiv(int a, int b) { int q = (int)((float)a * __builtin_amdgcn_rcpf((float)b)); const int r = a - q * b; q += (r >= b) ? 1 : 0; q -= (r < 0) ? 1 : 0; return q; }
HD void order_map(int L, int nM, int nN, int& pm, int& pn) {
    const int nwg = nM * nN; int wgid = L;
    { const int q = nwg / NXCD, r = nwg % NXCD, xcd = wgid % NXCD, off = wgid / NXCD; wgid = (xcd < r ? xcd * (q + 1) : r * (q + 1) + (xcd - r) * q) + off; }
    const int nig = WGM * nN, gid = fdiv(wgid, nig), fm = gid * WGM, gsz = (nM - fm) < WGM ? (nM - fm) : WGM;
    const int rem = wgid - gid * nig, pq = (gsz == WGM) ? (rem >> 3) : fdiv(rem, gsz);
    pm = fm + (rem - pq * gsz); pn = pq;
}
struct DenseSched {
    const bf16* A; const bf16* Bt; int nM, nN, G, c; int rowb = 2048;
    HD bool next(int i, UnitD& u) const {
        const long L = (long)i * G + c; if (L >= (long)nM * nN) return false;
        int pm, pn; order_map((int)L, nM, nN, pm, pn);
        u.pm = pm; u.pn = pn; u.e = 0; u.mt = 0; u.cnt = 256; u.rowbase = pm * 256;
        u.A = (const char*)A + (size_t)pm * (256 * rowb); u.B = (const char*)Bt + (size_t)pn * (256 * rowb); return true;
    }
    HD void rows(const UnitD&, int, unsigned (&)[2][2]) const {}
    HD unsigned off(unsigned raw, unsigned) const { return raw; }
};
struct PanelSched {
    const bf16* A; const bf16* Bt; int pm, nN; int rowb = 2048;
    HD bool next(int i, UnitD& u) const {
        if (i >= nN) return false;
        u.pm = pm; u.pn = i; u.e = 0; u.mt = 0; u.cnt = 256; u.rowbase = pm * 256;
        u.A = (const char*)A + (size_t)pm * (256 * rowb); u.B = (const char*)Bt + (size_t)i * (256 * rowb); return true;
    }
    HD void rows(const UnitD&, int, unsigned (&)[2][2]) const {}
    HD unsigned off(unsigned raw, unsigned) const { return raw; }
};
struct MoeSched {
    const bf16* Abase; const bf16* W; size_t wstride;
    const int* tokl; const LAS int* ecnt; const LAS int* tbase; const LAS unsigned short* texp;
    int T, nN, G, c; bool gather; int rowb;
    HD bool next(int i, UnitD& u) const {
        const long L = (long)i * G + c; if (L >= (long)T * nN) return false;
        int pm, pn; order_map((int)L, T, nN, pm, pn);
        const int e = __builtin_amdgcn_readfirstlane((int)texp[pm]), mt = pm - __builtin_amdgcn_readfirstlane(tbase[e]);
        u.pm = pm; u.pn = pn; u.e = e; u.mt = mt; u.cnt = __builtin_amdgcn_readfirstlane(ecnt[e]) - mt * 256; u.rowbase = pm * 256;
        u.A = gather ? (const char*)Abase : (const char*)Abase + (size_t)pm * (256 * rowb);
        u.B = (const char*)W + (size_t)e * wstride + (size_t)pn * (256 * rowb); return true;
    }
    HD void rows(const UnitD& u, int tid, unsigned (&v)[2][2]) const {
        const int* tl = tokl + (size_t)u.e * 65536 + u.mt * 256; int R, C; stage_rc(tid * 16, R, C); (void)C;
#pragma unroll
        for (int h = 0; h < 2; ++h)
#pragma unroll
            for (int i = 0; i < 2; ++i) { const int r = h * 128 + 64 * i + R; v[h][i] = (unsigned)tl[(r < u.cnt) ? r : 0]; }
    }
    HD unsigned off(unsigned raw, unsigned c2) const { return raw * (unsigned)rowb + c2; }
};

HD void glds16x2(const char* sbase, const char* sbase2, unsigned v0, unsigned lds_dst) {
    unsigned keep;
    const unsigned lds_dst2 = lds_dst + 0x2000u;
    asm volatile("s_mov_b32 %0, m0\n\ts_mov_b32 m0, %4\n\ts_nop 0\n\tglobal_load_lds_dwordx4 %1, %2\n\ts_mov_b32 m0, %5\n\ts_nop 0\n\tglobal_load_lds_dwordx4 %1, %3\n\ts_mov_b32 m0, %0"
                 : "=&s"(keep) : "v"(v0), "s"(sbase), "s"(sbase2), "s"(lds_dst), "s"(lds_dst2) : "memory");
}
HD void glds16x2g(const char* sbase, unsigned v0, unsigned v1, unsigned lds_dst) {
    unsigned keep;
    const unsigned lds_dst2 = lds_dst + 0x2000u;
    asm volatile("s_mov_b32 %0, m0\n\ts_mov_b32 m0, %4\n\ts_nop 0\n\tglobal_load_lds_dwordx4 %1, %3\n\ts_mov_b32 m0, %5\n\ts_nop 0\n\tglobal_load_lds_dwordx4 %2, %3\n\ts_mov_b32 m0, %0"
                 : "=&s"(keep) : "v"(v0), "v"(v1), "s"(sbase), "s"(lds_dst), "s"(lds_dst2) : "memory");
}
HD i32x8 cat32(bf16x8 lo, bf16x8 hi) { const i32x4 a = __builtin_bit_cast(i32x4, lo), b = __builtin_bit_cast(i32x4, hi); return (i32x8){a[0], a[1], a[2], a[3], b[0], b[1], b[2], b[3]}; }
template <class Epi, class Sched, bool GATHER, bool F8 = false>
__device__ __forceinline__ void gemm_phase(LAS unsigned char* lds, const Sched& S, const Epi& E) {
    int tid = my_tid(lds); asm volatile("" : "+v"(tid));
    const int wid = __builtin_amdgcn_readfirstlane(tid >> 6), lane = tid & 63, wr = wid >> 2, wc = wid & 3, fr = lane & 15, fq = lane >> 4;
    constexpr int ROWB = F8 ? 1024 : 2048;
    constexpr int nt = ROWB / 128;
    unsigned voffB, voffA0;
    { int R, C; stage_rc(tid * 16, R, C); const int Rb = (R & ~31) + perm32(R & 31); voffA0 = (unsigned)(R * ROWB + C * 2); voffB = (unsigned)(Rb * ROWB + C * 2); }
    constexpr size_t kstep = (size_t)(BK * 2);
    constexpr size_t hstep = (size_t)HALF * ROWB;
    const unsigned ldsw = (unsigned)wid * 1024u; const unsigned ldsbase = (unsigned)(size_t)lds;
    const int fcol = fq * 8;
    const int aoff = lds_byte(wr * 64 + fr, fcol), boff = lds_byte(wc * 32 + fr, fcol);

#define PG8_SA(b, h) (((b) * 2 + (h)) * HTB)
#define PG8_SB(b, h) ((4 + (b) * 2 + (h)) * HTB)
#define PG8_STAGE(bufoff, gbase, voff) glds16x2((const char*)(gbase), (const char*)(gbase) + 64 * ROWB, (voff), ldsbase + (unsigned)(bufoff) + ldsw)
#define PG8_STAGE_A(bufoff, gbase, vv) do { if constexpr (GATHER) glds16x2g((const char*)(gbase), (vv)[0], (vv)[1], ldsbase + (unsigned)(bufoff) + ldsw); else PG8_STAGE(bufoff, gbase, (vv)[0]); } while (0)
#define PG8_LDA(dst, b, h) do { if constexpr (F8) { _Pragma("unroll") for (int m = 0; m < 4; ++m) dst##8[m] = cat32(*(const LAS bf16x8*)(lds + PG8_SA(b, h) + aoff + m * 2048), *(const LAS bf16x8*)(lds + PG8_SA(b, h) + aoff + m * 2048 + 1024)); } \
        else { _Pragma("unroll") for (int m = 0; m < 4; ++m) _Pragma("unroll") for (int k = 0; k < 2; ++k) dst[m][k] = *(const LAS bf16x8*)(lds + PG8_SA(b, h) + aoff + m * 2048 + k * 1024); } } while (0)
#define PG8_LDB(dst, b, h) do { if constexpr (F8) { _Pragma("unroll") for (int n = 0; n < 2; ++n) dst##8[n] = cat32(*(const LAS bf16x8*)(lds + PG8_SB(b, h) + boff + n * 2048), *(const LAS bf16x8*)(lds + PG8_SB(b, h) + boff + n * 2048 + 1024)); } \
        else { _Pragma("unroll") for (int n = 0; n < 2; ++n) _Pragma("unroll") for (int k = 0; k < 2; ++k) dst[n][k] = *(const LAS bf16x8*)(lds + PG8_SB(b, h) + boff + n * 2048 + k * 1024); } } while (0)
#define PG8_MMA(ai, bj, At, Bt) do { __builtin_amdgcn_s_setprio(1); _Pragma("unroll") for (int m = 0; m < 4; ++m) _Pragma("unroll") for (int n = 0; n < 2; ++n) { \
        if constexpr (F8) asm volatile("v_mfma_scale_f32_16x16x128_f8f6f4 %0, %1, %2, %0, %3, %3 op_sel_hi:[0,0,0]" : "+v"(acc[ai][bj][m][n]) : "v"(Bt##8[n]), "v"(At##8[m]), "v"(scl8)); \
        else { _Pragma("unroll") for (int k = 0; k < 2; ++k) acc[ai][bj][m][n] = __builtin_amdgcn_mfma_f32_16x16x32_bf16(Bt[n][k], At[m][k], acc[ai][bj][m][n], 0, 0, 0); } } __builtin_amdgcn_s_setprio(0); } while (0)
#define PG8_WAIT_V(n) asm volatile("s_waitcnt vmcnt(" #n ")" ::: "memory")
#define PG8_WAIT_L(n) asm volatile("s_waitcnt lgkmcnt(" #n ")" ::: "memory")
#define PG8_WAIT_VR(relax) do { if constexpr (Epi::NST == 16) { if (relax) PG8_WAIT_V(24); else PG8_WAIT_V(8); } else if constexpr (Epi::NST == 8) { if (relax) PG8_WAIT_V(16); else PG8_WAIT_V(8); } else PG8_WAIT_V(8); } while (0)
#define PG8_BAR __builtin_amdgcn_s_barrier()
#define PG8_SCHED __builtin_amdgcn_sched_barrier(0)
    UnitD cur, nxt; int ui = 0; bool relaxU = false;
    if (!S.next(0, cur)) return;
    f32x4 acc[2][2][4][2];
    bf16x8 At[4][2], B0[2][2], B1[2][2]; i32x8 At8[4], B08[2], B18[2]; unsigned scl8 = 0x7F7F7F7Fu; asm volatile("" : "+v"(scl8));
    unsigned vA[2][2], vN[2][2], vNN[2][2];
    constexpr size_t ah = GATHER ? 0 : hstep;
    if constexpr (GATHER) { UnitD nn; S.rows(cur, tid, vA); const bool has_nn = S.next(1, nn); if (has_nn) S.rows(nn, tid, vN);
#pragma unroll
        for (int h = 0; h < 2; ++h)
#pragma unroll
            for (int i = 0; i < 2; ++i) { if (!has_nn) vN[h][i] = vA[h][i]; vNN[h][i] = vN[h][i]; vA[h][i] = S.off(vA[h][i], voffB & 127u); vN[h][i] = S.off(vN[h][i], voffB & 127u); } }
    else {
#pragma unroll
        for (int h = 0; h < 2; ++h)
#pragma unroll
            for (int i = 0; i < 2; ++i) { vA[h][i] = voffA0; vN[h][i] = voffA0; vNN[h][i] = voffA0; }
    }
    const char* cA = cur.A; const char* cB = cur.B;
    typename Epi::Pre preN;
    { int l2 = (int)__builtin_amdgcn_mbcnt_hi(~0u, __builtin_amdgcn_mbcnt_lo(~0u, 0u)); asm volatile("" : "+v"(l2)); preN = E.pre(cur, wr, wc, l2 & 15, l2 >> 4); E.init(acc, preN, cur); }
    PG8_STAGE(PG8_SB(0, 0), cB, voffB); PG8_STAGE(PG8_SB(0, 1), cB + hstep, voffB); PG8_STAGE_A(PG8_SA(0, 0), cA, vA[0]); PG8_STAGE_A(PG8_SA(0, 1), cA + ah, vA[1]);
    if (wr == 1) PG8_BAR;
    PG8_WAIT_V(2); PG8_BAR;
    PG8_STAGE(PG8_SB(1, 0), cB + kstep, voffB); PG8_STAGE_A(PG8_SA(1, 0), cA + kstep, vA[0]); PG8_STAGE(PG8_SB(1, 1), cB + hstep + kstep, voffB);
    PG8_WAIT_V(6); PG8_BAR;
    for (;;) {
        const bool has_next = S.next(ui + 1, nxt);
        const char* nA = has_next ? nxt.A : cA; const char* nB = has_next ? nxt.B : cB;
        if constexpr (GATHER) { UnitD n2; if (S.next(ui + 2, n2)) S.rows(n2, tid, vNN); }
#pragma unroll 1
        for (int t = 0; t < nt; t += 2) {
            const bool last = (t == nt - 2);
            const char* a1 = cA + (size_t)(t + 1) * kstep;
            const char* a2 = last ? nA : cA + (size_t)(t + 2) * kstep; const char* b2 = last ? nB : cB + (size_t)(t + 2) * kstep;
            const char* a3 = a2 + kstep; const char* b3 = b2 + kstep;
            unsigned v2[2][2];
#pragma unroll
            for (int h = 0; h < 2; ++h)
#pragma unroll
                for (int i = 0; i < 2; ++i) v2[h][i] = GATHER ? (last ? vN[h][i] : vA[h][i]) : vA[h][i];
            const bool relax = relaxU && (t == 0);
            PG8_LDB(B0, 0, 0); PG8_LDB(B1, 0, 1); PG8_SCHED; PG8_LDA(At, 0, 0); PG8_STAGE_A(PG8_SA(1, 1), a1 + ah, vA[1]);
            PG8_WAIT_VR(relax); PG8_WAIT_L(0); PG8_BAR; PG8_MMA(0, 0, At, B0); PG8_MMA(0, 1, At, B1); PG8_BAR; PG8_SCHED;
            PG8_LDA(At, 0, 1); PG8_STAGE(PG8_SB(0, 0), b2, voffB); PG8_STAGE(PG8_SB(0, 1), b2 + hstep, voffB); PG8_STAGE_A(PG8_SA(0, 0), a2, v2[0]);
            PG8_WAIT_VR(relax); PG8_WAIT_L(0); PG8_BAR; PG8_MMA(1, 0, At, B0); PG8_MMA(1, 1, At, B1); PG8_BAR; PG8_SCHED;
            PG8_LDB(B0, 1, 0); PG8_LDB(B1, 1, 1); PG8_SCHED; PG8_LDA(At, 1, 0); PG8_STAGE_A(PG8_SA(0, 1), a2 + ah, v2[1]);
            PG8_WAIT_V(8); PG8_WAIT_L(0); PG8_BAR; PG8_MMA(0, 0, At, B0); PG8_MMA(0, 1, At, B1); PG8_BAR; PG8_SCHED;
            PG8_LDA(At, 1, 1); PG8_STAGE(PG8_SB(1, 0), b3, voffB); PG8_STAGE(PG8_SB(1, 1), b3 + hstep, voffB); PG8_STAGE_A(PG8_SA(1, 0), a3, v2[0]);
            PG8_WAIT_V(8); PG8_WAIT_L(0); PG8_BAR; PG8_MMA(1, 0, At, B0); PG8_MMA(1, 1, At, B1); PG8_BAR; PG8_SCHED;
        }
        if (wr == 0) PG8_BAR;
        if constexpr (F8) asm volatile("s_nop 15\n\ts_nop 15" ::: "memory");
        { int l2 = (int)__builtin_amdgcn_mbcnt_hi(~0u, __builtin_amdgcn_mbcnt_lo(~0u, 0u)); asm volatile("" : "+v"(l2)); preN = E.pre(has_next ? nxt : cur, wr, wc, l2 & 15, l2 >> 4); E(acc, cur, wr, wc, l2 & 15, l2 >> 4); }
        if (!has_next) break;
        E.init(acc, preN, nxt);
        relaxU = E.stored(cur, wc);
        cur = nxt; cA = nA; cB = nB; ++ui;
#pragma unroll
        for (int h = 0; h < 2; ++h)
#pragma unroll
            for (int i = 0; i < 2; ++i) { vA[h][i] = vN[h][i]; vN[h][i] = GATHER ? S.off(vNN[h][i], voffB & 127u) : vNN[h][i]; }
        asm volatile("" :: "v"(acc[0][0][0][0]), "v"(acc[0][0][0][1]), "v"(acc[0][1][0][0]), "v"(acc[0][1][0][1]), "v"(vN[0][0]), "v"(vN[0][1]), "v"(vN[1][0]), "v"(vN[1][1]) : "memory");
        if (wr == 1) PG8_BAR;
    }
    PG8_WAIT_V(0);
    PG8_BAR;
#undef PG8_SA
#undef PG8_SB
#undef PG8_STAGE
#undef PG8_STAGE_A
#undef PG8_LDA
#undef PG8_LDB
#undef PG8_MMA
#undef PG8_WAIT_V
#undef PG8_WAIT_VR
#undef PG8_WAIT_L
#undef PG8_BAR
#undef PG8_SCHED
}

HD v4u pack8(const f32x4 a, const f32x4 b) { v4u w; w.x = pk2(a[0], a[1]); w.y = pk2(a[2], a[3]); w.z = pk2(b[0], b[1]); w.w = pk2(b[2], b[3]); return w; }
typedef f32x4 AccT[2][2][4][2];
struct Pre16 { f32x4 v[4]; };
struct Pre0 {};
HD void acc_zero(AccT& acc) {
#pragma unroll
    for (int a = 0; a < 2; ++a)
#pragma unroll
        for (int b = 0; b < 2; ++b)
#pragma unroll
            for (int m = 0; m < 4; ++m)
#pragma unroll
                for (int n = 0; n < 2; ++n) acc[a][b][m][n] = (f32x4){0.f, 0.f, 0.f, 0.f};
}
HD void acc_colbias(AccT& acc, const Pre16& p, float s) {
    f32x4 q[4];
#pragma unroll
    for (int k = 0; k < 4; ++k) q[k] = p.v[k] * s;
#pragma unroll
    for (int a = 0; a < 2; ++a)
#pragma unroll
        for (int b = 0; b < 2; ++b)
#pragma unroll
            for (int m = 0; m < 4; ++m)
#pragma unroll
                for (int n = 0; n < 2; ++n) acc[a][b][m][n] = q[b * 2 + n];
}

struct EpiBf16 {
    bf16* O; int ldc; const float* bias; int nscale; float scale;
    static constexpr int NST = 16; HD bool stored(const UnitD&, int) const { return true; }
    typedef Pre16 Pre;
    HD Pre pre(const UnitD& u, int wr, int wc, int fr, int fq) const { Pre p; const int col0 = u.pn * 256 + wc * 32 + 8 * fq;
#pragma unroll
        for (int bj = 0; bj < 2; ++bj)
#pragma unroll
            for (int n = 0; n < 2; ++n) p.v[bj * 2 + n] = *(const f32x4*)((bias ? bias : (const float*)O) + col0 + bj * HALF + 4 * n);
        return p; }
    HD void init(AccT& acc, const Pre& p, const UnitD& u) const { if (bias) acc_colbias(acc, p, 1.f / ((u.pn < nscale) ? scale : 1.f)); else acc_zero(acc); }
    HD void operator()(const AccT& acc, const UnitD& u, int wr, int wc, int fr, int fq) const {
        const int row0 = u.rowbase + wr * 64 + fr, col0 = u.pn * 256 + wc * 32 + 8 * fq;
        const float sc = (u.pn < nscale) ? scale : 1.f;
#pragma unroll
        for (int ai = 0; ai < 2; ++ai)
#pragma unroll
            for (int m = 0; m < 4; ++m) { bf16* rowp = O + (size_t)(row0 + ai * HALF + m * 16) * ldc + col0;
#pragma unroll
                for (int bj = 0; bj < 2; ++bj) *(v4u*)(rowp + bj * HALF) = pack8(acc[ai][bj][m][0] * sc, acc[ai][bj][m][1] * sc); }
    }
};
struct EpiGlaIn {
    bf16* O; float* glow; float qscale; float ascale;
    static constexpr int NST = 16; HD bool stored(const UnitD& u, int wc) const { return u.pn < 12 || wc == 0; }
    typedef Pre0 Pre; HD Pre pre(const UnitD&, int, int, int, int) const { return Pre(); }
    HD void init(AccT& acc, const Pre&, const UnitD&) const { acc_zero(acc); }
    HD void operator()(const AccT& acc, const UnitD& u, int wr, int wc, int fr, int fq) const {
        const int row0 = u.rowbase + wr * 64 + fr;
        if (u.pn < 12) {
            const int col0 = u.pn * 256 + wc * 32 + 8 * fq; const float sc = ((u.pn < 2) ? qscale : 1.f) * ascale;
#pragma unroll
            for (int ai = 0; ai < 2; ++ai)
#pragma unroll
                for (int m = 0; m < 4; ++m) { bf16* rowp = O + (size_t)(row0 + ai * HALF + m * 16) * 3072 + col0;
#pragma unroll
                    for (int bj = 0; bj < 2; ++bj) *(v4u*)(rowp + bj * HALF) = pack8(acc[ai][bj][m][0] * sc, acc[ai][bj][m][1] * sc); }
        } else if (wc == 0) {
#pragma unroll
            for (int ai = 0; ai < 2; ++ai)
#pragma unroll
                for (int m = 0; m < 4; ++m) { float* rowp = glow + (size_t)(row0 + ai * HALF + m * 16) * 32 + 8 * fq;
                    *(f32x4*)(rowp) = acc[ai][0][m][0] * ascale; *(f32x4*)(rowp + 4) = acc[ai][0][m][1] * ascale; }
        }
    }
};
struct EpiF32Cols32 {
    float* O;
    static constexpr int NST = 0; HD bool stored(const UnitD&, int) const { return false; }
    typedef Pre0 Pre; HD Pre pre(const UnitD&, int, int, int, int) const { return Pre(); }
    HD void init(AccT& acc, const Pre&, const UnitD&) const { acc_zero(acc); }
    HD void operator()(const AccT& acc, const UnitD& u, int wr, int wc, int fr, int fq) const {
        if (u.pn != 0 || wc != 0) return;
        const int row0 = u.rowbase + wr * 64 + fr;
#pragma unroll
        for (int ai = 0; ai < 2; ++ai)
#pragma unroll
            for (int m = 0; m < 4; ++m) { float* rowp = O + (size_t)(row0 + ai * HALF + m * 16) * 32 + 8 * fq;
                *(f32x4*)(rowp) = acc[ai][0][m][0]; *(f32x4*)(rowp + 4) = acc[ai][0][m][1]; }
    }
};
struct EpiHyIn {
    bf16* O; const float* bias; float ascale;
    static constexpr int NST = 16; HD bool stored(const UnitD&, int) const { return true; }
    typedef Pre16 Pre;
    HD Pre pre(const UnitD& u, int wr, int wc, int fr, int fq) const { Pre p; const int row0 = u.rowbase + wr * 64 + fr;
#pragma unroll
        for (int ai = 0; ai < 2; ++ai)
#pragma unroll
            for (int m = 0; m < 4; ++m) p.v[ai][m] = bias[row0 + ai * HALF + m * 16];
        p.v[2] = (f32x4){0.f, 0.f, 0.f, 0.f}; p.v[3] = p.v[2]; return p; }
    HD void init(AccT& acc, const Pre& p, const UnitD&) const {
#pragma unroll
        for (int a = 0; a < 2; ++a)
#pragma unroll
            for (int b = 0; b < 2; ++b)
#pragma unroll
                for (int m = 0; m < 4; ++m)
#pragma unroll
                    for (int n = 0; n < 2; ++n) { const float v = p.v[a][m] * (1.f / ascale); acc[a][b][m][n] = (f32x4){v, v, v, v}; } }
    HD void operator()(const AccT& acc, const UnitD& u, int wr, int wc, int fr, int fq) const {
        const int row0 = u.rowbase + wr * 64 + fr, col0 = u.pn * 256 + wc * 32 + 8 * fq;
#pragma unroll
        for (int ai = 0; ai < 2; ++ai)
#pragma unroll
            for (int m = 0; m < 4; ++m) { const int r = row0 + ai * HALF + m * 16; bf16* rowp = O + (size_t)r * M + col0;
#pragma unroll
                for (int bj = 0; bj < 2; ++bj) *(v4u*)(rowp + bj * HALF) = pack8(acc[ai][bj][m][0] * ascale, acc[ai][bj][m][1] * ascale); }
    }
};
struct EpiNaIn {
    bf16* O; size_t tstride; const float* bias; float qscale; float ascale;
    static constexpr int NST = 16; HD bool stored(const UnitD&, int) const { return true; }
    typedef Pre16 Pre;
    HD Pre pre(const UnitD& u, int wr, int wc, int fr, int fq) const { Pre p;
#pragma unroll
        for (int bj = 0; bj < 2; ++bj) { const int bcol = u.pn * 256 + bj * HALF + wc * 32 + 8 * fq; p.v[bj * 2] = *(const f32x4*)(bias + bcol); p.v[bj * 2 + 1] = *(const f32x4*)(bias + bcol + 4); }
        return p; }
    HD void init(AccT& acc, const Pre& p, const UnitD&) const { acc_colbias(acc, p, 1.f / ascale); }
    HD void operator()(const AccT& acc, const UnitD& u, int wr, int wc, int fr, int fq) const {
        const int row0 = u.rowbase + wr * 64 + fr; const float sc = (u.pn < 4) ? qscale : 1.f;
        const int ten = u.pn >> 2; bf16* base = O + (size_t)ten * tstride;
#pragma unroll
        for (int bj = 0; bj < 2; ++bj) {
            const int colt = (u.pn & 3) * 256 + bj * HALF + wc * 32;
            const int h = colt >> 5; const int bcol = u.pn * 256 + bj * HALF + wc * 32 + 8 * fq;
            (void)bcol;
#pragma unroll
            for (int ai = 0; ai < 2; ++ai)
#pragma unroll
                for (int m = 0; m < 4; ++m) { const int r = row0 + ai * HALF + m * 16; const int b = r >> 12, tok = r & 4095;
                    bf16* p = base + ((size_t)(b * 32 + h) * 4096 + tok) * 32 + 8 * fq;
                    *(v4u*)p = pack8(acc[ai][bj][m][0] * (ascale * sc), acc[ai][bj][m][1] * (ascale * sc)); }
        }
    }
};
struct EpiMoe1 {
    bf16* O; const float* bgu;
    static constexpr int NST = 8; HD bool stored(const UnitD&, int) const { return true; }
    typedef Pre16 Pre;
    HD Pre pre(const UnitD& u, int wr, int wc, int fr, int fq) const { Pre p; const float* bb = bgu + (size_t)u.e * 2048 + u.pn * 128 + wc * 32 + 8 * fq;
#pragma unroll
        for (int n = 0; n < 2; ++n) { p.v[n] = *(const f32x4*)(bb + 4 * n); p.v[2 + n] = *(const f32x4*)(bb + 1024 + 4 * n); }
        return p; }
    HD void init(AccT& acc, const Pre& p, const UnitD&) const { acc_colbias(acc, p, 2048.f); }
    HD void operator()(const AccT& acc, const UnitD& u, int wr, int wc, int fr, int fq) const {
        const int row0 = u.rowbase + wr * 64 + fr, colh = u.pn * 128 + wc * 32 + 8 * fq;
#pragma unroll
        for (int ai = 0; ai < 2; ++ai)
#pragma unroll
            for (int m = 0; m < 4; ++m) {
                unsigned w8a[2];
#pragma unroll
                for (int n = 0; n < 2; ++n) { const f32x4 g4 = acc[ai][0][m][n] * 4.8828125e-4f, l4 = acc[ai][1][m][n] * 4.8828125e-4f;
                    f32x2 o2[2];
#pragma unroll
                    for (int jp = 0; jp < 2; ++jp) {
                        const f32x2 gg = (f32x2){fminf(g4[2 * jp], 7.f), fminf(g4[2 * jp + 1], 7.f)};
                        const f32x2 ll = (f32x2){fminf(fmaxf(l4[2 * jp], -7.f), 7.f), fminf(fmaxf(l4[2 * jp + 1], -7.f), 7.f)};
                        const f32x2 t = gg * -2.4554669595930156f;
                        const f32x2 d = (f32x2){__builtin_amdgcn_exp2f(t[0]), __builtin_amdgcn_exp2f(t[1])} + 1.f;
                        const f32x2 r = (f32x2){__builtin_amdgcn_rcpf(d[0]), __builtin_amdgcn_rcpf(d[1])};
                        o2[jp] = (gg * r) * (ll * 4.f + 4.f); }
                    int w = 0; w = __builtin_amdgcn_cvt_pk_fp8_f32(o2[0][0], o2[0][1], w, false); w = __builtin_amdgcn_cvt_pk_fp8_f32(o2[1][0], o2[1][1], w, true); w8a[n] = (unsigned)w; }
                v2u w8; w8.x = w8a[0]; w8.y = w8a[1];
                *(v2u*)((unsigned char*)O + (size_t)(row0 + ai * HALF + m * 16) * 1024 + colh) = w8;
            }
    }
};
struct EpiMoe2 {
    bf16* O; const float* bdn;
    static constexpr int NST = 16; HD bool stored(const UnitD&, int) const { return true; }
    typedef Pre16 Pre;
    HD Pre pre(const UnitD& u, int wr, int wc, int fr, int fq) const { Pre p; const float* bb = bdn + (size_t)u.e * 1024 + u.pn * 256 + wc * 32 + 8 * fq;
#pragma unroll
        for (int bj = 0; bj < 2; ++bj)
#pragma unroll
            for (int n = 0; n < 2; ++n) p.v[bj * 2 + n] = *(const f32x4*)(bb + bj * HALF + 4 * n);
        return p; }
    HD void init(AccT& acc, const Pre& p, const UnitD&) const { acc_colbias(acc, p, 1024.f); }
    HD void operator()(const AccT& acc, const UnitD& u, int wr, int wc, int fr, int fq) const {
        const int row0 = u.rowbase + wr * 64 + fr, col0 = u.pn * 256 + wc * 32 + 8 * fq;
#pragma unroll
        for (int ai = 0; ai < 2; ++ai)
#pragma unroll
            for (int m = 0; m < 4; ++m) { unsigned char* rowp = (unsigned char*)O + (size_t)(row0 + ai * HALF + m * 16) * 1024 + col0;
#pragma unroll
                for (int bj = 0; bj < 2; ++bj) { const f32x4 a0 = acc[ai][bj][m][0] * 0.03125f, a1 = acc[ai][bj][m][1] * 0.03125f; v2u w; w.x = pk4_fp8(a0[0], a0[1], a0[2], a0[3]); w.y = pk4_fp8(a1[0], a1[1], a1[2], a1[3]); *(v2u*)(rowp + bj * HALF) = w; } }
    }
};
}

typedef float cf __attribute__((ext_vector_type(2)));
HD cf cf_mk(float a, float b) { return (cf){a, b}; }
HD cf cadd(cf a, cf b) { return cf_mk(a.x + b.x, a.y + b.y); }
HD cf csub(cf a, cf b) { return cf_mk(a.x - b.x, a.y - b.y); }
HD cf cmul(cf a, cf b) { return cf_mk(a.x * b.x - a.y * b.y, a.x * b.y + a.y * b.x); }
HD cf cmulc(cf a, cf b) { return cf_mk(a.x * b.x + a.y * b.y, a.y * b.x - a.x * b.y); }
template <bool INV> HD void r4(cf& a0, cf& a1, cf& a2, cf& a3) {
    const cf t0 = cadd(a0, a2), t1 = csub(a0, a2), t2 = cadd(a1, a3), t3 = csub(a1, a3);
    a0 = cadd(t0, t2); a2 = csub(t0, t2);
    const cf mit3 = INV ? cf_mk(-t3.y, t3.x) : cf_mk(t3.y, -t3.x);
    a1 = cadd(t1, mit3); a3 = csub(t1, mit3);
}
template <bool INV> HD void dft16(cf (&x)[16]) {
    const float C1 = 0.92387953251128674f, S1 = 0.38268343236508977f, R2 = 0.70710678118654752f;
#pragma unroll
    for (int n0 = 0; n0 < 4; ++n0) r4<INV>(x[n0], x[n0 + 4], x[n0 + 8], x[n0 + 12]);
    const cf w1 = cf_mk(C1, INV ? S1 : -S1), w2 = cf_mk(R2, INV ? R2 : -R2), w3 = cf_mk(S1, INV ? C1 : -C1);
    const cf w4 = cf_mk(0.f, INV ? 1.f : -1.f), w6 = cf_mk(-R2, INV ? R2 : -R2), w9 = cf_mk(-C1, INV ? -S1 : S1);
    x[1 + 4] = cmul(x[1 + 4], w1); x[1 + 8] = cmul(x[1 + 8], w2); x[1 + 12] = cmul(x[1 + 12], w3);
    x[2 + 4] = cmul(x[2 + 4], w2); x[2 + 8] = cmul(x[2 + 8], w4); x[2 + 12] = cmul(x[2 + 12], w6);
    x[3 + 4] = cmul(x[3 + 4], w3); x[3 + 8] = cmul(x[3 + 8], w6); x[3 + 12] = cmul(x[3 + 12], w9);
    cf y[16];
#pragma unroll
    for (int k0 = 0; k0 < 4; ++k0) {
        cf b0 = x[0 + 4 * k0], b1 = x[1 + 4 * k0], b2 = x[2 + 4 * k0], b3 = x[3 + 4 * k0];
        r4<INV>(b0, b1, b2, b3);
        y[k0] = b0; y[k0 + 4] = b1; y[k0 + 8] = b2; y[k0 + 12] = b3;
    }
#pragma unroll
    for (int i = 0; i < 16; ++i) x[i] = y[i];
}
#define FFT_HALF_STRIDE 4352
#define FFT_LDS_COMPLEX (2 * FFT_HALF_STRIDE)
constexpr int FFT_TW_OFF = FFT_LDS_COMPLEX * 8;
static_assert(FFT_TW_OFF + 32768 <= RING_BYTES, "fft lds");
HD int fpos(int hf, int p) { return hf * FFT_HALF_STRIDE + p + (p >> 4); }
HD cf tw8192(const LAS cf* TW, int i) { i &= 8191; const cf t = TW[i & 4095]; return (i & 4096) ? cf_mk(-t.x, -t.y) : t; }
HD void fft_fwd_p1(LAS cf* buf, const LAS cf* TW, int tid) {
    const int hf = tid >> 8, j = tid & 255; cf x[16];
#pragma unroll
    for (int n2 = 0; n2 < 16; ++n2) x[n2] = buf[fpos(hf, n2 * 256 + j)];
    dft16<false>(x);
#pragma unroll
    for (int k0 = 0; k0 < 16; ++k0) { const cf v = k0 ? cmul(x[k0], tw8192(TW, 2 * j * k0)) : x[0]; buf[fpos(hf, k0 * 256 + j)] = v; }
}
HD void fft_fwd_p2(LAS cf* buf, const LAS cf* TW, int tid) {
    const int hf = tid >> 8, j = tid & 255, k0 = j >> 4, n0 = j & 15; cf x[16];
#pragma unroll
    for (int n1 = 0; n1 < 16; ++n1) x[n1] = buf[fpos(hf, k0 * 256 + n1 * 16 + n0)];
    dft16<false>(x);
#pragma unroll
    for (int k1 = 0; k1 < 16; ++k1) { const cf v = k1 ? cmul(x[k1], tw8192(TW, 32 * n0 * k1)) : x[0]; buf[fpos(hf, k0 * 256 + k1 * 16 + n0)] = v; }
}
HD void fft_fwd_p3(LAS cf* buf, int tid, cf (&x)[16]) {
    const int hf = tid >> 8, j = tid & 255;
#pragma unroll
    for (int n0 = 0; n0 < 16; ++n0) x[n0] = buf[fpos(hf, 16 * j + n0)];
    dft16<false>(x);
}
HD void fft_inv_p1(LAS cf* buf, int tid, cf (&x)[16]) {
    const int hf = tid >> 8, j = tid & 255;
    dft16<true>(x);
#pragma unroll
    for (int n0 = 0; n0 < 16; ++n0) buf[fpos(hf, 16 * j + n0)] = x[n0];
}
HD void fft_inv_p2(LAS cf* buf, const LAS cf* TW, int tid) {
    const int hf = tid >> 8, j = tid & 255, k0 = j >> 4, n0 = j & 15; cf x[16];
#pragma unroll
    for (int k1 = 0; k1 < 16; ++k1) { const cf v = buf[fpos(hf, k0 * 256 + k1 * 16 + n0)]; x[k1] = k1 ? cmulc(v, tw8192(TW, 32 * n0 * k1)) : v; }
    dft16<true>(x);
#pragma unroll
    for (int n1 = 0; n1 < 16; ++n1) buf[fpos(hf, k0 * 256 + n1 * 16 + n0)] = x[n1];
}
HD void fft_inv_p3(LAS cf* buf, const LAS cf* TW, int tid) {
    const int hf = tid >> 8, j = tid & 255; cf x[16];
#pragma unroll
    for (int k0 = 0; k0 < 16; ++k0) { const cf v = buf[fpos(hf, k0 * 256 + j)]; x[k0] = k0 ? cmulc(v, tw8192(TW, 2 * j * k0)) : v; }
    dft16<true>(x);
#pragma unroll
    for (int n2 = 0; n2 < 16; ++n2) buf[fpos(hf, n2 * 256 + j)] = x[n2];
}

struct Args { const float* in[34]; float* out; unsigned char* ws; int ph_lo, ph_hi; };
typedef const Args __attribute__((address_space(4)))* ArgsP;
HD ArgsP argp() { ArgsP p = (ArgsP)__builtin_amdgcn_kernarg_segment_ptr(); asm volatile("" : "+s"(p)); return p; }
struct Frame {
    LAS unsigned char* lds; unsigned char* ws; unsigned* ctl;
    int tid, lane, wave, G, gw, NGW;
};
HD Frame mkframe(ArgsP a, LAS unsigned char* lds) {
    Frame F; { unsigned lb = (unsigned)(size_t)lds; asm volatile("" : "+s"(lb)); lds = (LAS unsigned char*)(size_t)lb; }
    int tid = my_tid(lds); asm volatile("" : "+v"(tid));
    F.lds = lds; F.ws = a->ws; F.ctl = (unsigned*)(a->ws + WS_CTL);
    F.tid = tid; F.lane = tid & 63; F.wave = __builtin_amdgcn_readfirstlane(tid >> 6); F.G = gridDim.x; F.gw = blockIdx.x * NWAVES + F.wave; F.NGW = F.G * NWAVES;
    return F;
}
enum { IN_X = 0, IN_LN1G, IN_LN1B, IN_LN2G, IN_LN2B, IN_GWIN, IN_GW2, IN_GGB, IN_GNG, IN_GWOUT, IN_HWIN, IN_HBIN, IN_HCW, IN_HCB, IN_HW1, IN_HB1, IN_HSF, IN_HW2, IN_HB2, IN_HW3, IN_HFB,
       IN_HWOUT, IN_HBOUT, IN_NWIN, IN_NBIN, IN_NRPB, IN_NWOUT, IN_NBOUT, IN_RW, IN_RB, IN_WGU, IN_BGU, IN_WDN, IN_BDN };

HD void transpose_item(const float* W, int Kd, int N, bf16* WT, int item, int mode, LAS float* scr, int lane) {
    const int nblk = N / 32, kb = item / nblk, nb = item % nblk, k0 = 64 * kb, n0 = 32 * nb;
    float stg[32];
#pragma unroll
    for (int i = 0; i < 32; ++i) { const int kk = 2 * i + (lane >> 5); stg[i] = W[(size_t)(k0 + kk) * N + n0 + (lane & 31)]; }
#pragma unroll
    for (int i = 0; i < 32; ++i) { const int kk = 2 * i + (lane >> 5); scr[kk * 33 + (lane & 31)] = stg[i]; }
    LDS_WAIT(); asm volatile("" ::: "memory");
    int r0 = n0;
    if (mode == 1) r0 = (n0 < 1024) ? 256 * (n0 >> 7) + (n0 & 127) : 256 * ((n0 - 1024) >> 7) + 128 + ((n0 - 1024) & 127);
    const int c = lane & 7;
#pragma unroll
    for (int j = 0; j < 4; ++j) { const int n = (lane >> 3) + 8 * j; const LAS float* s = scr + (8 * c) * 33 + n;
        v4u o; o.x = pk2(s[0 * 33], s[1 * 33]); o.y = pk2(s[2 * 33], s[3 * 33]); o.z = pk2(s[4 * 33], s[5 * 33]); o.w = pk2(s[6 * 33], s[7 * 33]);
        *(v4u*)(WT + (size_t)(r0 + n) * Kd + k0 + 8 * c) = o; }
    LDS_WAIT(); asm volatile("" ::: "memory");
}
HD void transpose_item8(const float* W, int N, unsigned char* WT, int item, int mode, float scale, LAS float* scr, int lane) {
    const int nblk = N / 32, kb = item / nblk, nb = item % nblk, k0 = 64 * kb, n0 = 32 * nb;
    float stg[32];
#pragma unroll
    for (int i = 0; i < 32; ++i) { const int kk = 2 * i + (lane >> 5); stg[i] = W[(size_t)(k0 + kk) * N + n0 + (lane & 31)]; }
#pragma unroll
    for (int i = 0; i < 32; ++i) { const int kk = 2 * i + (lane >> 5); scr[kk * 33 + (lane & 31)] = stg[i]; }
    LDS_WAIT(); asm volatile("" ::: "memory");
    int r0 = n0;
    if (mode == 1) r0 = (n0 < 1024) ? 256 * (n0 >> 7) + (n0 & 127) : 256 * ((n0 - 1024) >> 7) + 128 + ((n0 - 1024) & 127);
    const int n = lane >> 1, hh = lane & 1; const LAS float* sp = scr + (32 * hh) * 33 + n;
    v4u o[2];
#pragma unroll
    for (int q = 0; q < 2; ++q)
#pragma unroll
        for (int d = 0; d < 4; ++d) { const int kk = 16 * q + 4 * d; o[q][d] = pk4_fp8(sp[kk * 33] * scale, sp[(kk + 1) * 33] * scale, sp[(kk + 2) * 33] * scale, sp[(kk + 3) * 33] * scale); }
    unsigned char* dst = WT + (size_t)(r0 + n) * 1024 + k0 + 32 * hh;
    *(v4u*)dst = o[0]; *(v4u*)(dst + 16) = o[1];
    LDS_WAIT(); asm volatile("" ::: "memory");
}
HD void p0_prologue(const Frame& F, ArgsP a) {
    LAS float* scr = (LAS float*)(F.lds + F.wave * 16384);
    bf16* wgin = (bf16*)(F.ws + WS_WGIN); bf16* wgout = (bf16*)(F.ws + WS_WGOUT); bf16* whin = (bf16*)(F.ws + WS_WHIN); bf16* whout = (bf16*)(F.ws + WS_WHOUT);
    bf16* wnin = (bf16*)(F.ws + WS_WNIN); bf16* wnout = (bf16*)(F.ws + WS_WNOUT); bf16* wr = (bf16*)(F.ws + WS_WR); unsigned char* wgu = F.ws + WS_WGU; unsigned char* wdn = F.ws + WS_WDN;
    constexpr int I_GIN = 16 * 97, I_SQ = 16 * 32, I_IN3 = 16 * 96, I_R = 16, I_GU = 16 * 64;
    constexpr int NSMALL = 2 * I_GIN + 2 * I_SQ + I_IN3 + I_SQ + I_IN3 + I_SQ + 4 * I_R;
    constexpr int NITEMS = NSMALL + 128 * I_GU + 128 * I_SQ;
    for (int it = F.gw; it < NITEMS; it += F.NGW) {
        int r = it;
        if (r < 2 * I_GIN) { const int j = r / I_GIN; if (FP8_GLA) transpose_item8(a->in[IN_GWIN] + (size_t)j * 1024 * GLA_NIN, GLA_NIN, (unsigned char*)wgin + (size_t)j * GLA_NPAD * 1024, r % I_GIN, 0, 128.f, scr, F.lane); else transpose_item(a->in[IN_GWIN] + (size_t)j * 1024 * GLA_NIN, 1024, GLA_NIN, wgin + (size_t)j * GLA_NPAD * 1024, r % I_GIN, 0, scr, F.lane); continue; } r -= 2 * I_GIN;
        if (r < 2 * I_SQ) { const int j = r / I_SQ; transpose_item(a->in[IN_GWOUT] + (size_t)j * 1024 * 1024, 1024, 1024, wgout + (size_t)j * 1024 * 1024, r % I_SQ, 0, scr, F.lane); continue; } r -= 2 * I_SQ;
        if (r < I_IN3) { if (FP8_HY) transpose_item8(a->in[IN_HWIN], 3072, (unsigned char*)whin, r, 0, 128.f, scr, F.lane); else transpose_item(a->in[IN_HWIN], 1024, 3072, whin, r, 0, scr, F.lane); continue; } r -= I_IN3;
        if (r < I_SQ) { transpose_item(a->in[IN_HWOUT], 1024, 1024, whout, r, 0, scr, F.lane); continue; } r -= I_SQ;
        if (r < I_IN3) { if (FP8_NA) transpose_item8(a->in[IN_NWIN], 3072, (unsigned char*)wnin, r, 0, 128.f, scr, F.lane); else transpose_item(a->in[IN_NWIN], 1024, 3072, wnin, r, 0, scr, F.lane); continue; } r -= I_IN3;
        if (r < I_SQ) { if (FP8_NAOUT) transpose_item8(a->in[IN_NWOUT], 1024, (unsigned char*)wnout, r, 0, 256.f, scr, F.lane); else transpose_item(a->in[IN_NWOUT], 1024, 1024, wnout, r, 0, scr, F.lane); continue; } r -= I_SQ;
        if (r < 4 * I_R) { const int j = r / I_R; transpose_item(a->in[IN_RW] + (size_t)j * 1024 * 32, 1024, 32, wr + (size_t)j * 256 * 1024, r % I_R, 0, scr, F.lane); continue; } r -= 4 * I_R;
        if (r < 128 * I_GU) { const int j = r / I_GU; transpose_item8(a->in[IN_WGU] + (size_t)j * 1024 * 2048, 2048, wgu + (size_t)j * 2048 * 1024, r % I_GU, 1, 128.f, scr, F.lane); continue; } r -= 128 * I_GU;
        { const int j = r / I_SQ; transpose_item8(a->in[IN_WDN] + (size_t)j * 1024 * 1024, 1024, wdn + (size_t)j * 1024 * 1024, r % I_SQ, 0, 256.f, scr, F.lane); }
    }
    { const f32x4* x4 = (const f32x4*)a->in[IN_X]; v2u* o = (v2u*)(F.ws + WS_XAB); unsigned* o8 = (unsigned*)(F.ws + WS_X8);
      for (size_t i = (size_t)blockIdx.x * NT + F.tid; i < (size_t)M * D / 4; i += (size_t)F.G * NT) { const f32x4 v = x4[i];
          if (FP8_GLA) o8[i] = pk4_fp8(v[0] * 16.f, v[1] * 16.f, v[2] * 16.f, v[3] * 16.f); else { v2u w; w.x = pk2(v[0], v[1]); w.y = pk2(v[2], v[3]); o[i] = w; } } }
}
HD void p0_hyena_filters(const Frame& F, ArgsP a) {
    __syncthreads();
    constexpr int TB = 16;
    LAS float* pe = (LAS float*)(F.lds);
    LAS float* h1 = pe + TB * 33 + 16;
    LAS float* h2 = h1 + TB * 64;
    const float* w1 = a->in[IN_HW1]; const float* b1 = a->in[IN_HB1]; const float* sf = a->in[IN_HSF]; const float* w2 = a->in[IN_HW2]; const float* b2 = a->in[IN_HB2]; const float* w3 = a->in[IN_HW3];
    float* hfb = (float*)(F.ws + WS_HFB);
    for (int item = blockIdx.x; item < (SEQ / TB) * 8; item += F.G) {
        const int tb = item >> 3, cb = item & 7, t0 = tb * TB;
        for (int i = F.tid; i < TB * 33; i += NT) { const int tt = i / 33, q = i % 33; const float t = (float)(t0 + tt); float v;
            if (q == 0) v = t / 4095.f;
            else { const int bnd = (q - 1) & 15; const float fr = 1e-4f + (float)bnd * ((15.f - 1e-4f) / 15.f); const float rev = t * fr * (1.f / 4096.f); v = (q <= 16) ? cos_rev(rev) : -sin_rev(rev); }
            pe[tt * 33 + q] = v; }
        __syncthreads();
        { const int tt = F.tid >> 5, j0 = (F.tid & 31) * 2;
#pragma unroll
          for (int q = 0; q < 2; ++q) { const int j = j0 + q; float z = b1[j];
#pragma unroll 1
              for (int i = 0; i < 33; ++i) z += pe[tt * 33 + i] * w1[i * 64 + j];
              h1[tt * 64 + j] = sin_rad(sf[j] * z); } }
        __syncthreads();
        { const int tt = F.tid >> 5, j0 = (F.tid & 31) * 2;
#pragma unroll
          for (int q = 0; q < 2; ++q) { const int j = j0 + q; float z = b2[j];
#pragma unroll 1
              for (int k = 0; k < 64; ++k) z += h1[tt * 64 + k] * w2[k * 64 + j];
              h2[tt * 64 + j] = sin_rad(sf[64 + j] * z); } }
        __syncthreads();
        { const int col = cb * 512 + F.tid; float acc[TB];
#pragma unroll
          for (int tt = 0; tt < TB; ++tt) acc[tt] = 0.f;
#pragma unroll 2
          for (int k = 0; k < 64; ++k) { const float w = w3[(size_t)k * 4096 + col];
#pragma unroll
              for (int tt = 0; tt < TB; ++tt) acc[tt] += h2[tt * 64 + k] * w; }
          const int o = col >> 11, dir = (col >> 10) & 1, d = col & 1023;
          const float delta = 3.0701134573253944f + (float)d * ((15.350567286626972f - 3.0701134573253944f) / 1023.f);
          float* dst = hfb + ((size_t)dir * 2048 + o * 1024 + d) * 4096 + t0;
#pragma unroll
          for (int q = 0; q < TB / 4; ++q) { f32x4 v;
#pragma unroll
              for (int j = 0; j < 4; ++j) { const int tt = 4 * q + j; const float tn = (float)(t0 + tt) / 4095.f; v[j] = acc[tt] * (__expf(-tn * delta) + 0.05f); }
              *(f32x4*)(dst + 4 * q) = v; } }
        __syncthreads();
    }
}
HD void fft_build_tw(const Frame& F) {
    LAS cf* TW = (LAS cf*)(F.lds + FFT_TW_OFF);
    for (int i = F.tid; i < 4096; i += NT) { const float r = (float)i * (1.f / 8192.f); TW[i] = cf_mk(__builtin_amdgcn_cosf(r), -__builtin_amdgcn_sinf(r)); }
    __syncthreads();
}
HD void hyena_filter_fft(const Frame& F) {
    LAS cf* buf = (LAS cf*)F.lds; const LAS cf* TW = (const LAS cf*)(F.lds + FFT_TW_OFF);
    const float* hfb = (const float*)(F.ws + WS_HFB); cf* spec = (cf*)(F.ws + WS_HSPEC);
    fft_build_tw(F);
    for (int od = blockIdx.x; od < 2048; od += F.G) {
        const float* hf = hfb + (size_t)od * 4096; const float* hb = hfb + ((size_t)2048 + od) * 4096;
#pragma unroll
        for (int i = 0; i < 8; ++i) { const int n = F.tid + 512 * i; const float xa = hf[n], xb = (n == 0) ? 0.f : hb[4096 - n];
            buf[fpos(0, n)] = cf_mk(xa + xb, 0.f); buf[fpos(1, n)] = cmul(cf_mk(xa - xb, 0.f), tw8192(TW, n)); }
        __syncthreads();
        fft_fwd_p1(buf, TW, F.tid); __syncthreads();
        fft_fwd_p2(buf, TW, F.tid); __syncthreads();
        { cf x[16]; fft_fwd_p3(buf, F.tid, x); cf* dst = spec + (size_t)od * 8192 + (F.tid >> 8) * 4096 + 16 * (F.tid & 255);
#pragma unroll
          for (int k = 0; k < 8; ++k) *(f32x4*)(dst + 2 * k) = (f32x4){x[2 * k].x, x[2 * k].y, x[2 * k + 1].x, x[2 * k + 1].y}; }
        __syncthreads();
    }
}

struct HyRaw { v4u w; unsigned short lo, hi; };
HD HyRaw hy_raw(const bf16* PT, int c, int b, int j) {
    const bf16* row = PT + (size_t)c * M + (size_t)b * 4096; HyRaw r;
    r.w = *(const v4u*)(row + 8 * j);
    r.lo = row[8 * j - ((j > 0) ? 1 : 0)]; r.hi = row[8 * j + ((j < 511) ? 8 : 7)];
    return r;
}
HD void hy_conv3(const HyRaw& r, int j, int c, const float* cw, const float* cb, float (&u)[8]) {
    float p[10];
    p[0] = (j > 0) ? bflo((unsigned)r.lo) : 0.f; p[9] = (j < 511) ? bflo((unsigned)r.hi) : 0.f;
    p[1] = bflo(r.w.x); p[2] = bfhi(r.w.x); p[3] = bflo(r.w.y); p[4] = bfhi(r.w.y); p[5] = bflo(r.w.z); p[6] = bfhi(r.w.z); p[7] = bflo(r.w.w); p[8] = bfhi(r.w.w);
    const float w0 = cw[c], w1 = cw[3072 + c], w2 = cw[6144 + c], bb = cb[c];
#pragma unroll
    for (int i = 0; i < 8; ++i) u[i] = w0 * p[i] + w1 * p[i + 1] + w2 * p[i + 2] + bb;
}
constexpr int FFT_T1_OFF = FFT_LDS_COMPLEX * 8, FFT_T2_OFF = FFT_T1_OFF + 32768;
static_assert(FFT_T2_OFF + 2048 <= RING_BYTES, "fft lds 2");
HD void fftc_build(const Frame& F) {
    LAS cf* T1 = (LAS cf*)(F.lds + FFT_T1_OFF); LAS cf* T2 = (LAS cf*)(F.lds + FFT_T2_OFF);
    for (int i = F.tid; i < 4096; i += NT) { const int k0 = i >> 8, j = i & 255; const float r = (float)((j * k0) & 4095) * (1.f / 4096.f); T1[i] = cf_mk(__builtin_amdgcn_cosf(r), -__builtin_amdgcn_sinf(r)); }
    for (int i = F.tid; i < 256; i += NT) { const int k1 = i >> 4, n0 = i & 15; const float r = (float)((n0 * k1) & 255) * (1.f / 256.f); T2[i] = cf_mk(__builtin_amdgcn_cosf(r), -__builtin_amdgcn_sinf(r)); }
    __syncthreads();
}
HD cf tw_direct(int n) { const float r = (float)n * (1.f / 8192.f); return cf_mk(__builtin_amdgcn_cosf(r), -__builtin_amdgcn_sinf(r)); }
HD void fftc_fwd_p1(LAS cf* buf, const LAS cf* T1, int tid) {
    const int hf = tid >> 8, j = tid & 255; cf x[16];
#pragma unroll
    for (int n2 = 0; n2 < 16; ++n2) x[n2] = buf[fpos(hf, n2 * 256 + j)];
    dft16<false>(x);
#pragma unroll
    for (int k0 = 0; k0 < 16; ++k0) buf[fpos(hf, k0 * 256 + j)] = k0 ? cmul(x[k0], T1[k0 * 256 + j]) : x[0];
}
HD void fftc_fwd_p2(LAS cf* buf, const LAS cf* T2, int tid) {
    const int hf = tid >> 8, j = tid & 255, k0 = j >> 4, n0 = j & 15; cf x[16];
#pragma unroll
    for (int n1 = 0; n1 < 16; ++n1) x[n1] = buf[fpos(hf, k0 * 256 + n1 * 16 + n0)];
    dft16<false>(x);
#pragma unroll
    for (int k1 = 0; k1 < 16; ++k1) buf[fpos(hf, k0 * 256 + k1 * 16 + n0)] = k1 ? cmul(x[k1], T2[k1 * 16 + n0]) : x[0];
}
HD void fftc_inv_p2(LAS cf* buf, const LAS cf* T2, int tid) {
    const int hf = tid >> 8, j = tid & 255, k0 = j >> 4, n0 = j & 15; cf x[16];
#pragma unroll
    for (int k1 = 0; k1 < 16; ++k1) { const cf v = buf[fpos(hf, k0 * 256 + k1 * 16 + n0)]; x[k1] = k1 ? cmulc(v, T2[k1 * 16 + n0]) : v; }
    dft16<true>(x);
#pragma unroll
    for (int n1 = 0; n1 < 16; ++n1) buf[fpos(hf, k0 * 256 + n1 * 16 + n0)] = x[n1];
}
HD void fftc_inv_p3(LAS cf* buf, const LAS cf* T1, int tid) {
    const int hf = tid >> 8, j = tid & 255; cf x[16];
#pragma unroll
    for (int k0 = 0; k0 < 16; ++k0) { const cf v = buf[fpos(hf, k0 * 256 + j)]; x[k0] = k0 ? cmulc(v, T1[k0 * 256 + j]) : v; }
    dft16<true>(x);
#pragma unroll
    for (int n2 = 0; n2 < 16; ++n2) buf[fpos(hf, n2 * 256 + j)] = x[n2];
}
HD void hy_fftconv(const Frame& F, LAS cf* buf, const LAS cf* T1, const LAS cf* T2, const cf* spec, const float (&in)[2][8], float (&y)[2][8]) {
    int tid = F.tid; asm volatile("" : "+v"(tid));
#pragma unroll
    for (int i = 0; i < 8; ++i) { const int n = 8 * tid + i; const cf c = cf_mk(in[0][i], in[1][i]); buf[fpos(0, n)] = c; buf[fpos(1, n)] = cmul(c, tw_direct(n)); }
    __syncthreads();
    fftc_fwd_p1(buf, T1, tid); __syncthreads();
    f32x4 hv[8];
    { const cf* sp = spec + (tid >> 8) * 4096 + 16 * (tid & 255);
#pragma unroll
      for (int k = 0; k < 8; ++k) hv[k] = *(const f32x4*)(sp + 2 * k); }
    fftc_fwd_p2(buf, T2, tid); __syncthreads();
    { cf x[16]; fft_fwd_p3(buf, tid, x);
#pragma unroll
      for (int k = 0; k < 8; ++k) { x[2 * k] = cmul(x[2 * k], cf_mk(hv[k][0], hv[k][1])); x[2 * k + 1] = cmul(x[2 * k + 1], cf_mk(hv[k][2], hv[k][3])); }
      fft_inv_p1(buf, tid, x); }
    __syncthreads();
    fftc_inv_p2(buf, T2, tid); __syncthreads();
    fftc_inv_p3(buf, T1, tid); __syncthreads();
#pragma unroll
    for (int i = 0; i < 8; ++i) { const int n = 8 * tid + i; const cf E = buf[fpos(0, n)], O = buf[fpos(1, n)]; const cf r = cadd(E, cmulc(O, tw_direct(n)));
        y[0][i] = r.x * (1.f / 8192.f); y[1][i] = r.y * (1.f / 8192.f); }
    __syncthreads();
}
HD void hyena_core(const Frame& F, ArgsP a) {
    LAS cf* buf = (LAS cf*)F.lds; const LAS cf* T1 = (const LAS cf*)(F.lds + FFT_T1_OFF); const LAS cf* T2 = (const LAS cf*)(F.lds + FFT_T2_OFF);
    const bf16* PT = (const bf16*)(F.ws + WS_PT); bf16* OT = (bf16*)(F.ws + WS_OUTT); const cf* spec = (const cf*)(F.ws + WS_HSPEC);
    const float* cw = a->in[IN_HCW]; const float* cb = a->in[IN_HCB]; const float* fb = a->in[IN_HFB];
    fftc_build(F);
    const int per = (8192 + F.G - 1) / F.G;
    const int it0 = blockIdx.x * per, it1 = min((blockIdx.x + 1) * per, 8192);
    HyRaw rv[2];
    if (it0 < it1) { rv[0] = hy_raw(PT, it0 >> 3, 2 * (it0 & 7), F.tid); rv[1] = hy_raw(PT, it0 >> 3, 2 * (it0 & 7) + 1, F.tid); }
    for (int it = it0; it < it1; ++it) {
        const int d = it >> 3, bp = it & 7, b0 = 2 * bp;
        float v[2][8], y[2][8], z[2][8], g[2][8];
        HyRaw r1[2]; r1[0] = hy_raw(PT, 1024 + d, b0, F.tid); r1[1] = hy_raw(PT, 1024 + d, b0 + 1, F.tid);
        hy_conv3(rv[0], F.tid, d, cw, cb, v[0]); hy_conv3(rv[1], F.tid, d, cw, cb, v[1]);
        hy_fftconv(F, buf, T1, T2, spec + (size_t)d * 8192, v, y);
        HyRaw r2[2]; r2[0] = hy_raw(PT, 2048 + d, b0, F.tid); r2[1] = hy_raw(PT, 2048 + d, b0 + 1, F.tid);
        { const int itn = (it + 1 < it1) ? it + 1 : it; const int dn = itn >> 3, bn = 2 * (itn & 7); rv[0] = hy_raw(PT, dn, bn, F.tid); rv[1] = hy_raw(PT, dn, bn + 1, F.tid); }
        hy_conv3(r1[0], F.tid, 1024 + d, cw, cb, g[0]); hy_conv3(r1[1], F.tid, 1024 + d, cw, cb, g[1]);
        const float fb0 = fb[d], fb1 = fb[1024 + d];
#pragma unroll
        for (int b = 0; b < 2; ++b)
#pragma unroll
            for (int i = 0; i < 8; ++i) z[b][i] = g[b][i] * (y[b][i] + v[b][i] * fb0);
        hy_fftconv(F, buf, T1, T2, spec + (size_t)(1024 + d) * 8192, z, y);
        hy_conv3(r2[0], F.tid, 2048 + d, cw, cb, g[0]); hy_conv3(r2[1], F.tid, 2048 + d, cw, cb, g[1]);
#pragma unroll
        for (int b = 0; b < 2; ++b) { float o[8];
#pragma unroll
            for (int i = 0; i < 8; ++i) o[i] = g[b][i] * (y[b][i] + z[b][i] * fb1);
            v4u w; w.x = pk2(o[0], o[1]); w.y = pk2(o[2], o[3]); w.z = pk2(o[4], o[5]); w.w = pk2(o[6], o[7]);
            *(v4u*)(OT + (size_t)d * M + (size_t)(b0 + b) * 4096 + 8 * F.tid) = w; }
    }
}
HD void hyena_transpose(const Frame& F, int t_first, int t_end, int t_step) {
    LAS unsigned char* scr = F.lds + F.wave * 8704;
    const bf16* OT = (const bf16*)(F.ws + WS_OUTT); bf16* AB = (bf16*)(F.ws + WS_AB);
    const int lane = F.lane;
    v4u wq[8];
    { const int tile = (t_first < t_end) ? t_first : 0; const int d0 = (tile & 15) * 64, m0 = (tile >> 4) * 64;
#pragma unroll
      for (int r = 0; r < 8; ++r) { const int dd = r * 8 + (lane >> 3), ch = lane & 7; wq[r] = *(const v4u*)(OT + (size_t)(d0 + dd) * M + m0 + 8 * ch); } }
    for (int tile = t_first; tile < t_end; tile += t_step) {
        const int dt = tile & 15, tt = tile >> 4, d0 = dt * 64, m0 = tt * 64;
#pragma unroll
        for (int r = 0; r < 8; ++r) { const int dd = r * 8 + (lane >> 3), ch = lane & 7; const v4u w = wq[r];
            LAS v2u* p = (LAS v2u*)(scr + dd * 136 + ch * 16); p[0] = (v2u){w.x, w.y}; p[1] = (v2u){w.z, w.w}; }
        { const int tn = (tile + t_step < t_end) ? tile + t_step : tile; const int dn = (tn & 15) * 64, mn = (tn >> 4) * 64;
#pragma unroll
          for (int r = 0; r < 8; ++r) { const int dd = r * 8 + (lane >> 3), ch = lane & 7; wq[r] = *(const v4u*)(OT + (size_t)(dn + dd) * M + mn + 8 * ch); } }
        LDS_WAIT(); asm volatile("" ::: "memory");
#pragma unroll
        for (int r = 0; r < 8; ++r) { const int tk = r * 8 + (lane >> 3), ch = lane & 7; unsigned e[8];
#pragma unroll
            for (int i = 0; i < 8; ++i) e[i] = *(const LAS unsigned short*)(scr + (ch * 8 + i) * 136 + tk * 2);
            v4u w; w.x = e[0] | (e[1] << 16); w.y = e[2] | (e[3] << 16); w.z = e[4] | (e[5] << 16); w.w = e[6] | (e[7] << 16);
            *(v4u*)(AB + (size_t)(m0 + tk) * 1024 + d0 + 8 * ch) = w; }
        LDS_WAIT(); asm volatile("" ::: "memory");
    }
}

HD void gla_scan_naive(const Frame& F, ArgsP a, int j) {
    constexpr int CH = 32;
    LAS float* qs = (LAS float*)F.lds;
    LAS float* ks = qs + CH * 128;
    LAS float* as = ks + CH * 128;
    LAS float* vs = as + CH * 128;
    const bf16* QK = (const bf16*)(F.ws + WS_QKVG); const float* glow = (const float*)(F.ws + WS_GLOW);
    const float* gw2 = a->in[IN_GW2] + (size_t)j * 2 * 16 * 512; const float* gb = a->in[IN_GGB] + (size_t)j * 2 * 512;
    const int e = F.tid >> 1, half = F.tid & 1;
    for (int item = blockIdx.x; item < 128; item += F.G) {
        const int dir = item & 1, h = (item >> 1) & 3, b = item >> 3;
        bf16* O = (bf16*)(F.ws + (dir ? WS_OB : WS_OF));
        f32x2 S[32];
#pragma unroll
        for (int i = 0; i < 32; ++i) S[i] = (f32x2){0.f, 0.f};
        for (int cc = 0; cc < SEQ / CH; ++cc) {
            const int c = dir ? (SEQ / CH - 1 - cc) : cc; const int mbase = b * SEQ + c * CH;
            __syncthreads();
            for (int i = F.tid; i < CH * 128; i += NT) { const int tt = i >> 7, dd = i & 127; const size_t m = (size_t)(mbase + tt);
                qs[i] = bf2f(QK[m * 3072 + h * 128 + dd]); ks[i] = bf2f(QK[m * 3072 + 512 + h * 128 + dd]);
                float lg = gb[dir * 512 + h * 128 + dd]; const float* gl = glow + m * 32 + dir * 16;
#pragma unroll
                for (int r = 0; r < 16; ++r) lg += gl[r] * gw2[(dir * 16 + r) * 512 + h * 128 + dd];
                const float ls = fminf(lg, 0.f) - log1pf(expf(-fabsf(lg)));
                as[i] = expf(ls * (1.f / 16.f)); }
            for (int i = F.tid; i < CH * 256; i += NT) { const int tt = i >> 8, ee = i & 255; vs[i] = bf2f(QK[(size_t)(mbase + tt) * 3072 + 1024 + h * 256 + ee]); }
            __syncthreads();
            for (int s = 0; s < CH; ++s) {
                const int tt = dir ? (CH - 1 - s) : s;
                const LAS f32x2* q2 = (const LAS f32x2*)(qs + tt * 128 + half * 64); const LAS f32x2* k2 = (const LAS f32x2*)(ks + tt * 128 + half * 64); const LAS f32x2* a2 = (const LAS f32x2*)(as + tt * 128 + half * 64);
                const float ve = vs[tt * 256 + e];
                f32x2 o2 = (f32x2){0.f, 0.f};
                if (dir) {
#pragma unroll
                    for (int i = 0; i < 32; ++i) { S[i] = S[i] * a2[i]; o2 += q2[i] * S[i]; S[i] += k2[i] * ve; }
                } else {
#pragma unroll
                    for (int i = 0; i < 32; ++i) { S[i] = S[i] * a2[i] + k2[i] * ve; o2 += q2[i] * S[i]; }
                }
                float o = o2[0] + o2[1]; o += __shfl_xor(o, 1);
                if (half == 0) O[(size_t)(mbase + tt) * 1024 + h * 256 + e] = (bf16)f2bf(o);
            }
        }
    }
}
HD void gla_prep(const Frame& F, ArgsP a, int j) {
    LAS unsigned short* QR = (LAS unsigned short*)F.lds;
    LAS unsigned short* KR = QR + 64 * 512;
    LAS float* GL = (LAS float*)(F.lds + 139264);
    static_assert(139264 >= LDS_TEXP + MAXTILES * 2 && 139264 + 8192 <= LDS_BYTES, "gla prep lds");
    const bf16* QK = (const bf16*)(F.ws + WS_QKVG); const float* glow = (const float*)(F.ws + WS_GLOW);
    bf16* QT2 = (bf16*)(F.ws + WS_QT2); bf16* KT2 = (bf16*)(F.ws + WS_KT2); float* GS2 = (float*)(F.ws + WS_GS2);
    const float* gw2 = a->in[IN_GW2] + (size_t)j * 2 * 16 * 512; const float* gb = a->in[IN_GGB] + (size_t)j * 2 * 512;
    const int d = F.tid;
    float w2[2][16], gbv[2];
#pragma unroll
    for (int dir = 0; dir < 2; ++dir) { gbv[dir] = gb[dir * 512 + d];
#pragma unroll
        for (int r = 0; r < 16; ++r) w2[dir][r] = gw2[(dir * 16 + r) * 512 + d]; }
    v4u rq[8], rk[8]; f32x4 rgl;
    { const int it0 = (blockIdx.x < NB * 64) ? (int)blockIdx.x : 0; const size_t mb = (size_t)it0 * 64;
      rgl = *(const f32x4*)(glow + mb * 32 + 4 * F.tid);
#pragma unroll
      for (int i = 0; i < 8; ++i) { const int p = F.tid + 512 * i, t = p >> 6, ch = p & 63; rq[i] = *(const v4u*)(QK + (mb + t) * 3072 + 8 * ch); rk[i] = *(const v4u*)(QK + (mb + t) * 3072 + 512 + 8 * ch); } }
    for (int item = blockIdx.x; item < NB * 64; item += F.G) {
        const size_t mbase = (size_t)item * 64;
        __syncthreads();
        *(LAS f32x4*)(GL + 4 * F.tid) = rgl;
#pragma unroll
        for (int i = 0; i < 8; ++i) { const int p = F.tid + 512 * i, t = p >> 6, ch = p & 63;
            *(LAS v4u*)(QR + t * 512 + 8 * ch) = rq[i];
            *(LAS v4u*)(KR + t * 512 + 8 * ch) = rk[i]; }
        __syncthreads();
        { const int itn = (item + F.G < NB * 64) ? item + F.G : item; const size_t mb = (size_t)itn * 64;
          rgl = *(const f32x4*)(glow + mb * 32 + 4 * F.tid);
#pragma unroll
          for (int i = 0; i < 8; ++i) { const int p = F.tid + 512 * i, t = p >> 6, ch = p & 63; rq[i] = *(const v4u*)(QK + (mb + t) * 3072 + 8 * ch); rk[i] = *(const v4u*)(QK + (mb + t) * 3072 + 512 + 8 * ch); } }
#pragma unroll
        for (int dir = 0; dir < 2; ++dir) {
            float run = 0.f;
#pragma unroll 1
            for (int s0 = 0; s0 < 64; s0 += 4) {
                f32x4 gvv[4][4]; unsigned short qr[4], kr[4];
                const int tlo = dir ? 60 - s0 : s0;
                unsigned ga = (unsigned)(size_t)(GL + tlo * 32 + dir * 16); asm volatile("" : "+v"(ga));
                const LAS f32x4* gb = (const LAS f32x4*)(size_t)ga; const LAS unsigned short* qb = QR + tlo * 512 + d; const LAS unsigned short* kb = KR + tlo * 512 + d;
#pragma unroll
                for (int u = 0; u < 4; ++u) { const int o = dir ? 3 - u : u;
#pragma unroll
                    for (int q4 = 0; q4 < 4; ++q4) gvv[u][q4] = gb[o * 8 + q4];
                    qr[u] = qb[o * 512]; kr[u] = kb[o * 512]; }
                __builtin_amdgcn_sched_barrier(0);
#pragma unroll
                for (int u = 0; u < 4; ++u) { const int t = dir ? 63 - (s0 + u) : s0 + u; float lg = gbv[dir];
#pragma unroll
                    for (int q4 = 0; q4 < 4; ++q4) { const f32x4 gv = gvv[u][q4];
                        lg = __builtin_fmaf(gv[0], w2[dir][4 * q4], lg); lg = __builtin_fmaf(gv[1], w2[dir][4 * q4 + 1], lg); lg = __builtin_fmaf(gv[2], w2[dir][4 * q4 + 2], lg); lg = __builtin_fmaf(gv[3], w2[dir][4 * q4 + 3], lg); }
                    const float sp = __builtin_amdgcn_logf(1.f + __builtin_amdgcn_exp2f(-1.4426950408889634f * fabsf(lg))) * 0.6931471805599453f;
                    run += (fminf(lg, 0.f) - sp) * (1.f / 16.f);
                    const float r2 = run * 1.4426950408889634f; const float ex = __builtin_amdgcn_exp2f(r2), exn = __builtin_amdgcn_exp2f(-r2);
                    const size_t m = mbase + t; const float q = bf2f(qr[u]), k = bf2f(kr[u]);
                    const unsigned qk = pk2(q * ex, k * exn); QT2[((size_t)dir * M + m) * 512 + d] = (bf16)(qk & 0xffffu); KT2[((size_t)dir * M + m) * 512 + d] = (bf16)(qk >> 16); } }
            GS2[((size_t)dir * 1024 + item) * 512 + d] = __expf(run);
        }
    }
}
HD s16x4 tr16(const LAS unsigned char* p) { return __builtin_amdgcn_ds_read_tr16_b64_v4i16((LAS s16x4*)p); }
HD bf16x8 cat8(s16x4 a, s16x4 b) { return (bf16x8){a[0], a[1], a[2], a[3], b[0], b[1], b[2], b[3]}; }
HD void gla_scan_mfma(const Frame& F, ArgsP a, int j) {
    constexpr int PQ = 272, PV = 288;
    constexpr int OFF_QT = 0, OFF_KT = OFF_QT + 64 * PQ, OFF_V = OFF_KT + 64 * PQ, OFF_ST = OFF_V + 64 * PV, OFF_GS = OFF_ST + 128 * PQ;
    static_assert(OFF_GS + 512 <= RING_BYTES, "gla lds");
    LAS unsigned char* const QT = F.lds + OFF_QT; LAS unsigned char* const KT = F.lds + OFF_KT; LAS unsigned char* const VL = F.lds + OFF_V; LAS unsigned char* const ST = F.lds + OFF_ST;
    LAS float* const GS = (LAS float*)(F.lds + OFF_GS);
    const bf16* QK = (const bf16*)(F.ws + WS_QKVG); const bf16* QT2 = (const bf16*)(F.ws + WS_QT2); const bf16* KT2 = (const bf16*)(F.ws + WS_KT2); const float* GS2 = (const float*)(F.ws + WS_GS2);
    const int tid = F.tid, lane = F.lane, w = F.wave, g = lane >> 4, l15 = lane & 15, tq = l15 >> 2, tp = l15 & 3;
    for (int item = blockIdx.x; item < 256; item += F.G) {
        const int dir = item & 1, sl = (item >> 1) & 1, h = (item >> 2) & 3, b = item >> 4;
        bf16* Og = (bf16*)(F.ws + (dir ? WS_OB : WS_OF));
        const bf16* Qd = QT2 + (size_t)dir * M * 512 + h * 128; const bf16* Kd = KT2 + (size_t)dir * M * 512 + h * 128; const float* Gd = GS2 + (size_t)dir * 1024 * 512 + h * 128;
        f32x4 Sacc[8];
#pragma unroll
        for (int et = 0; et < 8; ++et) Sacc[et] = (f32x4){0.f, 0.f, 0.f, 0.f};
        const int pt0 = tid >> 4, pch = tid & 15;
        v4u rq[2], rk[2], rv[2]; f32x4 rg = (f32x4){0.f, 0.f, 0.f, 0.f};
        {   const int c = dir ? 63 : 0; const size_t mb = (size_t)b * SEQ + c * 64;
#pragma unroll
            for (int i = 0; i < 2; ++i) { const size_t m = mb + pt0 + 32 * i; rq[i] = *(const v4u*)(Qd + m * 512 + 8 * pch); rk[i] = *(const v4u*)(Kd + m * 512 + 8 * pch); rv[i] = *(const v4u*)(QK + m * 3072 + 1024 + h * 256 + sl * 128 + 8 * pch); }
            if (tid < 32) rg = *(const f32x4*)(Gd + (size_t)(b * 64 + c) * 512 + 4 * tid); }
        for (int cc = 0; cc < 64; ++cc) {
            const int c = dir ? 63 - cc : cc; const size_t mbase = (size_t)b * SEQ + c * 64;
#pragma unroll
            for (int i = 0; i < 2; ++i) { const int t = pt0 + 32 * i; *(LAS v4u*)(QT + t * PQ + 16 * pch) = rq[i]; *(LAS v4u*)(KT + t * PQ + 16 * pch) = rk[i]; *(LAS v4u*)(VL + t * PV + 16 * pch) = rv[i]; }
            if (tid < 32) *(LAS f32x4*)(GS + 4 * tid) = rg;
#pragma unroll
            for (int et = 0; et < 8; ++et) { v2u pw; pw.x = pk2(Sacc[et][0], Sacc[et][1]); pw.y = pk2(Sacc[et][2], Sacc[et][3]); *(LAS v2u*)(ST + (16 * et + l15) * PQ + (16 * w + 4 * g) * 2) = pw; }
            __syncthreads();
            if (cc + 1 < 64) { const int cn = dir ? 62 - cc : cc + 1; const size_t mb = (size_t)b * SEQ + cn * 64;
#pragma unroll
                for (int i = 0; i < 2; ++i) { const size_t m = mb + pt0 + 32 * i; rq[i] = *(const v4u*)(Qd + m * 512 + 8 * pch); rk[i] = *(const v4u*)(Kd + m * 512 + 8 * pch); rv[i] = *(const v4u*)(QK + m * 3072 + 1024 + h * 256 + sl * 128 + 8 * pch); }
                if (tid < 32) rg = *(const f32x4*)(Gd + (size_t)(b * 64 + cn) * 512 + 4 * tid); }
            {   const int it = w & 3, eg = w >> 2;
                bf16x8 Bq[4], Kfr[16];
#pragma unroll
                for (int ks = 0; ks < 4; ++ks) Bq[ks] = *(const LAS bf16x8*)(QT + (16 * it + l15) * PQ + ks * 64 + g * 16);
#pragma unroll
                for (int jt = 0; jt < 4; ++jt)
#pragma unroll
                    for (int ks = 0; ks < 4; ++ks) Kfr[jt * 4 + ks] = *(const LAS bf16x8*)(KT + (16 * jt + l15) * PQ + ks * 64 + g * 16);
                __builtin_amdgcn_sched_barrier(0);
                s16x4 pk[4];
#pragma unroll
                for (int jt = 0; jt < 4; ++jt) { f32x4 acc = (f32x4){0.f, 0.f, 0.f, 0.f};
#pragma unroll
                    for (int ks = 0; ks < 4; ++ks) acc = __builtin_amdgcn_mfma_f32_16x16x32_bf16(Kfr[jt * 4 + ks], Bq[ks], acc, 0, 0, 0);
                    const int ii = 16 * it + l15;
#pragma unroll
                    for (int r = 0; r < 4; ++r) { const int jj = 16 * jt + 4 * g + r; const bool keep = dir ? (jj > ii) : (jj <= ii); acc[r] = keep ? acc[r] : 0.f; }
                    const unsigned p0 = pk2(acc[0], acc[1]), p1 = pk2(acc[2], acc[3]);
                    pk[jt] = (s16x4){(short)(p0 & 0xffff), (short)(p0 >> 16), (short)(p1 & 0xffff), (short)(p1 >> 16)}; }
                const bf16x8 Bp0 = cat8(pk[0], pk[1]), Bp1 = cat8(pk[2], pk[3]);
                bf16x8 Avf[4][2], Asf[4][4];
#pragma unroll
                for (int e4 = 0; e4 < 4; ++e4) { const int et = 4 * eg + e4;
                    Avf[e4][0] = cat8(tr16(VL + (0 + 4 * g + tq) * PV + (16 * et + 4 * tp) * 2), tr16(VL + (16 + 4 * g + tq) * PV + (16 * et + 4 * tp) * 2));
                    Avf[e4][1] = cat8(tr16(VL + (32 + 4 * g + tq) * PV + (16 * et + 4 * tp) * 2), tr16(VL + (48 + 4 * g + tq) * PV + (16 * et + 4 * tp) * 2));
#pragma unroll
                    for (int ks = 0; ks < 4; ++ks) Asf[e4][ks] = *(const LAS bf16x8*)(ST + (16 * et + l15) * PQ + ks * 64 + g * 16); }
                __builtin_amdgcn_sched_barrier(0);
#pragma unroll
                for (int e4 = 0; e4 < 4; ++e4) { const int et = 4 * eg + e4; f32x4 acc = (f32x4){0.f, 0.f, 0.f, 0.f};
                    acc = __builtin_amdgcn_mfma_f32_16x16x32_bf16(Avf[e4][0], Bp0, acc, 0, 0, 0);
                    acc = __builtin_amdgcn_mfma_f32_16x16x32_bf16(Avf[e4][1], Bp1, acc, 0, 0, 0);
#pragma unroll
                    for (int ks = 0; ks < 4; ++ks) acc = __builtin_amdgcn_mfma_f32_16x16x32_bf16(Asf[e4][ks], Bq[ks], acc, 0, 0, 0);
                    { v2u ow; ow.x = pk2(acc[0], acc[1]); ow.y = pk2(acc[2], acc[3]); *(v2u*)(Og + (mbase + 16 * it + l15) * 1024 + h * 256 + sl * 128 + 16 * et + 4 * g) = ow; } }
                bf16x8 Ak[2];
#pragma unroll
                for (int k2 = 0; k2 < 2; ++k2) Ak[k2] = cat8(tr16(KT + (32 * k2 + 8 * g + tq) * PQ + (16 * w + 4 * tp) * 2), tr16(KT + (32 * k2 + 8 * g + 4 + tq) * PQ + (16 * w + 4 * tp) * 2));
                const f32x4 gs = *(const LAS f32x4*)(GS + 16 * w + 4 * g);
                bf16x8 Bvf[8][2];
#pragma unroll
                for (int et = 0; et < 8; ++et)
#pragma unroll
                    for (int k2 = 0; k2 < 2; ++k2) Bvf[et][k2] = cat8(tr16(VL + (32 * k2 + 8 * g + tq) * PV + (16 * et + 4 * tp) * 2), tr16(VL + (32 * k2 + 8 * g + 4 + tq) * PV + (16 * et + 4 * tp) * 2));
                __builtin_amdgcn_sched_barrier(0);
#pragma unroll
                for (int et = 0; et < 8; ++et) {
#pragma unroll
                    for (int k2 = 0; k2 < 2; ++k2) Sacc[et] = __builtin_amdgcn_mfma_f32_16x16x32_bf16(Ak[k2], Bvf[et][k2], Sacc[et], 0, 0, 0);
                    Sacc[et] = Sacc[et] * gs; }
            }
            __syncthreads();
        }
    }
}
HD void unpack8(const v4u w, float (&f)[8]) { f[0] = bflo(w.x); f[1] = bfhi(w.x); f[2] = bflo(w.y); f[3] = bfhi(w.y); f[4] = bflo(w.z); f[5] = bfhi(w.z); f[6] = bflo(w.w); f[7] = bfhi(w.w); }
HD v4u pack8f(const float (&f)[8]) { v4u w; w.x = pk2(f[0], f[1]); w.y = pk2(f[2], f[3]); w.z = pk2(f[4], f[5]); w.w = pk2(f[6], f[7]); return w; }
HD void unpack8_fp8(const v2u w, float (&f)[8]) {
    f[0] = __builtin_amdgcn_cvt_f32_fp8((int)w.x, 0); f[1] = __builtin_amdgcn_cvt_f32_fp8((int)w.x, 1); f[2] = __builtin_amdgcn_cvt_f32_fp8((int)w.x, 2); f[3] = __builtin_amdgcn_cvt_f32_fp8((int)w.x, 3);
    f[4] = __builtin_amdgcn_cvt_f32_fp8((int)w.y, 0); f[5] = __builtin_amdgcn_cvt_f32_fp8((int)w.y, 1); f[6] = __builtin_amdgcn_cvt_f32_fp8((int)w.y, 2); f[7] = __builtin_amdgcn_cvt_f32_fp8((int)w.y, 3);
}
HD float half_sum(float v) {
#pragma unroll
    for (int o = 1; o < 32; o <<= 1) v += __shfl_xor(v, o);
    return v;
}
HD void gla_gate(const Frame& F, ArgsP a, int j, int m_first, int m_end, int m_step) {
    const bf16* OFp = (const bf16*)(F.ws + WS_OF); const bf16* OBp = (const bf16*)(F.ws + WS_OB); const bf16* QK = (const bf16*)(F.ws + WS_QKVG); bf16* AB = (bf16*)(F.ws + WS_AB);
    float ng[8];
    { const float* np = a->in[IN_GNG] + (size_t)j * 256 + 8 * (F.lane & 31); const f32x4 n0 = *(const f32x4*)np, n1 = *(const f32x4*)(np + 4); ng[0] = n0[0]; ng[1] = n0[1]; ng[2] = n0[2]; ng[3] = n0[3]; ng[4] = n1[0]; ng[5] = n1[1]; ng[6] = n1[2]; ng[7] = n1[3]; }
#pragma unroll 2
    for (int m = m_first; m < m_end; m += m_step) {
        v4u fw[2], bw[2], gw_[2];
#pragma unroll
        for (int c = 0; c < 2; ++c) { const size_t off = (size_t)m * 1024 + 512 * c + 8 * F.lane; fw[c] = *(const v4u*)(OFp + off); bw[c] = *(const v4u*)(OBp + off); gw_[c] = *(const v4u*)(QK + (size_t)m * 3072 + 2048 + 512 * c + 8 * F.lane); }
#pragma unroll
        for (int c = 0; c < 2; ++c) {
            float f[8], b[8], g[8], r[8]; unpack8(fw[c], f); unpack8(bw[c], b); unpack8(gw_[c], g);
            float ss = 0.f;
#pragma unroll
            for (int i = 0; i < 8; ++i) { f[i] += b[i]; ss += f[i] * f[i]; }
            const float rs = 1.f / sqrtf(half_sum(ss) * (1.f / 256.f) + 1e-6f);
#pragma unroll
            for (int i = 0; i < 8; ++i) { const float sg = g[i] * __builtin_amdgcn_rcpf(1.f + __expf(-g[i])); r[i] = (f[i] * rs * ng[i]) * sg; }
            *(v4u*)(AB + (size_t)m * 1024 + 512 * c + 8 * F.lane) = pack8f(r);
        }
    }
}

HD void na_attn_naive(const Frame& F, ArgsP a) {
    const bf16* QH = (const bf16*)(F.ws + WS_QH); const bf16* KH = (const bf16*)(F.ws + WS_KH); const bf16* VH = (const bf16*)(F.ws + WS_VH); bf16* AB = (bf16*)(F.ws + WS_AB);
    const float* rpb = a->in[IN_NRPB];
    for (int item = F.gw; item < NB * 32 * 64; item += F.NGW) {
        const int r = item & 63, h = (item >> 6) & 31, b = item >> 11, c = F.lane;
        const size_t hb = (size_t)(b * 32 + h) * 4096;
        float q[32];
        { const v4u* qp = (const v4u*)(QH + (hb + r * 64 + c) * 32);
#pragma unroll
          for (int i = 0; i < 4; ++i) { const v4u w = qp[i]; q[8 * i] = bflo(w.x); q[8 * i + 1] = bfhi(w.x); q[8 * i + 2] = bflo(w.y); q[8 * i + 3] = bfhi(w.y); q[8 * i + 4] = bflo(w.z); q[8 * i + 5] = bfhi(w.z); q[8 * i + 6] = bflo(w.w); q[8 * i + 7] = bfhi(w.w); } }
        const int rs = min(max(r - 4, 0), 56), cs = min(max(c - 8, 0), 48);
        float mx = -3.0e38f, sum = 0.f, o[32];
#pragma unroll
        for (int i = 0; i < 32; ++i) o[i] = 0.f;
        for (int kr = 0; kr < 8; ++kr)
            for (int kc = 0; kc < 16; ++kc) {
                const int krow = rs + kr, kcol = cs + kc; const size_t kt = hb + krow * 64 + kcol;
                const v4u* kp = (const v4u*)(KH + kt * 32); float s = 0.f;
#pragma unroll
                for (int i = 0; i < 4; ++i) { const v4u w = kp[i];
                    s += q[8 * i] * bflo(w.x) + q[8 * i + 1] * bfhi(w.x) + q[8 * i + 2] * bflo(w.y) + q[8 * i + 3] * bfhi(w.y) + q[8 * i + 4] * bflo(w.z) + q[8 * i + 5] * bfhi(w.z) + q[8 * i + 6] * bflo(w.w) + q[8 * i + 7] * bfhi(w.w); }
                s += rpb[(h * 15 + (krow - r + 7)) * 31 + (kcol - c + 15)];
                const float mn = fmaxf(mx, s), sc = __expf(mx - mn), p = __expf(s - mn); mx = mn; sum = sum * sc + p;
                const v4u* vp = (const v4u*)(VH + kt * 32);
#pragma unroll
                for (int i = 0; i < 4; ++i) { const v4u w = vp[i];
                    o[8 * i] = o[8 * i] * sc + p * bflo(w.x); o[8 * i + 1] = o[8 * i + 1] * sc + p * bfhi(w.x); o[8 * i + 2] = o[8 * i + 2] * sc + p * bflo(w.y); o[8 * i + 3] = o[8 * i + 3] * sc + p * bfhi(w.y);
                    o[8 * i + 4] = o[8 * i + 4] * sc + p * bflo(w.z); o[8 * i + 5] = o[8 * i + 5] * sc + p * bfhi(w.z); o[8 * i + 6] = o[8 * i + 6] * sc + p * bflo(w.w); o[8 * i + 7] = o[8 * i + 7] * sc + p * bfhi(w.w); }
            }
        const float inv = 1.f / sum;
        v4u* op = (v4u*)(AB + ((size_t)b * 4096 + r * 64 + c) * 1024 + h * 32);
#pragma unroll
        for (int i = 0; i < 4; ++i) { v4u w; w.x = pk2(o[8 * i] * inv, o[8 * i + 1] * inv); w.y = pk2(o[8 * i + 2] * inv, o[8 * i + 3] * inv); w.z = pk2(o[8 * i + 4] * inv, o[8 * i + 5] * inv); w.w = pk2(o[8 * i + 6] * inv, o[8 * i + 7] * inv); op[i] = w; }
    }
}

HD void na_attn_mfma(const Frame& F, ArgsP a) {
    constexpr int OFF_RPB = 15 * 64 * 64;
    static_assert(OFF_RPB + 2048 <= RING_BYTES, "na lds");
    LAS unsigned char* const VL = F.lds; LAS float* const RP = (LAS float*)(F.lds + OFF_RPB);
    const bf16* QH = (const bf16*)(F.ws + WS_QH); const bf16* KH = (const bf16*)(F.ws + WS_KH); const bf16* VH = (const bf16*)(F.ws + WS_VH); bf16* AB = (bf16*)(F.ws + WS_AB);
    const float* rpb = a->in[IN_NRPB];
    const int tid = F.tid, lane = F.lane, w = F.wave, g = lane >> 4, l15 = lane & 15, tq = l15 >> 2, tp = l15 & 3;
    bf16x8 Kf[16], Bqn;
    auto ldk = [&](int item_, int cb_) {
        const int rg_ = item_ & 7, h_ = (item_ >> 3) & 31, b_ = item_ >> 8; const size_t hb_ = (size_t)(b_ * 32 + h_) * 4096;
        const int r_ = 8 * rg_ + w, rs_ = min(max(r_ - 4, 0), 56), bs_ = min(max(16 * cb_ - 8, 0), 32), qc_ = 16 * cb_ + l15;
        Bqn = *(const bf16x8*)(QH + (hb_ + r_ * 64 + qc_) * 32 + 8 * g);
#pragma unroll
        for (int t = 0; t < 16; ++t) { const int kr = t >> 1, kc0 = bs_ + 16 * (t & 1); Kf[t] = *(const bf16x8*)(KH + (hb_ + (rs_ + kr) * 64 + kc0 + l15) * 32 + 8 * g); }
    };
    { const int it0 = (blockIdx.x < NB * 32 * 8) ? (int)blockIdx.x : 0; ldk(it0, 0); }
    v2u pend[2]; pend[0] = (v2u){0u, 0u}; pend[1] = pend[0]; size_t pidx = 0; bool hasp = false;
    auto flush = [&]() {
#pragma unroll
        for (int dt = 0; dt < 2; ++dt) {
            if (FP8_NAOUT) *(unsigned*)((unsigned char*)AB + pidx + 16 * dt) = pend[dt].x;
            else *(v2u*)(AB + pidx + 16 * dt) = pend[dt]; }
    };
    for (int item = blockIdx.x; item < NB * 32 * 8; item += F.G) {
        const int rg = item & 7, h = (item >> 3) & 31, b = item >> 8, r0 = 8 * rg;
        const size_t hb = (size_t)(b * 32 + h) * 4096;
        const int klo = min(max(r0 - 4, 0), 56), khi = min(max(r0 + 3, 0), 56) + 7, nrows = khi - klo + 1;
        __syncthreads();
        { const v4u* src = (const v4u*)(VH + (hb + (size_t)klo * 64) * 32); const int npc = nrows * 256;
          v4u vv[8];
#pragma unroll
          for (int i = 0; i < 8; ++i) { const int p = tid + NT * i; vv[i] = src[p < npc ? p : npc - 1]; }
          const float rpv = rpb[h * 465 + (tid < 465 ? tid : 464)];
          __builtin_amdgcn_sched_barrier(0);
#pragma unroll
          for (int i = 0; i < 8; ++i) { const int p = tid + NT * i; if (p < npc) *(LAS v4u*)(VL + p * 16) = vv[i]; }
          if (tid < 465) RP[tid] = rpv; }
        __syncthreads();
        const int r = r0 + w, rs = min(max(r - 4, 0), 56);
#pragma unroll 1
        for (int cb = 0; cb < 4; ++cb) {
            const int bs = min(max(16 * cb - 8, 0), 32), qc = 16 * cb + l15, cs = min(max(qc - 8, 0), 48);
            f32x4 sc[16];
#pragma unroll
            for (int t = 0; t < 16; ++t) sc[t] = __builtin_amdgcn_mfma_f32_16x16x32_bf16(Kf[t], Bqn, (f32x4){0.f, 0.f, 0.f, 0.f}, 0, 0, 0);
            { int ni = item, nc = cb + 1; if (nc == 4) { nc = 0; ni = (item + F.G < NB * 32 * 8) ? item + F.G : item; } ldk(ni, nc); }
            if (hasp) flush();
            bool sel0[4]; int dix[4];
#pragma unroll
            for (int rr = 0; rr < 4; ++rr) { const int kcol0 = bs + 4 * g + rr; sel0[rr] = kcol0 >= cs; dix[rr] = (sel0[rr] ? kcol0 : kcol0 + 16) - qc + 15; }
            float pv[8][4]; float mx = -3.0e38f;
#pragma unroll
            for (int kr = 0; kr < 8; ++kr) { const LAS float* rp = RP + (rs + kr - r + 7) * 31;
#pragma unroll
                for (int rr = 0; rr < 4; ++rr) { const float v = (sel0[rr] ? sc[2 * kr][rr] : sc[2 * kr + 1][rr]) + rp[dix[rr]]; pv[kr][rr] = v; mx = fmaxf(mx, v); } }
            mx = fmaxf(mx, __shfl_xor(mx, 16)); mx = fmaxf(mx, __shfl_xor(mx, 32));
            float sum = 0.f;
#pragma unroll
            for (int kr = 0; kr < 8; ++kr)
#pragma unroll
                for (int rr = 0; rr < 4; ++rr) { const float p = __expf(pv[kr][rr] - mx); pv[kr][rr] = p; sum += p; }
            sum += __shfl_xor(sum, 16); sum += __shfl_xor(sum, 32);
            const float inv = 1.f / sum;
            bf16x8 Bp[8];
#pragma unroll
            for (int kr = 0; kr < 8; ++kr) { unsigned q[4];
#pragma unroll
                for (int rr = 0; rr < 4; rr += 2) { const unsigned w2_ = pk2(pv[kr][rr], pv[kr][rr + 1]); q[rr] = w2_ & 0xffffu; q[rr + 1] = w2_ >> 16; }
                unsigned short e0[4], e1[4];
#pragma unroll
                for (int rr = 0; rr < 4; ++rr) { e0[rr] = (unsigned short)(sel0[rr] ? q[rr] : 0u); e1[rr] = (unsigned short)(sel0[rr] ? 0u : q[rr]); }
                Bp[kr] = (bf16x8){(short)e0[0], (short)e0[1], (short)e0[2], (short)e0[3], (short)e1[0], (short)e1[1], (short)e1[2], (short)e1[3]}; }
#pragma unroll
            for (int dt = 0; dt < 2; ++dt) { f32x4 acc = (f32x4){0.f, 0.f, 0.f, 0.f};
#pragma unroll
                for (int kr = 0; kr < 8; ++kr) { const int rowb = (rs + kr - klo) * 64 + bs + 4 * g + tq;
                    const bf16x8 A = cat8(tr16(VL + rowb * 64 + (16 * dt + 4 * tp) * 2), tr16(VL + (rowb + 16) * 64 + (16 * dt + 4 * tp) * 2));
                    acc = __builtin_amdgcn_mfma_f32_16x16x32_bf16(A, Bp[kr], acc, 0, 0, 0); }
                if (FP8_NAOUT) { const float i16 = inv * 16.f; pend[dt].x = pk4_fp8(acc[0] * i16, acc[1] * i16, acc[2] * i16, acc[3] * i16); }
                else { pend[dt].x = pk2(acc[0] * inv, acc[1] * inv); pend[dt].y = pk2(acc[2] * inv, acc[3] * inv); } }
            pidx = ((size_t)b * 4096 + r * 64 + qc) * 1024 + h * 32 + 4 * g; hasp = true;
        }
    }
    if (hasp) flush();
}

HD void ln1_phase(const Frame& F, const float* xin, const bf16* xinb, const float* g, const float* bta, bf16* xob, unsigned char* xo8, int m_first, int m_end, int m_step) {
    const bf16* HP = (const bf16*)(F.ws + WS_HPRE);
    float gv[16], bv[16];
#pragma unroll
    for (int c = 0; c < 2; ++c)
#pragma unroll
        for (int q = 0; q < 2; ++q) { const f32x4 a4 = *(const f32x4*)(g + 512 * c + 8 * F.lane + 4 * q), b4 = *(const f32x4*)(bta + 512 * c + 8 * F.lane + 4 * q);
#pragma unroll
            for (int i = 0; i < 4; ++i) { gv[8 * c + 4 * q + i] = a4[i]; bv[8 * c + 4 * q + i] = b4[i]; } }
#pragma unroll 2
    for (int m = m_first; m < m_end; m += m_step) {
        float v[16]; float s = 0.f;
#pragma unroll
        for (int c = 0; c < 2; ++c) { const size_t off = (size_t)m * D + 512 * c + 8 * F.lane; float x[8], h[8];
            if (xin) { const f32x4 x0 = *(const f32x4*)(xin + off), x1 = *(const f32x4*)(xin + off + 4); x[0] = x0[0]; x[1] = x0[1]; x[2] = x0[2]; x[3] = x0[3]; x[4] = x1[0]; x[5] = x1[1]; x[6] = x1[2]; x[7] = x1[3]; }
            else unpack8(*(const v4u*)(xinb + off), x);
            unpack8(*(const v4u*)(HP + off), h);
#pragma unroll
            for (int i = 0; i < 8; ++i) { v[8 * c + i] = x[i] * DN_ALPHA + h[i]; s += v[8 * c + i]; } }
        const float mean = wave_sum(s) * (1.f / D); float s2 = 0.f;
#pragma unroll
        for (int i = 0; i < 16; ++i) { v[i] -= mean; s2 += v[i] * v[i]; }
        const float rstd = 1.f / sqrtf(wave_sum(s2) * (1.f / D) + LN_EPS);
#pragma unroll
        for (int c = 0; c < 2; ++c) { const size_t off = (size_t)m * D + 512 * c + 8 * F.lane; float y[8];
#pragma unroll
            for (int i = 0; i < 8; ++i) y[i] = v[8 * c + i] * rstd * gv[8 * c + i] + bv[8 * c + i];
            *(v4u*)(xob + off) = pack8f(y);
            v2u w8; w8.x = pk4_fp8(y[0] * 16.f, y[1] * 16.f, y[2] * 16.f, y[3] * 16.f); w8.y = pk4_fp8(y[4] * 16.f, y[5] * 16.f, y[6] * 16.f, y[7] * 16.f);
            *(v2u*)(xo8 + off) = w8; }
    }
}
HD void topk_rows(const Frame& F, const float* rb, int layer, int row0) {
    LAS int* hist = (LAS int*)F.lds; LAS int* base = hist + 32;
    const float* LG = (const float*)(F.ws + WS_LOGIT); int* tokl = (int*)(F.ws + WS_TOKL); int* sel = (int*)(F.ws + WS_SEL); float* gate = (float*)(F.ws + WS_GATE);
    unsigned* gcnt = F.ctl + CW_CNT + layer * 32;
    {
        __syncthreads();
        if (F.tid < 32) hist[F.tid] = 0;
        __syncthreads();
        const bool act = F.tid < 256; const int m = row0 + (act ? F.tid : 0);
        float lg[32];
        __builtin_amdgcn_fence(__ATOMIC_ACQUIRE, "agent");
        { f32x4 l4[8];
#pragma unroll
          for (int q4 = 0; q4 < 8; ++q4) l4[q4] = *(const f32x4*)(LG + (size_t)m * 32 + 4 * q4);
#pragma unroll
          for (int q4 = 0; q4 < 8; ++q4)
#pragma unroll
              for (int i = 0; i < 4; ++i) lg[4 * q4 + i] = l4[q4][i] + rb[4 * q4 + i]; }
        int ti[4]; float tv[4];
#pragma unroll
        for (int k = 0; k < 4; ++k) { float best = -3.0e38f; int bi = 0;
#pragma unroll
            for (int e = 0; e < 32; ++e) { const bool take = lg[e] > best; best = take ? lg[e] : best; bi = take ? e : bi; }
            ti[k] = bi; tv[k] = best;
#pragma unroll
            for (int e = 0; e < 32; ++e) lg[e] = (e == bi) ? -3.0e38f : lg[e]; }
        float ex[4], es = 0.f;
#pragma unroll
        for (int k = 0; k < 4; ++k) { ex[k] = expf(tv[k] - tv[0]); es += ex[k]; }
        int rk[4];
#pragma unroll
        for (int k = 0; k < 4; ++k) rk[k] = act ? __hip_atomic_fetch_add(&hist[ti[k]], 1, __ATOMIC_RELAXED, __HIP_MEMORY_SCOPE_WORKGROUP) : 0;
        __syncthreads();
        if (F.tid < 32) base[F.tid] = (int)atomicAdd(&gcnt[F.tid], (unsigned)hist[F.tid]);
        __syncthreads();
        if (act)
#pragma unroll
        for (int k = 0; k < 4; ++k) { const int slot = base[ti[k]] + rk[k]; tokl[(size_t)ti[k] * 65536 + slot] = m; sel[((size_t)m * 4 + k) * 2] = ti[k]; sel[((size_t)m * 4 + k) * 2 + 1] = slot; gate[(size_t)m * 4 + k] = ex[k] / es; }
    }
}
HD int moe_tables(const Frame& F, int layer, bool reuse = false) {
    LAS int* ecnt = (LAS int*)(F.lds + LDS_ECNT); LAS int* tbase = (LAS int*)(F.lds + LDS_TBASE); LAS unsigned short* texp = (LAS unsigned short*)(F.lds + LDS_TEXP);
    if (reuse) { const int T = tbase[32]; return T < MAXTILES ? T : MAXTILES; }
    __syncthreads();
    if (F.tid < 32) ecnt[F.tid] = (int)__hip_atomic_load(F.ctl + CW_CNT + layer * 32 + F.tid, __ATOMIC_RELAXED, __HIP_MEMORY_SCOPE_AGENT);
    __syncthreads();
    if (F.tid == 0) { int acc = 0; for (int e = 0; e < 32; ++e) { tbase[e] = acc; acc += (ecnt[e] + 255) >> 8; } tbase[32] = acc; }
    __syncthreads();
    if (F.tid < 32) { const int t0 = tbase[F.tid], t1 = tbase[F.tid + 1]; for (int t = t0; t < t1 && t < MAXTILES; ++t) texp[t] = (unsigned short)F.tid; }
    __syncthreads();
    const int T = tbase[32]; return T < MAXTILES ? T : MAXTILES;
}
HD void moe_scatter(const Frame& F) {
    const LAS int* tbase = (const LAS int*)(F.lds + LDS_TBASE);
    const unsigned char* X8 = F.ws + WS_X8; unsigned char* XS = F.ws + WS_XS; const int* sel = (const int*)(F.ws + WS_SEL);
    for (int m = F.gw; m < M; m += F.NGW) {
        const v4u row = *((const v4u*)(X8 + (size_t)m * 1024) + F.lane);
        const i32x4 s0 = *(const i32x4*)(sel + (size_t)m * 8), s1 = *(const i32x4*)(sel + (size_t)m * 8 + 4);
        *((v4u*)(XS + ((size_t)tbase[s0[0]] * 256 + s0[1]) * 1024) + F.lane) = row;
        *((v4u*)(XS + ((size_t)tbase[s0[2]] * 256 + s0[3]) * 1024) + F.lane) = row;
        *((v4u*)(XS + ((size_t)tbase[s1[0]] * 256 + s1[1]) * 1024) + F.lane) = row;
        *((v4u*)(XS + ((size_t)tbase[s1[2]] * 256 + s1[3]) * 1024) + F.lane) = row;
    }
}
HD void ln2_phase(const Frame& F, const bf16* xinb, const float* g, const float* bta, float* xo, bf16* xob, unsigned char* xo8) {
    const LAS int* tbase = (const LAS int*)(F.lds + LDS_TBASE);
    const bf16* Y = (const bf16*)(F.ws + WS_YBUF); const int* sel = (const int*)(F.ws + WS_SEL); const float* gate = (const float*)(F.ws + WS_GATE);
    float gv[16], bv[16];
#pragma unroll
    for (int c = 0; c < 2; ++c)
#pragma unroll
        for (int q = 0; q < 2; ++q) { const f32x4 a4 = *(const f32x4*)(g + 512 * c + 8 * F.lane + 4 * q), b4 = *(const f32x4*)(bta + 512 * c + 8 * F.lane + 4 * q);
#pragma unroll
            for (int i = 0; i < 4; ++i) { gv[8 * c + 4 * q + i] = a4[i]; bv[8 * c + 4 * q + i] = b4[i]; } }
    for (int m = F.gw; m < M; m += F.NGW) {
        const i32x4 s0 = *(const i32x4*)(sel + (size_t)m * 8), s1 = *(const i32x4*)(sel + (size_t)m * 8 + 4); const f32x4 gt = *(const f32x4*)(gate + (size_t)m * 4);
        size_t rows[4]; rows[0] = (size_t)tbase[s0[0]] * 256 + s0[1]; rows[1] = (size_t)tbase[s0[2]] * 256 + s0[3]; rows[2] = (size_t)tbase[s1[0]] * 256 + s1[1]; rows[3] = (size_t)tbase[s1[2]] * 256 + s1[3];
        v4u xw[2]; v2u yw[4][2];
#pragma unroll
        for (int c = 0; c < 2; ++c) { xw[c] = *(const v4u*)(xinb + (size_t)m * D + 512 * c + 8 * F.lane);
#pragma unroll
            for (int k = 0; k < 4; ++k) yw[k][c] = *(const v2u*)((const unsigned char*)Y + rows[k] * 1024 + 512 * c + 8 * F.lane); }
        float v[16]; float s = 0.f;
#pragma unroll
        for (int c = 0; c < 2; ++c) { float x[8]; unpack8(xw[c], x);
#pragma unroll
            for (int i = 0; i < 8; ++i) v[8 * c + i] = x[i] * DN_ALPHA;
#pragma unroll
            for (int k = 0; k < 4; ++k) { float y[8]; unpack8_fp8(yw[k][c], y); const float gk = gt[k] * 0.03125f;
#pragma unroll
                for (int i = 0; i < 8; ++i) v[8 * c + i] += y[i] * gk; }
#pragma unroll
            for (int i = 0; i < 8; ++i) s += v[8 * c + i]; }
        const float mean = wave_sum(s) * (1.f / D); float s2 = 0.f;
#pragma unroll
        for (int i = 0; i < 16; ++i) { v[i] -= mean; s2 += v[i] * v[i]; }
        const float rstd = 1.f / sqrtf(wave_sum(s2) * (1.f / D) + LN_EPS);
#pragma unroll
        for (int c = 0; c < 2; ++c) { const size_t off = (size_t)m * D + 512 * c + 8 * F.lane; float y[8];
#pragma unroll
            for (int i = 0; i < 8; ++i) y[i] = v[8 * c + i] * rstd * gv[8 * c + i] + bv[8 * c + i];
            if (xo) { *(f32x4*)(xo + off) = (f32x4){y[0], y[1], y[2], y[3]}; *(f32x4*)(xo + off + 4) = (f32x4){y[4], y[5], y[6], y[7]}; }
            else { *(v4u*)(xob + off) = pack8f(y);
                if (xo8) { v2u w8; w8.x = pk4_fp8(y[0] * 16.f, y[1] * 16.f, y[2] * 16.f, y[3] * 16.f); w8.y = pk4_fp8(y[4] * 16.f, y[5] * 16.f, y[6] * 16.f, y[7] * 16.f); *(v2u*)(xo8 + off) = w8; } } }
    }
}

__global__ void __launch_bounds__(NT, 2) enc_fwd(Args args_by_value) {
    extern __shared__ __attribute__((aligned(16))) unsigned char lds_raw[];
    LAS unsigned char* const lds = (LAS unsigned char*)lds_raw;
    { const int t0 = threadIdx.x; for (int u = t0; u < 64; u += NT) ((LAS unsigned*)(lds + LDS_MISC))[u] = 0u;
      if ((t0 & 63) == 0) ((LAS int*)(lds + LDS_WTAB))[hw_slot()] = t0 >> 6; }
    __syncthreads();
    int lo, hi; { ArgsP ap = argp(); lo = ap->ph_lo; hi = ap->ph_hi; }
    const bool multi = (hi - lo) > 1;
    if (multi) (void)xcd_barrier_post((unsigned*)(argp()->ws + WS_CTL) + CW_BAR, (volatile LAS unsigned*)(lds + LDS_MISC) + 8);
#define IN(k) (lo <= (k) && (k) < hi)
#define SEAM(k) do { if (multi && (k) + 1 < hi) { XcdBarrier bar_; bar_.bar = (unsigned*)(argp()->ws + WS_CTL) + CW_BAR; bar_.x = xb_xcc_id(); bar_.st = (volatile LAS unsigned*)(lds + LDS_MISC) + 8; xcd_barrier(bar_); } } while (0)
#define FRAME() ArgsP ap = argp(); const Frame F = mkframe(ap, lds); unsigned char* const ws = F.ws; (void)ws

    if (IN(0)) { { FRAME(); if (PEN(0)) REP(0) p0_prologue(F, ap); } { FRAME(); if (PEN(17)) REP(17) p0_hyena_filters(F, ap); } SEAM(0); }

    for (int layer = 0; layer < DEPTH; ++layer) {
        const int pb = 1 + 16 * layer, mixer = layer % 3, jj = layer / 3;
        if (mixer == 0) {
            if (IN(pb + 0)) {
                if (PEN(1)) REP(1) { FRAME();
                    constexpr int RB = FP8_GLA ? 1024 : 2048;
                    g8::DenseSched S{(const bf16*)(ws + (FP8_GLA ? WS_X8 : WS_XAB)), (const bf16*)(ws + WS_WGIN + (size_t)jj * GLA_NPAD * RB), M / 256, GLA_NPAD / 256, F.G, (int)blockIdx.x, RB};
                    g8::EpiGlaIn E{(bf16*)(ws + WS_QKVG), (float*)(ws + WS_GLOW), 0.08838834764831845f, FP8_GLA ? 4.8828125e-4f : 1.f};
                    g8::gemm_phase<g8::EpiGlaIn, g8::DenseSched, false, FP8_GLA != 0>(F.lds, S, E); }
                if (PEN(16) && layer == 0) REP(16) { FRAME(); hyena_filter_fft(F); }
                SEAM(pb + 0);
            }
            if (IN(pb + 1)) { if (PEN(19)) REP(19) { FRAME(); gla_prep(F, ap, jj); } if (multi) SEAM(-1000);
                if (PEN(2)) REP(2) { FRAME(); if (GLA_NAIVE) gla_scan_naive(F, ap, jj); else gla_scan_mfma(F, ap, jj); } SEAM(pb + 1); }
        } else if (mixer == 1) {
            if (IN(pb + 0)) { if (PEN(4)) REP(4) { FRAME();
                constexpr int RB = FP8_HY ? 1024 : 2048;
                g8::DenseSched S{(const bf16*)(ws + WS_WHIN), (const bf16*)(ws + (FP8_HY ? WS_X8 : WS_XAB)), 3072 / 256, M / 256, F.G, (int)blockIdx.x, RB};
                g8::EpiHyIn E{(bf16*)(ws + WS_PT), ap->in[IN_HBIN], FP8_HY ? 4.8828125e-4f : 1.f};
                g8::gemm_phase<g8::EpiHyIn, g8::DenseSched, false, FP8_HY != 0>(F.lds, S, E); }
                SEAM(pb + 0);
            }
            if (IN(pb + 1)) { if (PEN(5)) REP(5) { FRAME(); hyena_core(F, ap); } SEAM(pb + 1); }
        } else {
            if (IN(pb + 0)) { if (PEN(7)) REP(7) { FRAME();
                constexpr int RB = FP8_NA ? 1024 : 2048;
                g8::DenseSched S{(const bf16*)(ws + (FP8_NA ? WS_X8 : WS_XAB)), (const bf16*)(ws + WS_WNIN), M / 256, 3072 / 256, F.G, (int)blockIdx.x, RB};
                g8::EpiNaIn E{(bf16*)(ws + WS_QH), (size_t)(WS_KH - WS_QH) / 2, ap->in[IN_NBIN], 0.17677669529663687f, FP8_NA ? 4.8828125e-4f : 1.f};
                g8::gemm_phase<g8::EpiNaIn, g8::DenseSched, false, FP8_NA != 0>(F.lds, S, E); }
                SEAM(pb + 0);
            }
            if (IN(pb + 1)) { if (PEN(8)) REP(8) { FRAME(); if (NA_NAIVE) na_attn_naive(F, ap); else na_attn_mfma(F, ap); } SEAM(pb + 1); }
        }
        if (IN(pb + 3)) { if (PEN(9)) REP(9) {
            for (int pm = blockIdx.x; pm < M / 256; pm += 256) {
                const int r0 = pm * 256;
                if (mixer == 0) { FRAME(); gla_gate(F, ap, jj, r0 + F.wave, r0 + 256, NWAVES); }
                else if (mixer == 1) { FRAME(); hyena_transpose(F, 64 * pm + F.wave, 64 * pm + 64, NWAVES); }
                VM_WAIT(); __syncthreads();
                { FRAME();
                  const bf16* wout = (mixer == 0) ? (const bf16*)(ws + WS_WGOUT) + (size_t)jj * 1024 * 1024 : (mixer == 1) ? (const bf16*)(ws + WS_WHOUT) : (const bf16*)(ws + WS_WNOUT);
                  const float* bout = (mixer == 0) ? nullptr : (mixer == 1) ? ap->in[IN_HBOUT] : ap->in[IN_NBOUT];
                  if (FP8_NAOUT && mixer == 2) {
                      g8::PanelSched S{(const bf16*)(ws + WS_AB), wout, pm, 4, 1024};
                      g8::EpiBf16 E{(bf16*)(ws + WS_HPRE), 1024, bout, 4, 2.44140625e-4f};
                      g8::gemm_phase<g8::EpiBf16, g8::PanelSched, false, true>(F.lds, S, E);
                  } else {
                  g8::PanelSched S{(const bf16*)(ws + WS_AB), wout, pm, 4};
                  g8::EpiBf16 E{(bf16*)(ws + WS_HPRE), 1024, bout, 0, 1.f};
                  g8::gemm_phase<g8::EpiBf16, g8::PanelSched, false>(F.lds, S, E); } }
                VM_WAIT(); __syncthreads();
                { FRAME();
                  const float* xin = (layer == 0) ? ap->in[IN_X] : nullptr;
                  ln1_phase(F, xin, (const bf16*)(ws + WS_XAB), ap->in[IN_LN1G] + layer * D, ap->in[IN_LN1B] + layer * D, (bf16*)(ws + WS_XBB), ws + WS_X8, r0 + F.wave, r0 + 256, NWAVES); }
                VM_WAIT(); __syncthreads();
                { FRAME();
                  g8::PanelSched S{(const bf16*)(ws + WS_XBB), (const bf16*)(ws + WS_WR) + (size_t)layer * 256 * 1024, pm, 1};
                  g8::EpiF32Cols32 E{(float*)(ws + WS_LOGIT)};
                  g8::gemm_phase<g8::EpiF32Cols32, g8::PanelSched, false>(F.lds, S, E);
                  VM_WAIT(); __syncthreads();
                  topk_rows(F, ap->in[IN_RB] + layer * 32, layer, r0); }
                __syncthreads();
            } }
            SEAM(pb + 3);
        }
        if (IN(pb + 8)) { if (PEN(13)) REP(13) { FRAME();
            const int T = moe_tables(F, layer);
            g8::MoeSched S{(const bf16*)(ws + WS_X8), (const bf16*)(ws + WS_WGU + (size_t)layer * 32 * 2048 * 1024), (size_t)2048 * 1024, (const int*)(ws + WS_TOKL),
                           (const LAS int*)(F.lds + LDS_ECNT), (const LAS int*)(F.lds + LDS_TBASE), (const LAS unsigned short*)(F.lds + LDS_TEXP), T, 8, F.G, (int)blockIdx.x, true, 1024};
            g8::EpiMoe1 E{(bf16*)(ws + WS_HBUF), ap->in[IN_BGU] + (size_t)layer * 32 * 2048};
            g8::gemm_phase<g8::EpiMoe1, g8::MoeSched, true, true>(F.lds, S, E); }
            SEAM(pb + 8);
        }
        if (IN(pb + 9)) { if (PEN(14)) REP(14) { FRAME();
            const int T = moe_tables(F, layer, lo <= pb + 8);
            g8::MoeSched S{(const bf16*)(ws + WS_HBUF), (const bf16*)(ws + WS_WDN + (size_t)layer * 32 * 1024 * 1024), (size_t)1024 * 1024, (const int*)(ws + WS_TOKL),
                           (const LAS int*)(F.lds + LDS_ECNT), (const LAS int*)(F.lds + LDS_TBASE), (const LAS unsigned short*)(F.lds + LDS_TEXP), T, 4, F.G, (int)blockIdx.x, false, 1024};
            g8::EpiMoe2 E{(bf16*)(ws + WS_YBUF), ap->in[IN_BDN] + (size_t)layer * 32 * 1024};
            g8::gemm_phase<g8::EpiMoe2, g8::MoeSched, false, true>(F.lds, S, E); }
            SEAM(pb + 9);
        }
        if (IN(pb + 10)) { const bool lastl = (layer == DEPTH - 1);
            if (PEN(15)) REP(15) { FRAME();
            (void)moe_tables(F, layer, lo <= pb + 8);
            ln2_phase(F, (const bf16*)(ws + WS_XBB), ap->in[IN_LN2G] + layer * D, ap->in[IN_LN2B] + layer * D, lastl ? ap->out : nullptr, lastl ? nullptr : (bf16*)(ws + WS_XAB), (((layer + 1) % 3 == 0) ? FP8_GLA : ((layer + 1) % 3 == 1) ? FP8_HY : FP8_NA) ? ws + WS_X8 : nullptr); }
            if (!lastl) SEAM(pb + 10);
        }
    }
#undef IN
#undef SEAM
#undef FRAME
}

extern "C" void kernel_launch(void* const* d_in, const int* in_sizes, int n_in, void* d_out, int out_size, void* d_ws, size_t ws_size, hipStream_t stream) {
    static int grid = 0;
    if (grid == 0) {
        if (n_in != 34 || out_size != M * D || ws_size < WS_NEED) { fprintf(stderr, "kernel_launch: unexpected shapes (n_in %d out %d ws %zu need %zu)\n", n_in, out_size, ws_size, (size_t)WS_NEED); grid = -1; return; }
        int dev = 0, cus = 0, per_cu = 0;
        if (hipGetDevice(&dev) != hipSuccess || hipDeviceGetAttribute(&cus, hipDeviceAttributeMultiprocessorCount, dev) != hipSuccess) { grid = -1; return; }
        if (hipFuncSetAttribute((const void*)enc_fwd, hipFuncAttributeMaxDynamicSharedMemorySize, LDS_BYTES) != hipSuccess) { fprintf(stderr, "kernel_launch: hipFuncSetAttribute failed\n"); grid = -1; return; }
        if (hipOccupancyMaxActiveBlocksPerMultiprocessor(&per_cu, (const void*)enc_fwd, NT, LDS_BYTES) != hipSuccess || per_cu < 1) fprintf(stderr, "kernel_launch: occupancy query reports %d\n", per_cu);
        (void)hipGetLastError();
        grid = 256;
        if (cus < 256) fprintf(stderr, "kernel_launch: %d CUs < 256: the persistent grid is not resident\n", cus);
    }
    if (grid < 0) return;
    (void)hipMemsetAsync((char*)d_ws + WS_CTL, 0, CTL_ZERO_BYTES, stream);
    Args a{};
    for (int i = 0; i < 34; ++i) a.in[i] = (const float*)d_in[i];
    a.out = (float*)d_out; a.ws = (unsigned char*)d_ws;
#if MK_ONE_LAUNCH
    a.ph_lo = 0; a.ph_hi = 1000;
    hipLaunchKernelGGL(enc_fwd, dim3(grid), dim3(NT), LDS_BYTES, stream, a);
#else
    int phases[64]; int np = 0;
    phases[np++] = 0;
    for (int l = 0; l < DEPTH; ++l) { const int pb = 1 + 16 * l, mixer = l % 3; for (int k = 0; k < 11; ++k) { if (k == 2 || k == 4 || k == 5 || k == 6 || k == 7) continue; phases[np++] = pb + k; } }
    for (int i = 0; i < np; ++i) { a.ph_lo = phases[i]; a.ph_hi = phases[i] + 1; hipLaunchKernelGGL(enc_fwd, dim3(grid), dim3(NT), LDS_BYTES, stream, a); }
#endif
}
```

```cpp
#include <hip/hip_runtime.h>
#include <cstdio>
#include <cstdint>

#ifndef PHASE_MASK
#define PHASE_MASK 0xFFFFFFFFu
#endif
#define PEN(k) ((PHASE_MASK >> (k)) & 1u)
#ifndef REPEAT_MASK
#define REPEAT_MASK 0u
#endif
#define REP(k) for (int rep_ = 0; rep_ < 1 + (int)((REPEAT_MASK >> (k)) & 1u); ++rep_)
#ifndef GLA_NAIVE
#define GLA_NAIVE 0
#endif
#ifndef NA_NAIVE
#define NA_NAIVE 0
#endif
#ifndef FP8_GLA
#define FP8_GLA 0
#endif
#ifndef FP8_NAOUT
#define FP8_NAOUT 1
#endif
#ifndef FP8_HY
#define FP8_HY 0
#endif
#ifndef FP8_NA
#define FP8_NA 1
#endif
#ifndef MK_ONE_LAUNCH
#define MK_ONE_LAUNCH 1
#endif

#define GAS __attribute__((address_space(1)))
#define LAS __attribute__((address_space(3)))
#define HD __device__ __forceinline__
typedef unsigned short bf16;
typedef unsigned v4u __attribute__((ext_vector_type(4)));
typedef unsigned v2u __attribute__((ext_vector_type(2)));
typedef float f32x4 __attribute__((ext_vector_type(4)));
typedef float f32x2 __attribute__((ext_vector_type(2)));
typedef short bf16x8 __attribute__((ext_vector_type(8)));
typedef short s16x4 __attribute__((ext_vector_type(4)));
typedef int i32x8 __attribute__((ext_vector_type(8)));
typedef int i32x4 __attribute__((ext_vector_type(4)));

constexpr int D = 1024, NB = 16, SEQ = 4096, M = NB * SEQ, DEPTH = 4;
constexpr int NEXP = 32, TOPK = 4;
constexpr int GLA_NIN = 3104, GLA_NPAD = 3328;
constexpr float LN_EPS = 1e-5f;
constexpr float DN_ALPHA = 1.6817928305074290f;
constexpr int NWAVES = 8, NT = 512;
constexpr int MAXTILES = 1088;
constexpr int MOE_ROWS = MAXTILES * 256;

constexpr size_t MiB = 1ull << 20;
constexpr size_t WS_CTL = 0, CTL_ZERO_BYTES = 1 * MiB;
constexpr size_t WS_WGIN = 2 * MiB;
constexpr size_t WS_WGOUT = WS_WGIN + 14 * MiB;
constexpr size_t WS_WHIN = WS_WGOUT + 4 * MiB;
constexpr size_t WS_WHOUT = WS_WHIN + 6 * MiB;
constexpr size_t WS_WNIN = WS_WHOUT + 2 * MiB;
constexpr size_t WS_WNOUT = WS_WNIN + 6 * MiB;
constexpr size_t WS_WR = WS_WNOUT + 2 * MiB;
constexpr size_t WS_WGU = WS_WR + 2 * MiB;
constexpr size_t WS_WDN = WS_WGU + 512 * MiB;
constexpr size_t WS_HFB = WS_WDN + 256 * MiB;
constexpr size_t WS_HSPEC = WS_HFB + 64 * MiB;
constexpr size_t WS_XA = WS_HSPEC + 128 * MiB;
constexpr size_t WS_XB = WS_XA + 256 * MiB;
constexpr size_t WS_XAB = WS_XB + 256 * MiB;
constexpr size_t WS_XBB = WS_XAB + 128 * MiB;
constexpr size_t WS_HPRE = WS_XBB + 128 * MiB;
constexpr size_t WS_AB = WS_HPRE + 128 * MiB;
constexpr size_t WS_BIG = WS_AB + 128 * MiB;
constexpr size_t WS_QKVG = WS_BIG;
constexpr size_t WS_GLOW = WS_QKVG + 384 * MiB;
constexpr size_t WS_OF = WS_GLOW + 8 * MiB;
constexpr size_t WS_OB = WS_OF + 256 * MiB;
constexpr size_t WS_QT2 = WS_OF + 128 * MiB;
constexpr size_t WS_KT2 = WS_OB + 128 * MiB;
constexpr size_t WS_GS2 = WS_OB + 256 * MiB;
constexpr size_t WS_PT = WS_BIG;
constexpr size_t WS_OUTT = WS_PT + 384 * MiB;
constexpr size_t WS_QH = WS_BIG, WS_KH = WS_QH + 128 * MiB, WS_VH = WS_KH + 128 * MiB;
constexpr size_t WS_HBUF = WS_BIG;
constexpr size_t WS_YBUF = WS_HBUF + (size_t)MOE_ROWS * 2048;
constexpr size_t WS_TOKL = WS_YBUF + (size_t)MOE_ROWS * 2048;
constexpr size_t WS_SEL = WS_TOKL + 8 * MiB;
constexpr size_t WS_GATE = WS_SEL + 2 * MiB;
constexpr size_t WS_LOGIT = WS_GATE + 1 * MiB;
constexpr size_t WS_X8 = WS_LOGIT + 8 * MiB;
constexpr size_t WS_XS = WS_X8 + 64 * MiB;
constexpr size_t WS_END = WS_XS + (size_t)MOE_ROWS * 1024;
static_assert(WS_OB + 256 * MiB <= WS_END + 64 * MiB, "map");
constexpr size_t WS_NEED = (WS_END > WS_OB + 256 * MiB ? WS_END : WS_OB + 256 * MiB);
constexpr int CW_TMO = 0;
constexpr int CW_CNT = 64;
constexpr int CW_BAR = 4096;

constexpr int RING_BYTES = 131072;
constexpr int LDS_MISC = RING_BYTES;
constexpr int LDS_WTAB = LDS_MISC + 1024;
constexpr int LDS_ECNT = LDS_MISC + 1280;
constexpr int LDS_TBASE = LDS_ECNT + 128;
constexpr int LDS_TEXP = LDS_TBASE + 144;
constexpr int LDS_BYTES = 147456;
static_assert(LDS_TEXP + MAXTILES * 2 <= LDS_BYTES && LDS_MISC == 131072 && LDS_WTAB == 131072 + 1024, "lds");

#define LDS_WAIT() asm volatile("s_waitcnt lgkmcnt(0)" ::: "memory")
#define VM_WAIT() asm volatile("s_waitcnt vmcnt(0)" ::: "memory")
typedef __bf16 hwbf16x2 __attribute__((ext_vector_type(2)));
HD unsigned pk2(float lo, float hi) { const hwbf16x2 r = __builtin_convertvector((f32x2){lo, hi}, hwbf16x2); return __builtin_bit_cast(unsigned, r); }
HD unsigned f2bf(float f) { return pk2(f, 0.f) & 0xffffu; }
HD float clamp8(float v) { return fminf(fmaxf(v, -448.f), 448.f); }
HD unsigned pk4_fp8(float a, float b, float c, float d) { int w = 0; w = __builtin_amdgcn_cvt_pk_fp8_f32(clamp8(a), clamp8(b), w, false); w = __builtin_amdgcn_cvt_pk_fp8_f32(clamp8(c), clamp8(d), w, true); return (unsigned)w; }
HD float bf2f(unsigned b) { return __builtin_bit_cast(float, b << 16); }
HD float bflo(unsigned w) { return __builtin_bit_cast(float, w << 16); }
HD float bfhi(unsigned w) { return __builtin_bit_cast(float, w & 0xffff0000u); }
HD float sin_rev(float r) { r -= rintf(r); return __builtin_amdgcn_sinf(r); }
HD float cos_rev(float r) { r -= rintf(r); return __builtin_amdgcn_cosf(r); }
HD float sin_rad(float x) { return sin_rev(x * 0.15915494309189535f); }
HD int hw_slot() { const unsigned h = (unsigned)__builtin_amdgcn_s_getreg((6 << 11) | 4); return (int)(h & 0x3fu); }
HD int my_tid(const LAS unsigned char* lds_) {
    const int lane = (int)__builtin_amdgcn_mbcnt_hi(~0u, __builtin_amdgcn_mbcnt_lo(~0u, 0u));
    const int wv = __builtin_amdgcn_readfirstlane(((const LAS int*)(lds_ + 131072 + 1024))[hw_slot()]);
    return wv * 64 + lane;
}
template <int CTRL> HD float dpp_add(float v) { const int t = __builtin_amdgcn_update_dpp(0, __builtin_bit_cast(int, v), CTRL, 0xf, 0xf, true); return v + __builtin_bit_cast(float, t); }
HD float wave_sum(float v) {
    v = dpp_add<0xB1>(v); v = dpp_add<0x4E>(v); v = dpp_add<0x141>(v); v = dpp_add<0x140>(v);
    const int iv = __builtin_bit_cast(int, v);
    return (__builtin_bit_cast(float, __builtin_amdgcn_readlane(iv, 0)) + __builtin_bit_cast(float, __builtin_amdgcn_readlane(iv, 16)))
         + (__builtin_bit_cast(float, __builtin_amdgcn_readlane(iv, 32)) + __builtin_bit_cast(float, __builtin_amdgcn_readlane(iv, 48)));
}

#define XB_TMO      128
#define XB_XCNT(j)  (256  + 64 * (j))
#define XB_XSUB(j)  (1280 + 64 * (j))
#define XB_XGEN(j)  (2304 + 64 * (j))
#define XB_TOP      3328
#define XB_TOPGEN   3392
#define XCD_BAR_WORDS 3456
#define XB_SPIN_CAP (1u << 18)
__device__ __forceinline__ unsigned xb_ld(unsigned* p)              { return __hip_atomic_load(p, __ATOMIC_RELAXED, __HIP_MEMORY_SCOPE_AGENT); }
__device__ __forceinline__ unsigned xb_add(unsigned* p, unsigned v) { return __hip_atomic_fetch_add(p, v, __ATOMIC_RELAXED, __HIP_MEMORY_SCOPE_AGENT); }
__device__ __forceinline__ unsigned xb_xcc_id() { return (unsigned)__builtin_amdgcn_s_getreg((3 << 11) | 20) & 0xFu; }
#define XB_SPIN(cond, bar) do { unsigned _sp = 0; while (cond) { __builtin_amdgcn_s_sleep(1); \
    if ((++_sp & 255u) == 0u) { if (xb_ld(&(bar)[XB_TMO])) break; if (_sp > XB_SPIN_CAP) { atomicAdd(&(bar)[XB_TMO], 1u); break; } } } } while (0)
struct XcdBarrier { unsigned* bar; unsigned x; volatile LAS unsigned* st; };
__device__ __forceinline__ XcdBarrier xcd_barrier_post(unsigned* bar, volatile LAS unsigned* st) {
    XcdBarrier b; b.bar = bar; b.x = xb_xcc_id(); b.st = st;
    if (my_tid((const LAS unsigned char*)st - (131072 + 32)) == 0) (void)xb_add(&bar[XB_XCNT(b.x)], 1u);
    return b;
}
__device__ __forceinline__ void xcd_barrier_complete(unsigned* bar, unsigned x, unsigned& nloc, unsigned& nx) {
    const unsigned G = gridDim.x * gridDim.y * gridDim.z;
    unsigned sum, cnt, mine, sp = 0u;
    for (;;) {
        sum = 0u; cnt = 0u; mine = 0u;
#pragma unroll
        for (unsigned j = 0; j < 16; ++j) { const unsigned c = xb_ld(&bar[XB_XCNT(j)]); sum += c; cnt += (c > 0u) ? 1u : 0u; mine = (j == x) ? c : mine; }
        if (sum == G) break;
        __builtin_amdgcn_s_sleep(1);
        if ((++sp & 255u) == 0u) { if (xb_ld(&bar[XB_TMO])) break; if (sp > XB_SPIN_CAP) { atomicAdd(&bar[XB_TMO], 1u); break; } }
    }
    nloc = mine > 0u ? mine : 1u; nx = cnt > 0u ? cnt : 1u;
}
__device__ __forceinline__ void xcd_barrier(const XcdBarrier& b) {
    asm volatile("s_waitcnt vmcnt(0)" ::: "memory");
    __syncthreads();
    if (my_tid((const LAS unsigned char*)b.st - (131072 + 32)) == 0) {
        unsigned* bar = b.bar;
        __builtin_amdgcn_s_waitcnt(0);
        unsigned nloc = b.st[0], nx = b.st[1];
        if (nloc == 0u) { xcd_barrier_complete(bar, b.x, nloc, nx); b.st[0] = nloc; b.st[1] = nx; }
        const unsigned old = xb_add(&bar[XB_XSUB(b.x)], 1u);
        const unsigned gen = old / nloc;
        if (old + 1u == (gen + 1u) * nloc) {
            __builtin_amdgcn_fence(__ATOMIC_RELEASE, "agent");
            asm volatile("s_waitcnt vmcnt(0)" ::: "memory");
            const unsigned og = xb_add(&bar[XB_TOP], 1u);
            const unsigned tg = og / nx;
            if (og + 1u == (tg + 1u) * nx) xb_add(&bar[XB_TOPGEN], 1u);
            else XB_SPIN(xb_ld(&bar[XB_TOPGEN]) == tg, bar);
            __builtin_amdgcn_fence(__ATOMIC_ACQUIRE, "agent");
            xb_add(&bar[XB_XGEN(b.x)], 1u);
            asm volatile("s_waitcnt vmcnt(0)" ::: "memory");
        } else {
            XB_SPIN(xb_ld(&bar[XB_XGEN(b.x)]) == gen, bar);
            __builtin_amdgcn_fence(__ATOMIC_ACQUIRE, "agent");
            asm volatile("s_waitcnt vmcnt(0)" ::: "memory");
        }
    }
    __syncthreads();
}

namespace g8 {
constexpr int BM = 256, BK = 64, HALF = 128, HTB = HALF * BK * 2, STAGE_BYTES = 8 * HTB, NXCD = 8, WGM = 8, K = 1024;
HD int lds_byte(int r, int c) { const int st = (r >> 4) * 2 + (c >> 5), rr = r & 15, cc = c & 31, ob = rr * 64 + cc * 2; return st * 1024 + (ob ^ (((ob >> 9) & 1) << 5)); }
HD void stage_rc(int b, int& R, int& C) { const int st = b / 1024, sb = b % 1024, swz = sb ^ (((sb >> 9) & 1) << 5); R = (st >> 1) * 16 + swz / 64; C = (st & 1) * 32 + (swz % 64) / 2; }
HD int perm32(int rho) { const int n = rho >> 4, i = rho & 15; return 8 * (i >> 2) + 4 * n + (i & 3); }
struct UnitD { const char* A; const char* B; int pm, pn, e, mt, cnt, rowbase; };
HD int fdiv(int a, int b) { int q = (int)((float)a * __builtin_amdgcn_rcpf((float)b)); const int r = a - q * b; q += (r >= b) ? 1 : 0; q -= (r < 0) ? 1 : 0; return q; }
HD void order_map(int L, int nM, int nN, int& pm, int& pn) {
    const int nwg = nM * nN; int wgid = L;
    { const int q = nwg / NXCD, r = nwg % NXCD, xcd = wgid % NXCD, off = wgid / NXCD; wgid = (xcd < r ? xcd * (q + 1) : r * (q + 1) + (xcd - r) * q) + off; }
    const int nig = WGM * nN, gid = fdiv(wgid, nig), fm = gid * WGM, gsz = (nM - fm) < WGM ? (nM - fm) : WGM;
    const int rem = wgid - gid * nig, pq = (gsz == WGM) ? (rem >> 3) : fdiv(rem, gsz);
    pm = fm + (rem - pq * gsz); pn = pq;
}
struct DenseSched {
    const bf16* A; const bf16* Bt; int nM, nN, G, c; int rowb = 2048;
    HD bool next(int i, UnitD& u) const {
        const long L = (long)i * G + c; if (L >= (long)nM * nN) return false;
        int pm, pn; order_map((int)L, nM, nN, pm, pn);
        u.pm = pm; u.pn = pn; u.e = 0; u.mt = 0; u.cnt = 256; u.rowbase = pm * 256;
        u.A = (const char*)A + (size_t)pm * (256 * rowb); u.B = (const char*)Bt + (size_t)pn * (256 * rowb); return true;
    }
    HD void rows(const UnitD&, int, unsigned (&)[2][2]) const {}
    HD unsigned off(unsigned raw, unsigned) const { return raw; }
};
struct PanelSched {
    const bf16* A; const bf16* Bt; int pm, nN; int rowb = 2048;
    HD bool next(int i, UnitD& u) const {
        if (i >= nN) return false;
        u.pm = pm; u.pn = i; u.e = 0; u.mt = 0; u.cnt = 256; u.rowbase = pm * 256;
        u.A = (const char*)A + (size_t)pm * (256 * rowb); u.B = (const char*)Bt + (size_t)i * (256 * rowb); return true;
    }
    HD void rows(const UnitD&, int, unsigned (&)[2][2]) const {}
    HD unsigned off(unsigned raw, unsigned) const { return raw; }
};
struct MoeSched {
    const bf16* Abase; const bf16* W; size_t wstride;
    const int* tokl; const LAS int* ecnt; const LAS int* tbase; const LAS unsigned short* texp;
    int T, nN, G, c; bool gather; int rowb;
    HD bool next(int i, UnitD& u) const {
        const long L = (long)i * G + c; if (L >= (long)T * nN) return false;
        int pm, pn; order_map((int)L, T, nN, pm, pn);
        const int e = __builtin_amdgcn_readfirstlane((int)texp[pm]), mt = pm - __builtin_amdgcn_readfirstlane(tbase[e]);
        u.pm = pm; u.pn = pn; u.e = e; u.mt = mt; u.cnt = __builtin_amdgcn_readfirstlane(ecnt[e]) - mt * 256; u.rowbase = pm * 256;
        u.A = gather ? (const char*)Abase : (const char*)Abase + (size_t)pm * (256 * rowb);
        u.B = (const char*)W + (size_t)e * wstride + (size_t)pn * (256 * rowb); return true;
    }
    HD void rows(const UnitD& u, int tid, unsigned (&v)[2][2]) const {
        const int* tl = tokl + (size_t)u.e * 65536 + u.mt * 256; int R, C; stage_rc(tid * 16, R, C); (void)C;
#pragma unroll
        for (int h = 0; h < 2; ++h)
#pragma unroll
            for (int i = 0; i < 2; ++i) { const int r = h * 128 + 64 * i + R; v[h][i] = (unsigned)tl[(r < u.cnt) ? r : 0]; }
    }
    HD unsigned off(unsigned raw, unsigned c2) const { return raw * (unsigned)rowb + c2; }
};

HD void glds16x2(const char* sbase, const char* sbase2, unsigned v0, unsigned lds_dst) {
    unsigned keep;
    const unsigned lds_dst2 = lds_dst + 0x2000u;
    asm volatile("s_mov_b32 %0, m0\n\ts_mov_b32 m0, %4\n\ts_nop 0\n\tglobal_load_lds_dwordx4 %1, %2\n\ts_mov_b32 m0, %5\n\ts_nop 0\n\tglobal_load_lds_dwordx4 %1, %3\n\ts_mov_b32 m0, %0"
                 : "=&s"(keep) : "v"(v0), "s"(sbase), "s"(sbase2), "s"(lds_dst), "s"(lds_dst2) : "memory");
}
HD void glds16x2g(const char* sbase, unsigned v0, unsigned v1, unsigned lds_dst) {
    unsigned keep;
    const unsigned lds_dst2 = lds_dst + 0x2000u;
    asm volatile("s_mov_b32 %0, m0\n\ts_mov_b32 m0, %4\n\ts_nop 0\n\tglobal_load_lds_dwordx4 %1, %3\n\ts_mov_b32 m0, %5\n\ts_nop 0\n\tglobal_load_lds_dwordx4 %2, %3\n\ts_mov_b32 m0, %0"
                 : "=&s"(keep) : "v"(v0), "v"(v1), "s"(sbase), "s"(lds_dst), "s"(lds_dst2) : "memory");
}
HD i32x8 cat32(bf16x8 lo, bf16x8 hi) { const i32x4 a = __builtin_bit_cast(i32x4, lo), b = __builtin_bit_cast(i32x4, hi); return (i32x8){a[0], a[1], a[2], a[3], b[0], b[1], b[2], b[3]}; }
template <class Epi, class Sched, bool GATHER, bool F8 = false>
__device__ __forceinline__ void gemm_phase(LAS unsigned char* lds, const Sched& S, const Epi& E) {
    int tid = my_tid(lds); asm volatile("" : "+v"(tid));
    const int wid = __builtin_amdgcn_readfirstlane(tid >> 6), lane = tid & 63, wr = wid >> 2, wc = wid & 3, fr = lane & 15, fq = lane >> 4;
    constexpr int ROWB = F8 ? 1024 : 2048;
    constexpr int nt = ROWB / 128;
    unsigned voffB, voffA0;
    { int R, C; stage_rc(tid * 16, R, C); const int Rb = (R & ~31) + perm32(R & 31); voffA0 = (unsigned)(R * ROWB + C * 2); voffB = (unsigned)(Rb * ROWB + C * 2); }
    constexpr size_t kstep = (size_t)(BK * 2);
    constexpr size_t hstep = (size_t)HALF * ROWB;
    const unsigned ldsw = (unsigned)wid * 1024u; const unsigned ldsbase = (unsigned)(size_t)lds;
    const int fcol = fq * 8;
    const int aoff = lds_byte(wr * 64 + fr, fcol), boff = lds_byte(wc * 32 + fr, fcol);

#define PG8_SA(b, h) (((b) * 2 + (h)) * HTB)
#define PG8_SB(b, h) ((4 + (b) * 2 + (h)) * HTB)
#define PG8_STAGE(bufoff, gbase, voff) glds16x2((const char*)(gbase), (const char*)(gbase) + 64 * ROWB, (voff), ldsbase + (unsigned)(bufoff) + ldsw)
#define PG8_STAGE_A(bufoff, gbase, vv) do { if constexpr (GATHER) glds16x2g((const char*)(gbase), (vv)[0], (vv)[1], ldsbase + (unsigned)(bufoff) + ldsw); else PG8_STAGE(bufoff, gbase, (vv)[0]); } while (0)
#define PG8_LDA(dst, b, h) do { if constexpr (F8) { _Pragma("unroll") for (int m = 0; m < 4; ++m) dst##8[m] = cat32(*(const LAS bf16x8*)(lds + PG8_SA(b, h) + aoff + m * 2048), *(const LAS bf16x8*)(lds + PG8_SA(b, h) + aoff + m * 2048 + 1024)); } \
        else { _Pragma("unroll") for (int m = 0; m < 4; ++m) _Pragma("unroll") for (int k = 0; k < 2; ++k) dst[m][k] = *(const LAS bf16x8*)(lds + PG8_SA(b, h) + aoff + m * 2048 + k * 1024); } } while (0)
#define PG8_LDB(dst, b, h) do { if constexpr (F8) { _Pragma("unroll") for (int n = 0; n < 2; ++n) dst##8[n] = cat32(*(const LAS bf16x8*)(lds + PG8_SB(b, h) + boff + n * 2048), *(const LAS bf16x8*)(lds + PG8_SB(b, h) + boff + n * 2048 + 1024)); } \
        else { _Pragma("unroll") for (int n = 0; n < 2; ++n) _Pragma("unroll") for (int k = 0; k < 2; ++k) dst[n][k] = *(const LAS bf16x8*)(lds + PG8_SB(b, h) + boff + n * 2048 + k * 1024); } } while (0)
#define PG8_MMA(ai, bj, At, Bt) do { __builtin_amdgcn_s_setprio(1); _Pragma("unroll") for (int m = 0; m < 4; ++m) _Pragma("unroll") for (int n = 0; n < 2; ++n) { \
        if constexpr (F8) asm volatile("v_mfma_scale_f32_16x16x128_f8f6f4 %0, %1, %2, %0, %3, %3 op_sel_hi:[0,0,0]" : "+v"(acc[ai][bj][m][n]) : "v"(Bt##8[n]), "v"(At##8[m]), "v"(scl8)); \
        else { _Pragma("unroll") for (int k = 0; k < 2; ++k) acc[ai][bj][m][n] = __builtin_amdgcn_mfma_f32_16x16x32_bf16(Bt[n][k], At[m][k], acc[ai][bj][m][n], 0, 0, 0); } } __builtin_amdgcn_s_setprio(0); } while (0)
#define PG8_WAIT_V(n) asm volatile("s_waitcnt vmcnt(" #n ")" ::: "memory")
#define PG8_WAIT_L(n) asm volatile("s_waitcnt lgkmcnt(" #n ")" ::: "memory")
#define PG8_WAIT_VR(relax) do { if constexpr (Epi::NST == 16) { if (relax) PG8_WAIT_V(24); else PG8_WAIT_V(8); } else if constexpr (Epi::NST == 8) { if (relax) PG8_WAIT_V(16); else PG8_WAIT_V(8); } else PG8_WAIT_V(8); } while (0)
#define PG8_BAR __builtin_amdgcn_s_barrier()
#define PG8_SCHED __builtin_amdgcn_sched_barrier(0)
    UnitD cur, nxt; int ui = 0; bool relaxU = false;
    if (!S.next(0, cur)) return;
    f32x4 acc[2][2][4][2];
    bf16x8 At[4][2], B0[2][2], B1[2][2]; i32x8 At8[4], B08[2], B18[2]; unsigned scl8 = 0x7F7F7F7Fu; asm volatile("" : "+v"(scl8));
    unsigned vA[2][2], vN[2][2], vNN[2][2];
    constexpr size_t ah = GATHER ? 0 : hstep;
    if constexpr (GATHER) { UnitD nn; S.rows(cur, tid, vA); const bool has_nn = S.next(1, nn); if (has_nn) S.rows(nn, tid, vN);
#pragma unroll
        for (int h = 0; h < 2; ++h)
#pragma unroll
            for (int i = 0; i < 2; ++i) { if (!has_nn) vN[h][i] = vA[h][i]; vNN[h][i] = vN[h][i]; vA[h][i] = S.off(vA[h][i], voffB & 127u); vN[h][i] = S.off(vN[h][i], voffB & 127u); } }
    else {
#pragma unroll
        for (int h = 0; h < 2; ++h)
#pragma unroll
            for (int i = 0; i < 2; ++i) { vA[h][i] = voffA0; vN[h][i] = voffA0; vNN[h][i] = voffA0; }
    }
    const char* cA = cur.A; const char* cB = cur.B;
    typename Epi::Pre preN;
    { int l2 = (int)__builtin_amdgcn_mbcnt_hi(~0u, __builtin_amdgcn_mbcnt_lo(~0u, 0u)); asm volatile("" : "+v"(l2)); preN = E.pre(cur, wr, wc, l2 & 15, l2 >> 4); E.init(acc, preN, cur); }
    PG8_STAGE(PG8_SB(0, 0), cB, voffB); PG8_STAGE(PG8_SB(0, 1), cB + hstep, voffB); PG8_STAGE_A(PG8_SA(0, 0), cA, vA[0]); PG8_STAGE_A(PG8_SA(0, 1), cA + ah, vA[1]);
    if (wr == 1) PG8_BAR;
    PG8_WAIT_V(2); PG8_BAR;
    PG8_STAGE(PG8_SB(1, 0), cB + kstep, voffB); PG8_STAGE_A(PG8_SA(1, 0), cA + kstep, vA[0]); PG8_STAGE(PG8_SB(1, 1), cB + hstep + kstep, voffB);
    PG8_WAIT_V(6); PG8_BAR;
    for (;;) {
        const bool has_next = S.next(ui + 1, nxt);
        const char* nA = has_next ? nxt.A : cA; const char* nB = has_next ? nxt.B : cB;
        if constexpr (GATHER) { UnitD n2; if (S.next(ui + 2, n2)) S.rows(n2, tid, vNN); }
#pragma unroll 1
        for (int t = 0; t < nt; t += 2) {
            const bool last = (t == nt - 2);
            const char* a1 = cA + (size_t)(t + 1) * kstep;
            const char* a2 = last ? nA : cA + (size_t)(t + 2) * kstep; const char* b2 = last ? nB : cB + (size_t)(t + 2) * kstep;
            const char* a3 = a2 + kstep; const char* b3 = b2 + kstep;
            unsigned v2[2][2];
#pragma unroll
            for (int h = 0; h < 2; ++h)
#pragma unroll
                for (int i = 0; i < 2; ++i) v2[h][i] = GATHER ? (last ? vN[h][i] : vA[h][i]) : vA[h][i];
            const bool relax = relaxU && (t == 0);
            PG8_LDB(B0, 0, 0); PG8_LDB(B1, 0, 1); PG8_SCHED; PG8_LDA(At, 0, 0); PG8_STAGE_A(PG8_SA(1, 1), a1 + ah, vA[1]);
            PG8_WAIT_VR(relax); PG8_WAIT_L(0); PG8_BAR; PG8_MMA(0, 0, At, B0); PG8_MMA(0, 1, At, B1); PG8_BAR; PG8_SCHED;
            PG8_LDA(At, 0, 1); PG8_STAGE(PG8_SB(0, 0), b2, voffB); PG8_STAGE(PG8_SB(0, 1), b2 + hstep, voffB); PG8_STAGE_A(PG8_SA(0, 0), a2, v2[0]);
            PG8_WAIT_VR(relax); PG8_WAIT_L(0); PG8_BAR; PG8_MMA(1, 0, At, B0); PG8_MMA(1, 1, At, B1); PG8_BAR; PG8_SCHED;
            PG8_LDB(B0, 1, 0); PG8_LDB(B1, 1, 1); PG8_SCHED; PG8_LDA(At, 1, 0); PG8_STAGE_A(PG8_SA(0, 1), a2 + ah, v2[1]);
            PG8_WAIT_V(8); PG8_WAIT_L(0); PG8_BAR; PG8_MMA(0, 0, At, B0); PG8_MMA(0, 1, At, B1); PG8_BAR; PG8_SCHED;
            PG8_LDA(At, 1, 1); PG8_STAGE(PG8_SB(1, 0), b3, voffB); PG8_STAGE(PG8_SB(1, 1), b3 + hstep, voffB); PG8_STAGE_A(PG8_SA(1, 0), a3, v2[0]);
            PG8_WAIT_V(8); PG8_WAIT_L(0); PG8_BAR; PG8_MMA(1, 0, At, B0); PG8_MMA(1, 1, At, B1); PG8_BAR; PG8_SCHED;
        }
        if (wr == 0) PG8_BAR;
        if constexpr (F8) asm volatile("s_nop 15\n\ts_nop 15" ::: "memory");
        { int l2 = (int)__builtin_amdgcn_mbcnt_hi(~0u, __builtin_amdgcn_mbcnt_lo(~0u, 0u)); asm volatile("" : "+v"(l2)); preN = E.pre(has_next ? nxt : cur, wr, wc, l2 & 15, l2 >> 4); E(acc, cur, wr, wc, l2 & 15, l2 >> 4); }
        if (!has_next) break;
        E.init(acc, preN, nxt);
        relaxU = E.stored(cur, wc);
        cur = nxt; cA = nA; cB = nB; ++ui;
#pragma unroll
        for (int h = 0; h < 2; ++h)
#pragma unroll
            for (int i = 0; i < 2; ++i) { vA[h][i] = vN[h][i]; vN[h][i] = GATHER ? S.off(vNN[h][i], voffB & 127u) : vNN[h][i]; }
        asm volatile("" :: "v"(acc[0][0][0][0]), "v"(acc[0][0][0][1]), "v"(acc[0][1][0][0]), "v"(acc[0][1][0][1]), "v"(vN[0][0]), "v"(vN[0][1]), "v"(vN[1][0]), "v"(vN[1][1]) : "memory");
        if (wr == 1) PG8_BAR;
    }
    PG8_WAIT_V(0);
    PG8_BAR;
#undef PG8_SA
#undef PG8_SB
#undef PG8_STAGE
#undef PG8_STAGE_A
#undef PG8_LDA
#undef PG8_LDB
#undef PG8_MMA
#undef PG8_WAIT_V
#undef PG8_WAIT_VR
#undef PG8_WAIT_L
#undef PG8_BAR
#undef PG8_SCHED
}

HD v4u pack8(const f32x4 a, const f32x4 b) { v4u w; w.x = pk2(a[0], a[1]); w.y = pk2(a[2], a[3]); w.z = pk2(b[0], b[1]); w.w = pk2(b[2], b[3]); return w; }
typedef f32x4 AccT[2][2][4][2];
struct Pre16 { f32x4 v[4]; };
struct Pre0 {};
HD void acc_zero(AccT& acc) {
#pragma unroll
    for (int a = 0; a < 2; ++a)
#pragma unroll
        for (int b = 0; b < 2; ++b)
#pragma unroll
            for (int m = 0; m < 4; ++m)
#pragma unroll
                for (int n = 0; n < 2; ++n) acc[a][b][m][n] = (f32x4){0.f, 0.f, 0.f, 0.f};
}
HD void acc_colbias(AccT& acc, const Pre16& p, float s) {
    f32x4 q[4];
#pragma unroll
    for (int k = 0; k < 4; ++k) q[k] = p.v[k] * s;
#pragma unroll
    for (int a = 0; a < 2; ++a)
#pragma unroll
        for (int b = 0; b < 2; ++b)
#pragma unroll
            for (int m = 0; m < 4; ++m)
#pragma unroll
                for (int n = 0; n < 2; ++n) acc[a][b][m][n] = q[b * 2 + n];
}

struct EpiBf16 {
    bf16* O; int ldc; const float* bias; int nscale; float scale;
    static constexpr int NST = 16; HD bool stored(const UnitD&, int) const { return true; }
    typedef Pre16 Pre;
    HD Pre pre(const UnitD& u, int wr, int wc, int fr, int fq) const { Pre p; const int col0 = u.pn * 256 + wc * 32 + 8 * fq;
#pragma unroll
        for (int bj = 0; bj < 2; ++bj)
#pragma unroll
            for (int n = 0; n < 2; ++n) p.v[bj * 2 + n] = *(const f32x4*)((bias ? bias : (const float*)O) + col0 + bj * HALF + 4 * n);
        return p; }
    HD void init(AccT& acc, const Pre& p, const UnitD& u) const { if (bias) acc_colbias(acc, p, 1.f / ((u.pn < nscale) ? scale : 1.f)); else acc_zero(acc); }
    HD void operator()(const AccT& acc, const UnitD& u, int wr, int wc, int fr, int fq) const {
        const int row0 = u.rowbase + wr * 64 + fr, col0 = u.pn * 256 + wc * 32 + 8 * fq;
        const float sc = (u.pn < nscale) ? scale : 1.f;
#pragma unroll
        for (int ai = 0; ai < 2; ++ai)
#pragma unroll
            for (int m = 0; m < 4; ++m) { bf16* rowp = O + (size_t)(row0 + ai * HALF + m * 16) * ldc + col0;
#pragma unroll
                for (int bj = 0; bj < 2; ++bj) *(v4u*)(rowp + bj * HALF) = pack8(acc[ai][bj][m][0] * sc, acc[ai][bj][m][1] * sc); }
    }
};
struct EpiGlaIn {
    bf16* O; float* glow; float qscale; float ascale;
    static constexpr int NST = 16; HD bool stored(const UnitD& u, int wc) const { return u.pn < 12 || wc == 0; }
    typedef Pre0 Pre; HD Pre pre(const UnitD&, int, int, int, int) const { return Pre(); }
    HD void init(AccT& acc, const Pre&, const UnitD&) const { acc_zero(acc); }
    HD void operator()(const AccT& acc, const UnitD& u, int wr, int wc, int fr, int fq) const {
        const int row0 = u.rowbase + wr * 64 + fr;
        if (u.pn < 12) {
            const int col0 = u.pn * 256 + wc * 32 + 8 * fq; const float sc = ((u.pn < 2) ? qscale : 1.f) * ascale;
#pragma unroll
            for (int ai = 0; ai < 2; ++ai)
#pragma unroll
                for (int m = 0; m < 4; ++m) { bf16* rowp = O + (size_t)(row0 + ai * HALF + m * 16) * 3072 + col0;
#pragma unroll
                    for (int bj = 0; bj < 2; ++bj) *(v4u*)(rowp + bj * HALF) = pack8(acc[ai][bj][m][0] * sc, acc[ai][bj][m][1] * sc); }
        } else if (wc == 0) {
#pragma unroll
            for (int ai = 0; ai < 2; ++ai)
#pragma unroll
                for (int m = 0; m < 4; ++m) { float* rowp = glow + (size_t)(row0 + ai * HALF + m * 16) * 32 + 8 * fq;
                    *(f32x4*)(rowp) = acc[ai][0][m][0] * ascale; *(f32x4*)(rowp + 4) = acc[ai][0][m][1] * ascale; }
        }
    }
};
struct EpiF32Cols32 {
    float* O;
    static constexpr int NST = 0; HD bool stored(const UnitD&, int) const { return false; }
    typedef Pre0 Pre; HD Pre pre(const UnitD&, int, int, int, int) const { return Pre(); }
    HD void init(AccT& acc, const Pre&, const UnitD&) const { acc_zero(acc); }
    HD void operator()(const AccT& acc, const UnitD& u, int wr, int wc, int fr, int fq) const {
        if (u.pn != 0 || wc != 0) return;
        const int row0 = u.rowbase + wr * 64 + fr;
#pragma unroll
        for (int ai = 0; ai < 2; ++ai)
#pragma unroll
            for (int m = 0; m < 4; ++m) { float* rowp = O + (size_t)(row0 + ai * HALF + m * 16) * 32 + 8 * fq;
                *(f32x4*)(rowp) = acc[ai][0][m][0]; *(f32x4*)(rowp + 4) = acc[ai][0][m][1]; }
    }
};
struct EpiHyIn {
    bf16* O; const float* bias; float ascale;
    static constexpr int NST = 16; HD bool stored(const UnitD&, int) const { return true; }
    typedef Pre16 Pre;
    HD Pre pre(const UnitD& u, int wr, int wc, int fr, int fq) const { Pre p; const int row0 = u.rowbase + wr * 64 + fr;
#pragma unroll
        for (int ai = 0; ai < 2; ++ai)
#pragma unroll
            for (int m = 0; m < 4; ++m) p.v[ai][m] = bias[row0 + ai * HALF + m * 16];
        p.v[2] = (f32x4){0.f, 0.f, 0.f, 0.f}; p.v[3] = p.v[2]; return p; }
    HD void init(AccT& acc, const Pre& p, const UnitD&) const {
#pragma unroll
        for (int a = 0; a < 2; ++a)
#pragma unroll
            for (int b = 0; b < 2; ++b)
#pragma unroll
                for (int m = 0; m < 4; ++m)
#pragma unroll
                    for (int n = 0; n < 2; ++n) { const float v = p.v[a][m] * (1.f / ascale); acc[a][b][m][n] = (f32x4){v, v, v, v}; } }
    HD void operator()(const AccT& acc, const UnitD& u, int wr, int wc, int fr, int fq) const {
        const int row0 = u.rowbase + wr * 64 + fr, col0 = u.pn * 256 + wc * 32 + 8 * fq;
#pragma unroll
        for (int ai = 0; ai < 2; ++ai)
#pragma unroll
            for (int m = 0; m < 4; ++m) { const int r = row0 + ai * HALF + m * 16; bf16* rowp = O + (size_t)r * M + col0;
#pragma unroll
                for (int bj = 0; bj < 2; ++bj) *(v4u*)(rowp + bj * HALF) = pack8(acc[ai][bj][m][0] * ascale, acc[ai][bj][m][1] * ascale); }
    }
};
struct EpiNaIn {
    bf16* O; size_t tstride; const float* bias; float qscale; float ascale;
    static constexpr int NST = 16; HD bool stored(const UnitD&, int) const { return true; }
    typedef Pre16 Pre;
    HD Pre pre(const UnitD& u, int wr, int wc, int fr, int fq) const { Pre p;
#pragma unroll
        for (int bj = 0; bj < 2; ++bj) { const int bcol = u.pn * 256 + bj * HALF + wc * 32 + 8 * fq; p.v[bj * 2] = *(const f32x4*)(bias + bcol); p.v[bj * 2 + 1] = *(const f32x4*)(bias + bcol + 4); }
        return p; }
    HD void init(AccT& acc, const Pre& p, const UnitD&) const { acc_colbias(acc, p, 1.f / ascale); }
    HD void operator()(const AccT& acc, const UnitD& u, int wr, int wc, int fr, int fq) const {
        const int row0 = u.rowbase + wr * 64 + fr; const float sc = (u.pn < 4) ? qscale : 1.f;
        const int ten = u.pn >> 2; bf16* base = O + (size_t)ten * tstride;
#pragma unroll
        for (int bj = 0; bj < 2; ++bj) {
            const int colt = (u.pn & 3) * 256 + bj * HALF + wc * 32;
            const int h = colt >> 5; const int bcol = u.pn * 256 + bj * HALF + wc * 32 + 8 * fq;
            (void)bcol;
#pragma unroll
            for (int ai = 0; ai < 2; ++ai)
#pragma unroll
                for (int m = 0; m < 4; ++m) { const int r = row0 + ai * HALF + m * 16; const int b = r >> 12, tok = r & 4095;
                    bf16* p = base + ((size_t)(b * 32 + h) * 4096 + tok) * 32 + 8 * fq;
                    *(v4u*)p = pack8(acc[ai][bj][m][0] * (ascale * sc), acc[ai][bj][m][1] * (ascale * sc)); }
        }
    }
};
struct EpiMoe1 {
    bf16* O; const float* bgu;
    static constexpr int NST = 8; HD bool stored(const UnitD&, int) const { return true; }
    typedef Pre16 Pre;
    HD Pre pre(const UnitD& u, int wr, int wc, int fr, int fq) const { Pre p; const float* bb = bgu + (size_t)u.e * 2048 + u.pn * 128 + wc * 32 + 8 * fq;
#pragma unroll
        for (int n = 0; n < 2; ++n) { p.v[n] = *(const f32x4*)(bb + 4 * n); p.v[2 + n] = *(const f32x4*)(bb + 1024 + 4 * n); }
        return p; }
    HD void init(AccT& acc, const Pre& p, const UnitD&) const { acc_colbias(acc, p, 2048.f); }
    HD void operator()(const AccT& acc, const UnitD& u, int wr, int wc, int fr, int fq) const {
        const int row0 = u.rowbase + wr * 64 + fr, colh = u.pn * 128 + wc * 32 + 8 * fq;
#pragma unroll
        for (int ai = 0; ai < 2; ++ai)
#pragma unroll
            for (int m = 0; m < 4; ++m) {
                unsigned w8a[2];
#pragma unroll
                for (int n = 0; n < 2; ++n) { const f32x4 g4 = acc[ai][0][m][n] * 4.8828125e-4f, l4 = acc[ai][1][m][n] * 4.8828125e-4f;
                    f32x2 o2[2];
#pragma unroll
                    for (int jp = 0; jp < 2; ++jp) {
                        const f32x2 gg = (f32x2){fminf(g4[2 * jp], 7.f), fminf(g4[2 * jp + 1], 7.f)};
                        const f32x2 ll = (f32x2){fminf(fmaxf(l4[2 * jp], -7.f), 7.f), fminf(fmaxf(l4[2 * jp + 1], -7.f), 7.f)};
                        const f32x2 t = gg * -2.4554669595930156f;
                        const f32x2 d = (f32x2){__builtin_amdgcn_exp2f(t[0]), __builtin_amdgcn_exp2f(t[1])} + 1.f;
                        const f32x2 r = (f32x2){__builtin_amdgcn_rcpf(d[0]), __builtin_amdgcn_rcpf(d[1])};
                        o2[jp] = (gg * r) * (ll * 4.f + 4.f); }
                    int w = 0; w = __builtin_amdgcn_cvt_pk_fp8_f32(o2[0][0], o2[0][1], w, false); w = __builtin_amdgcn_cvt_pk_fp8_f32(o2[1][0], o2[1][1], w, true); w8a[n] = (unsigned)w; }
                v2u w8; w8.x = w8a[0]; w8.y = w8a[1];
                *(v2u*)((unsigned char*)O + (size_t)(row0 + ai * HALF + m * 16) * 1024 + colh) = w8;
            }
    }
};
struct EpiMoe2 {
    bf16* O; const float* bdn;
    static constexpr int NST = 16; HD bool stored(const UnitD&, int) const { return true; }
    typedef Pre16 Pre;
    HD Pre pre(const UnitD& u, int wr, int wc, int fr, int fq) const { Pre p; const float* bb = bdn + (size_t)u.e * 1024 + u.pn * 256 + wc * 32 + 8 * fq;
#pragma unroll
        for (int bj = 0; bj < 2; ++bj)
#pragma unroll
            for (int n = 0; n < 2; ++n) p.v[bj * 2 + n] = *(const f32x4*)(bb + bj * HALF + 4 * n);
        return p; }
    HD void init(AccT& acc, const Pre& p, const UnitD&) const { acc_colbias(acc, p, 1024.f); }
    HD void operator()(const AccT& acc, const UnitD& u, int wr, int wc, int fr, int fq) const {
        const int row0 = u.rowbase + wr * 64 + fr, col0 = u.pn * 256 + wc * 32 + 8 * fq;
#pragma unroll
        for (int ai = 0; ai < 2; ++ai)
#pragma unroll
            for (int m = 0; m < 4; ++m) { unsigned char* rowp = (unsigned char*)O + (size_t)(row0 + ai * HALF + m * 16) * 1024 + col0;
#pragma unroll
                for (int bj = 0; bj < 2; ++bj) { const f32x4 a0 = acc[ai][bj][m][0] * 0.03125f, a1 = acc[ai][bj][m][1] * 0.03125f; v2u w; w.x = pk4_fp8(a0[0], a0[1], a0[2], a0[3]); w.y = pk4_fp8(a1[0], a1[1], a1[2], a1[3]); *(v2u*)(rowp + bj * HALF) = w; } }
    }
};
}

typedef float cf __attribute__((ext_vector_type(2)));
HD cf cf_mk(float a, float b) { return (cf){a, b}; }
HD cf cadd(cf a, cf b) { return cf_mk(a.x + b.x, a.y + b.y); }
HD cf csub(cf a, cf b) { return cf_mk(a.x - b.x, a.y - b.y); }
HD cf cmul(cf a, cf b) { return cf_mk(a.x * b.x - a.y * b.y, a.x * b.y + a.y * b.x); }
HD cf cmulc(cf a, cf b) { return cf_mk(a.x * b.x + a.y * b.y, a.y * b.x - a.x * b.y); }
template <bool INV> HD void r4(cf& a0, cf& a1, cf& a2, cf& a3) {
    const cf t0 = cadd(a0, a2), t1 = csub(a0, a2), t2 = cadd(a1, a3), t3 = csub(a1, a3);
    a0 = cadd(t0, t2); a2 = csub(t0, t2);
    const cf mit3 = INV ? cf_mk(-t3.y, t3.x) : cf_mk(t3.y, -t3.x);
    a1 = cadd(t1, mit3); a3 = csub(t1, mit3);
}
template <bool INV> HD void dft16(cf (&x)[16]) {
    const float C1 = 0.92387953251128674f, S1 = 0.38268343236508977f, R2 = 0.70710678118654752f;
#pragma unroll
    for (int n0 = 0; n0 < 4; ++n0) r4<INV>(x[n0], x[n0 + 4], x[n0 + 8], x[n0 + 12]);
    const cf w1 = cf_mk(C1, INV ? S1 : -S1), w2 = cf_mk(R2, INV ? R2 : -R2), w3 = cf_mk(S1, INV ? C1 : -C1);
    const cf w4 = cf_mk(0.f, INV ? 1.f : -1.f), w6 = cf_mk(-R2, INV ? R2 : -R2), w9 = cf_mk(-C1, INV ? -S1 : S1);
    x[1 + 4] = cmul(x[1 + 4], w1); x[1 + 8] = cmul(x[1 + 8], w2); x[1 + 12] = cmul(x[1 + 12], w3);
    x[2 + 4] = cmul(x[2 + 4], w2); x[2 + 8] = cmul(x[2 + 8], w4); x[2 + 12] = cmul(x[2 + 12], w6);
    x[3 + 4] = cmul(x[3 + 4], w3); x[3 + 8] = cmul(x[3 + 8], w6); x[3 + 12] = cmul(x[3 + 12], w9);
    cf y[16];
#pragma unroll
    for (int k0 = 0; k0 < 4; ++k0) {
        cf b0 = x[0 + 4 * k0], b1 = x[1 + 4 * k0], b2 = x[2 + 4 * k0], b3 = x[3 + 4 * k0];
        r4<INV>(b0, b1, b2, b3);
        y[k0] = b0; y[k0 + 4] = b1; y[k0 + 8] = b2; y[k0 + 12] = b3;
    }
#pragma unroll
    for (int i = 0; i < 16; ++i) x[i] = y[i];
}
#define FFT_HALF_STRIDE 4352
#define FFT_LDS_COMPLEX (2 * FFT_HALF_STRIDE)
constexpr int FFT_TW_OFF = FFT_LDS_COMPLEX * 8;
static_assert(FFT_TW_OFF + 32768 <= RING_BYTES, "fft lds");
HD int fpos(int hf, int p) { return hf * FFT_HALF_STRIDE + p + (p >> 4); }
HD cf tw8192(const LAS cf* TW, int i) { i &= 8191; const cf t = TW[i & 4095]; return (i & 4096) ? cf_mk(-t.x, -t.y) : t; }
HD void fft_fwd_p1(LAS cf* buf, const LAS cf* TW, int tid) {
    const int hf = tid >> 8, j = tid & 255; cf x[16];
#pragma unroll
    for (int n2 = 0; n2 < 16; ++n2) x[n2] = buf[fpos(hf, n2 * 256 + j)];
    dft16<false>(x);
#pragma unroll
    for (int k0 = 0; k0 < 16; ++k0) { const cf v = k0 ? cmul(x[k0], tw8192(TW, 2 * j * k0)) : x[0]; buf[fpos(hf, k0 * 256 + j)] = v; }
}
HD void fft_fwd_p2(LAS cf* buf, const LAS cf* TW, int tid) {
    const int hf = tid >> 8, j = tid & 255, k0 = j >> 4, n0 = j & 15; cf x[16];
#pragma unroll
    for (int n1 = 0; n1 < 16; ++n1) x[n1] = buf[fpos(hf, k0 * 256 + n1 * 16 + n0)];
    dft16<false>(x);
#pragma unroll
    for (int k1 = 0; k1 < 16; ++k1) { const cf v = k1 ? cmul(x[k1], tw8192(TW, 32 * n0 * k1)) : x[0]; buf[fpos(hf, k0 * 256 + k1 * 16 + n0)] = v; }
}
HD void fft_fwd_p3(LAS cf* buf, int tid, cf (&x)[16]) {
    const int hf = tid >> 8, j = tid & 255;
#pragma unroll
    for (int n0 = 0; n0 < 16; ++n0) x[n0] = buf[fpos(hf, 16 * j + n0)];
    dft16<false>(x);
}
HD void fft_inv_p1(LAS cf* buf, int tid, cf (&x)[16]) {
    const int hf = tid >> 8, j = tid & 255;
    dft16<true>(x);
#pragma unroll
    for (int n0 = 0; n0 < 16; ++n0) buf[fpos(hf, 16 * j + n0)] = x[n0];
}
HD void fft_inv_p2(LAS cf* buf, const LAS cf* TW, int tid) {
    const int hf = tid >> 8, j = tid & 255, k0 = j >> 4, n0 = j & 15; cf x[16];
#pragma unroll
    for (int k1 = 0; k1 < 16; ++k1) { const cf v = buf[fpos(hf, k0 * 256 + k1 * 16 + n0)]; x[k1] = k1 ? cmulc(v, tw8192(TW, 32 * n0 * k1)) : v; }
    dft16<true>(x);
#pragma unroll
    for (int n1 = 0; n1 < 16; ++n1) buf[fpos(hf, k0 * 256 + n1 * 16 + n0)] = x[n1];
}
HD void fft_inv_p3(LAS cf* buf, const LAS cf* TW, int tid) {
    const int hf = tid >> 8, j = tid & 255; cf x[16];
#pragma unroll
    for (int k0 = 0; k0 < 16; ++k0) { const cf v = buf[fpos(hf, k0 * 256 + j)]; x[k0] = k0 ? cmulc(v, tw8192(TW, 2 * j * k0)) : v; }
    dft16<true>(x);
#pragma unroll
    for (int n2 = 0; n2 < 16; ++n2) buf[fpos(hf, n2 * 256 + j)] = x[n2];
}

struct Args { const float* in[34]; float* out; unsigned char* ws; int ph_lo, ph_hi; };
typedef const Args __attribute__((address_space(4)))* ArgsP;
HD ArgsP argp() { ArgsP p = (ArgsP)__builtin_amdgcn_kernarg_segment_ptr(); asm volatile("" : "+s"(p)); return p; }
struct Frame {
    LAS unsigned char* lds; unsigned char* ws; unsigned* ctl;
    int tid, lane, wave, G, gw, NGW;
};
HD Frame mkframe(ArgsP a, LAS unsigned char* lds) {
    Frame F; { unsigned lb = (unsigned)(size_t)lds; asm volatile("" : "+s"(lb)); lds = (LAS unsigned char*)(size_t)lb; }
    int tid = my_tid(lds); asm volatile("" : "+v"(tid));
    F.lds = lds; F.ws = a->ws; F.ctl = (unsigned*)(a->ws + WS_CTL);
    F.tid = tid; F.lane = tid & 63; F.wave = __builtin_amdgcn_readfirstlane(tid >> 6); F.G = gridDim.x; F.gw = blockIdx.x * NWAVES + F.wave; F.NGW = F.G * NWAVES;
    return F;
}
enum { IN_X = 0, IN_LN1G, IN_LN1B, IN_LN2G, IN_LN2B, IN_GWIN, IN_GW2, IN_GGB, IN_GNG, IN_GWOUT, IN_HWIN, IN_HBIN, IN_HCW, IN_HCB, IN_HW1, IN_HB1, IN_HSF, IN_HW2, IN_HB2, IN_HW3, IN_HFB,
       IN_HWOUT, IN_HBOUT, IN_NWIN, IN_NBIN, IN_NRPB, IN_NWOUT, IN_NBOUT, IN_RW, IN_RB, IN_WGU, IN_BGU, IN_WDN, IN_BDN };

HD void transpose_item(const float* W, int Kd, int N, bf16* WT, int item, int mode, LAS float* scr, int lane) {
    const int nblk = N / 32, kb = item / nblk, nb = item % nblk, k0 = 64 * kb, n0 = 32 * nb;
    float stg[32];
#pragma unroll
    for (int i = 0; i < 32; ++i) { const int kk = 2 * i + (lane >> 5); stg[i] = W[(size_t)(k0 + kk) * N + n0 + (lane & 31)]; }
#pragma unroll
    for (int i = 0; i < 32; ++i) { const int kk = 2 * i + (lane >> 5); scr[kk * 33 + (lane & 31)] = stg[i]; }
    LDS_WAIT(); asm volatile("" ::: "memory");
    int r0 = n0;
    if (mode == 1) r0 = (n0 < 1024) ? 256 * (n0 >> 7) + (n0 & 127) : 256 * ((n0 - 1024) >> 7) + 128 + ((n0 - 1024) & 127);
    const int c = lane & 7;
#pragma unroll
    for (int j = 0; j < 4; ++j) { const int n = (lane >> 3) + 8 * j; const LAS float* s = scr + (8 * c) * 33 + n;
        v4u o; o.x = pk2(s[0 * 33], s[1 * 33]); o.y = pk2(s[2 * 33], s[3 * 33]); o.z = pk2(s[4 * 33], s[5 * 33]); o.w = pk2(s[6 * 33], s[7 * 33]);
        *(v4u*)(WT + (size_t)(r0 + n) * Kd + k0 + 8 * c) = o; }
    LDS_WAIT(); asm volatile("" ::: "memory");
}
HD void transpose_item8(const float* W, int N, unsigned char* WT, int item, int mode, float scale, LAS float* scr, int lane) {
    const int nblk = N / 32, kb = item / nblk, nb = item % nblk, k0 = 64 * kb, n0 = 32 * nb;
    float stg[32];
#pragma unroll
    for (int i = 0; i < 32; ++i) { const int kk = 2 * i + (lane >> 5); stg[i] = W[(size_t)(k0 + kk) * N + n0 + (lane & 31)]; }
#pragma unroll
    for (int i = 0; i < 32; ++i) { const int kk = 2 * i + (lane >> 5); scr[kk * 33 + (lane & 31)] = stg[i]; }
    LDS_WAIT(); asm volatile("" ::: "memory");
    int r0 = n0;
    if (mode == 1) r0 = (n0 < 1024) ? 256 * (n0 >> 7) + (n0 & 127) : 256 * ((n0 - 1024) >> 7) + 128 + ((n0 - 1024) & 127);
    const int n = lane >> 1, hh = lane & 1; const LAS float* sp = scr + (32 * hh) * 33 + n;
    v4u o[2];
#pragma unroll
    for (int q = 0; q < 2; ++q)
#pragma unroll
        for (int d = 0; d < 4; ++d) { const int kk = 16 * q + 4 * d; o[q][d] = pk4_fp8(sp[kk * 33] * scale, sp[(kk + 1) * 33] * scale, sp[(kk + 2) * 33] * scale, sp[(kk + 3) * 33] * scale); }
    unsigned char* dst = WT + (size_t)(r0 + n) * 1024 + k0 + 32 * hh;
    *(v4u*)dst = o[0]; *(v4u*)(dst + 16) = o[1];
    LDS_WAIT(); asm volatile("" ::: "memory");
}
HD void p0_prologue(const Frame& F, ArgsP a) {
    LAS float* scr = (LAS float*)(F.lds + F.wave * 16384);
    bf16* wgin = (bf16*)(F.ws + WS_WGIN); bf16* wgout = (bf16*)(F.ws + WS_WGOUT); bf16* whin = (bf16*)(F.ws + WS_WHIN); bf16* whout = (bf16*)(F.ws + WS_WHOUT);
    bf16* wnin = (bf16*)(F.ws + WS_WNIN); bf16* wnout = (bf16*)(F.ws + WS_WNOUT); bf16* wr = (bf16*)(F.ws + WS_WR); unsigned char* wgu = F.ws + WS_WGU; unsigned char* wdn = F.ws + WS_WDN;
    constexpr int I_GIN = 16 * 97, I_SQ = 16 * 32, I_IN3 = 16 * 96, I_R = 16, I_GU = 16 * 64;
    constexpr int NSMALL = 2 * I_GIN + 2 * I_SQ + I_IN3 + I_SQ + I_IN3 + I_SQ + 4 * I_R;
    constexpr int NITEMS = NSMALL + 128 * I_GU + 128 * I_SQ;
    for (int it = F.gw; it < NITEMS; it += F.NGW) {
        int r = it;
        if (r < 2 * I_GIN) { const int j = r / I_GIN; if (FP8_GLA) transpose_item8(a->in[IN_GWIN] + (size_t)j * 1024 * GLA_NIN, GLA_NIN, (unsigned char*)wgin + (size_t)j * GLA_NPAD * 1024, r % I_GIN, 0, 128.f, scr, F.lane); else transpose_item(a->in[IN_GWIN] + (size_t)j * 1024 * GLA_NIN, 1024, GLA_NIN, wgin + (size_t)j * GLA_NPAD * 1024, r % I_GIN, 0, scr, F.lane); continue; } r -= 2 * I_GIN;
        if (r < 2 * I_SQ) { const int j = r / I_SQ; transpose_item(a->in[IN_GWOUT] + (size_t)j * 1024 * 1024, 1024, 1024, wgout + (size_t)j * 1024 * 1024, r % I_SQ, 0, scr, F.lane); continue; } r -= 2 * I_SQ;
        if (r < I_IN3) { if (FP8_HY) transpose_item8(a->in[IN_HWIN], 3072, (unsigned char*)whin, r, 0, 128.f, scr, F.lane); else transpose_item(a->in[IN_HWIN], 1024, 3072, whin, r, 0, scr, F.lane); continue; } r -= I_IN3;
        if (r < I_SQ) { transpose_item(a->in[IN_HWOUT], 1024, 1024, whout, r, 0, scr, F.lane); continue; } r -= I_SQ;
        if (r < I_IN3) { if (FP8_NA) transpose_item8(a->in[IN_NWIN], 3072, (unsigned char*)wnin, r, 0, 128.f, scr, F.lane); else transpose_item(a->in[IN_NWIN], 1024, 3072, wnin, r, 0, scr, F.lane); continue; } r -= I_IN3;
        if (r < I_SQ) { if (FP8_NAOUT) transpose_item8(a->in[IN_NWOUT], 1024, (unsigned char*)wnout, r, 0, 256.f, scr, F.lane); else transpose_item(a->in[IN_NWOUT], 1024, 1024, wnout, r, 0, scr, F.lane); continue; } r -= I_SQ;
        if (r < 4 * I_R) { const int j = r / I_R; transpose_item(a->in[IN_RW] + (size_t)j * 1024 * 32, 1024, 32, wr + (size_t)j * 256 * 1024, r % I_R, 0, scr, F.lane); continue; } r -= 4 * I_R;
        if (r < 128 * I_GU) { const int j = r / I_GU; transpose_item8(a->in[IN_WGU] + (size_t)j * 1024 * 2048, 2048, wgu + (size_t)j * 2048 * 1024, r % I_GU, 1, 128.f, scr, F.lane); continue; } r -= 128 * I_GU;
        { const int j = r / I_SQ; transpose_item8(a->in[IN_WDN] + (size_t)j * 1024 * 1024, 1024, wdn + (size_t)j * 1024 * 1024, r % I_SQ, 0, 256.f, scr, F.lane); }
    }
    { const f32x4* x4 = (const f32x4*)a->in[IN_X]; v2u* o = (v2u*)(F.ws + WS_XAB); unsigned* o8 = (unsigned*)(F.ws + WS_X8);
      for (size_t i = (size_t)blockIdx.x * NT + F.tid; i < (size_t)M * D / 4; i += (size_t)F.G * NT) { const f32x4 v = x4[i];
          if (FP8_GLA) o8[i] = pk4_fp8(v[0] * 16.f, v[1] * 16.f, v[2] * 16.f, v[3] * 16.f); else { v2u w; w.x = pk2(v[0], v[1]); w.y = pk2(v[2], v[3]); o[i] = w; } } }
}
HD void p0_hyena_filters(const Frame& F, ArgsP a) {
    __syncthreads();
    constexpr int TB = 16;
    LAS float* pe = (LAS float*)(F.lds);
    LAS float* h1 = pe + TB * 33 + 16;
    LAS float* h2 = h1 + TB * 64;
    const float* w1 = a->in[IN_HW1]; const float* b1 = a->in[IN_HB1]; const float* sf = a->in[IN_HSF]; const float* w2 = a->in[IN_HW2]; const float* b2 = a->in[IN_HB2]; const float* w3 = a->in[IN_HW3];
    float* hfb = (float*)(F.ws + WS_HFB);
    for (int item = blockIdx.x; item < (SEQ / TB) * 8; item += F.G) {
        const int tb = item >> 3, cb = item & 7, t0 = tb * TB;
        for (int i = F.tid; i < TB * 33; i += NT) { const int tt = i / 33, q = i % 33; const float t = (float)(t0 + tt); float v;
            if (q == 0) v = t / 4095.f;
            else { const int bnd = (q - 1) & 15; const float fr = 1e-4f + (float)bnd * ((15.f - 1e-4f) / 15.f); const float rev = t * fr * (1.f / 4096.f); v = (q <= 16) ? cos_rev(rev) : -sin_rev(rev); }
            pe[tt * 33 + q] = v; }
        __syncthreads();
        { const int tt = F.tid >> 5, j0 = (F.tid & 31) * 2;
#pragma unroll
          for (int q = 0; q < 2; ++q) { const int j = j0 + q; float z = b1[j];
#pragma unroll 1
              for (int i = 0; i < 33; ++i) z += pe[tt * 33 + i] * w1[i * 64 + j];
              h1[tt * 64 + j] = sin_rad(sf[j] * z); } }
        __syncthreads();
        { const int tt = F.tid >> 5, j0 = (F.tid & 31) * 2;
#pragma unroll
          for (int q = 0; q < 2; ++q) { const int j = j0 + q; float z = b2[j];
#pragma unroll 1
              for (int k = 0; k < 64; ++k) z += h1[tt * 64 + k] * w2[k * 64 + j];
              h2[tt * 64 + j] = sin_rad(sf[64 + j] * z); } }
        __syncthreads();
        { const int col = cb * 512 + F.tid; float acc[TB];
#pragma unroll
          for (int tt = 0; tt < TB; ++tt) acc[tt] = 0.f;
#pragma unroll 2
          for (int k = 0; k < 64; ++k) { const float w = w3[(size_t)k * 4096 + col];
#pragma unroll
              for (int tt = 0; tt < TB; ++tt) acc[tt] += h2[tt * 64 + k] * w; }
          const int o = col >> 11, dir = (col >> 10) & 1, d = col & 1023;
          const float delta = 3.0701134573253944f + (float)d * ((15.350567286626972f - 3.0701134573253944f) / 1023.f);
          float* dst = hfb + ((size_t)dir * 2048 + o * 1024 + d) * 4096 + t0;
#pragma unroll
          for (int q = 0; q < TB / 4; ++q) { f32x4 v;
#pragma unroll
              for (int j = 0; j < 4; ++j) { const int tt = 4 * q + j; const float tn = (float)(t0 + tt) / 4095.f; v[j] = acc[tt] * (__expf(-tn * delta) + 0.05f); }
              *(f32x4*)(dst + 4 * q) = v; } }
        __syncthreads();
    }
}
HD void fft_build_tw(const Frame& F) {
    LAS cf* TW = (LAS cf*)(F.lds + FFT_TW_OFF);
    for (int i = F.tid; i < 4096; i += NT) { const float r = (float)i * (1.f / 8192.f); TW[i] = cf_mk(__builtin_amdgcn_cosf(r), -__builtin_amdgcn_sinf(r)); }
    __syncthreads();
}
HD void hyena_filter_fft(const Frame& F) {
    LAS cf* buf = (LAS cf*)F.lds; const LAS cf* TW = (const LAS cf*)(F.lds + FFT_TW_OFF);
    const float* hfb = (const float*)(F.ws + WS_HFB); cf* spec = (cf*)(F.ws + WS_HSPEC);
    fft_build_tw(F);
    for (int od = blockIdx.x; od < 2048; od += F.G) {
        const float* hf = hfb + (size_t)od * 4096; const float* hb = hfb + ((size_t)2048 + od) * 4096;
#pragma unroll
        for (int i = 0; i < 8; ++i) { const int n = F.tid + 512 * i; const float xa = hf[n], xb = (n == 0) ? 0.f : hb[4096 - n];
            buf[fpos(0, n)] = cf_mk(xa + xb, 0.f); buf[fpos(1, n)] = cmul(cf_mk(xa - xb, 0.f), tw8192(TW, n)); }
        __syncthreads();
        fft_fwd_p1(buf, TW, F.tid); __syncthreads();
        fft_fwd_p2(buf, TW, F.tid); __syncthreads();
        { cf x[16]; fft_fwd_p3(buf, F.tid, x); cf* dst = spec + (size_t)od * 8192 + (F.tid >> 8) * 4096 + 16 * (F.tid & 255);
#pragma unroll
          for (int k = 0; k < 8; ++k) *(f32x4*)(dst + 2 * k) = (f32x4){x[2 * k].x, x[2 * k].y, x[2 * k + 1].x, x[2 * k + 1].y}; }
        __syncthreads();
    }
}

struct HyRaw { v4u w; unsigned short lo, hi; };
HD HyRaw hy_raw(const bf16* PT, int c, int b, int j) {
    const bf16* row = PT + (size_t)c * M + (size_t)b * 4096; HyRaw r;
    r.w = *(const v4u*)(row + 8 * j);
    r.lo = row[8 * j - ((j > 0) ? 1 : 0)]; r.hi = row[8 * j + ((j < 511) ? 8 : 7)];
    return r;
}
HD void hy_conv3(const HyRaw& r, int j, int c, const float* cw, const float* cb, float (&u)[8]) {
    float p[10];
    p[0] = (j > 0) ? bflo((unsigned)r.lo) : 0.f; p[9] = (j < 511) ? bflo((unsigned)r.hi) : 0.f;
    p[1] = bflo(r.w.x); p[2] = bfhi(r.w.x); p[3] = bflo(r.w.y); p[4] = bfhi(r.w.y); p[5] = bflo(r.w.z); p[6] = bfhi(r.w.z); p[7] = bflo(r.w.w); p[8] = bfhi(r.w.w);
    const float w0 = cw[c], w1 = cw[3072 + c], w2 = cw[6144 + c], bb = cb[c];
#pragma unroll
    for (int i = 0; i < 8; ++i) u[i] = w0 * p[i] + w1 * p[i + 1] + w2 * p[i + 2] + bb;
}
constexpr int FFT_T1_OFF = FFT_LDS_COMPLEX * 8, FFT_T2_OFF = FFT_T1_OFF + 32768;
static_assert(FFT_T2_OFF + 2048 <= RING_BYTES, "fft lds 2");
HD void fftc_build(const Frame& F) {
    LAS cf* T1 = (LAS cf*)(F.lds + FFT_T1_OFF); LAS cf* T2 = (LAS cf*)(F.lds + FFT_T2_OFF);
    for (int i = F.tid; i < 4096; i += NT) { const int k0 = i >> 8, j = i & 255; const float r = (float)((j * k0) & 4095) * (1.f / 4096.f); T1[i] = cf_mk(__builtin_amdgcn_cosf(r), -__builtin_amdgcn_sinf(r)); }
    for (int i = F.tid; i < 256; i += NT) { const int k1 = i >> 4, n0 = i & 15; const float r = (float)((n0 * k1) & 255) * (1.f / 256.f); T2[i] = cf_mk(__builtin_amdgcn_cosf(r), -__builtin_amdgcn_sinf(r)); }
    __syncthreads();
}
HD cf tw_direct(int n) { const float r = (float)n * (1.f / 8192.f); return cf_mk(__builtin_amdgcn_cosf(r), -__builtin_amdgcn_sinf(r)); }
HD void fftc_fwd_p1(LAS cf* buf, const LAS cf* T1, int tid) {
    const int hf = tid >> 8, j = tid & 255; cf x[16];
#pragma unroll
    for (int n2 = 0; n2 < 16; ++n2) x[n2] = buf[fpos(hf, n2 * 256 + j)];
    dft16<false>(x);
#pragma unroll
    for (int k0 = 0; k0 < 16; ++k0) buf[fpos(hf, k0 * 256 + j)] = k0 ? cmul(x[k0], T1[k0 * 256 + j]) : x[0];
}
HD void fftc_fwd_p2(LAS cf* buf, const LAS cf* T2, int tid) {
    const int hf = tid >> 8, j = tid & 255, k0 = j >> 4, n0 = j & 15; cf x[16];
#pragma unroll
    for (int n1 = 0; n1 < 16; ++n1) x[n1] = buf[fpos(hf, k0 * 256 + n1 * 16 + n0)];
    dft16<false>(x);
#pragma unroll
    for (int k1 = 0; k1 < 16; ++k1) buf[fpos(hf, k0 * 256 + k1 * 16 + n0)] = k1 ? cmul(x[k1], T2[k1 * 16 + n0]) : x[0];
}
HD void fftc_inv_p2(LAS cf* buf, const LAS cf* T2, int tid) {
    const int hf = tid >> 8, j = tid & 255, k0 = j >> 4, n0 = j & 15; cf x[16];
#pragma unroll
    for (int k1 = 0; k1 < 16; ++k1) { const cf v = buf[fpos(hf, k0 * 256 + k1 * 16 + n0)]; x[k1] = k1 ? cmulc(v, T2[k1 * 16 + n0]) : v; }
    dft16<true>(x);
#pragma unroll
    for (int n1 = 0; n1 < 16; ++n1) buf[fpos(hf, k0 * 256 + n1 * 16 + n0)] = x[n1];
}
HD void fftc_inv_p3(LAS cf* buf, const LAS cf* T1, int tid) {
    const int hf = tid >> 8, j = tid & 255; cf x[16];
#pragma unroll
    for (int k0 = 0; k0 < 16; ++k0) { const cf v = buf[fpos(hf, k0 * 256 + j)]; x[k0] = k0 ? cmulc(v, T1[k0 * 256 + j]) : v; }
    dft16<true>(x);
#pragma unroll
    for (int n2 = 0; n2 < 16; ++n2) buf[fpos(hf, n2 * 256 + j)] = x[n2];
}
HD void hy_fftconv(const Frame& F, LAS cf* buf, const LAS cf* T1, const LAS cf* T2, const cf* spec, const float (&in)[2][8], float (&y)[2][8]) {
    int tid = F.tid; asm volatile("" : "+v"(tid));
#pragma unroll
    for (int i = 0; i < 8; ++i) { const int n = 8 * tid + i; const cf c = cf_mk(in[0][i], in[1][i]); buf[fpos(0, n)] = c; buf[fpos(1, n)] = cmul(c, tw_direct(n)); }
    __syncthreads();
    fftc_fwd_p1(buf, T1, tid); __syncthreads();
    f32x4 hv[8];
    { const cf* sp = spec + (tid >> 8) * 4096 + 16 * (tid & 255);
#pragma unroll
      for (int k = 0; k < 8; ++k) hv[k] = *(const f32x4*)(sp + 2 * k); }
    fftc_fwd_p2(buf, T2, tid); __syncthreads();
    { cf x[16]; fft_fwd_p3(buf, tid, x);
#pragma unroll
      for (int k = 0; k < 8; ++k) { x[2 * k] = cmul(x[2 * k], cf_mk(hv[k][0], hv[k][1])); x[2 * k + 1] = cmul(x[2 * k + 1], cf_mk(hv[k][2], hv[k][3])); }
      fft_inv_p1(buf, tid, x); }
    __syncthreads();
    fftc_inv_p2(buf, T2, tid); __syncthreads();
    fftc_inv_p3(buf, T1, tid); __syncthreads();
#pragma unroll
    for (int i = 0; i < 8; ++i) { const int n = 8 * tid + i; const cf E = buf[fpos(0, n)], O = buf[fpos(1, n)]; const cf r = cadd(E, cmulc(O, tw_direct(n)));
        y[0][i] = r.x * (1.f / 8192.f); y[1][i] = r.y * (1.f / 8192.f); }
    __syncthreads();
}
HD void hyena_core(const Frame& F, ArgsP a) {
    LAS cf* buf = (LAS cf*)F.lds; const LAS cf* T1 = (const LAS cf*)(F.lds + FFT_T1_OFF); const LAS cf* T2 = (const LAS cf*)(F.lds + FFT_T2_OFF);
    const bf16* PT = (const bf16*)(F.ws + WS_PT); bf16* OT = (bf16*)(F.ws + WS_OUTT); const cf* spec = (const cf*)(F.ws + WS_HSPEC);
    const float* cw = a->in[IN_HCW]; const float* cb = a->in[IN_HCB]; const float* fb = a->in[IN_HFB];
    fftc_build(F);
    const int per = (8192 + F.G - 1) / F.G;
    const int it0 = blockIdx.x * per, it1 = min((blockIdx.x + 1) * per, 8192);
    HyRaw rv[2];
    if (it0 < it1) { rv[0] = hy_raw(PT, it0 >> 3, 2 * (it0 & 7), F.tid); rv[1] = hy_raw(PT, it0 >> 3, 2 * (it0 & 7) + 1, F.tid); }
    for (int it = it0; it < it1; ++it) {
        const int d = it >> 3, bp = it & 7, b0 = 2 * bp;
        float v[2][8], y[2][8], z[2][8], g[2][8];
        HyRaw r1[2]; r1[0] = hy_raw(PT, 1024 + d, b0, F.tid); r1[1] = hy_raw(PT, 1024 + d, b0 + 1, F.tid);
        hy_conv3(rv[0], F.tid, d, cw, cb, v[0]); hy_conv3(rv[1], F.tid, d, cw, cb, v[1]);
        hy_fftconv(F, buf, T1, T2, spec + (size_t)d * 8192, v, y);
        HyRaw r2[2]; r2[0] = hy_raw(PT, 2048 + d, b0, F.tid); r2[1] = hy_raw(PT, 2048 + d, b0 + 1, F.tid);
        { const int itn = (it + 1 < it1) ? it + 1 : it; const int dn = itn >> 3, bn = 2 * (itn & 7); rv[0] = hy_raw(PT, dn, bn, F.tid); rv[1] = hy_raw(PT, dn, bn + 1, F.tid); }
        hy_conv3(r1[0], F.tid, 1024 + d, cw, cb, g[0]); hy_conv3(r1[1], F.tid, 1024 + d, cw, cb, g[1]);
        const float fb0 = fb[d], fb1 = fb[1024 + d];
#pragma unroll
        for (int b = 0; b < 2; ++b)
#pragma unroll
            for (int i = 0; i < 8; ++i) z[b][i] = g[b][i] * (y[b][i] + v[b][i] * fb0);
        hy_fftconv(F, buf, T1, T2, spec + (size_t)(1024 + d) * 8192, z, y);
        hy_conv3(r2[0], F.tid, 2048 + d, cw, cb, g[0]); hy_conv3(r2[1], F.tid, 2048 + d, cw, cb, g[1]);
#pragma unroll
        for (int b = 0; b < 2; ++b) { float o[8];
#pragma unroll
            for (int i = 0; i < 8; ++i) o[i] = g[b][i] * (y[b][i] + z[b][i] * fb1);
            v4u w; w.x = pk2(o[0], o[1]); w.y = pk2(o[2], o[3]); w.z = pk2(o[4], o[5]); w.w = pk2(o[6], o[7]);
            *(v4u*)(OT + (size_t)d * M + (size_t)(b0 + b) * 4096 + 8 * F.tid) = w; }
    }
}
HD void hyena_transpose(const Frame& F, int t_first, int t_end, int t_step) {
    LAS unsigned char* scr = F.lds + F.wave * 8704;
    const bf16* OT = (const bf16*)(F.ws + WS_OUTT); bf16* AB = (bf16*)(F.ws + WS_AB);
    const int lane = F.lane;
    v4u wq[8];
    { const int tile = (t_first < t_end) ? t_first : 0; const int d0 = (tile & 15) * 64, m0 = (tile >> 4) * 64;
#pragma unroll
      for (int r = 0; r < 8; ++r) { const int dd = r * 8 + (lane >> 3), ch = lane & 7; wq[r] = *(const v4u*)(OT + (size_t)(d0 + dd) * M + m0 + 8 * ch); } }
    for (int tile = t_first; tile < t_end; tile += t_step) {
        const int dt = tile & 15, tt = tile >> 4, d0 = dt * 64, m0 = tt * 64;
#pragma unroll
        for (int r = 0; r < 8; ++r) { const int dd = r * 8 + (lane >> 3), ch = lane & 7; const v4u w = wq[r];
            LAS v2u* p = (LAS v2u*)(scr + dd * 136 + ch * 16); p[0] = (v2u){w.x, w.y}; p[1] = (v2u){w.z, w.w}; }
        { const int tn = (tile + t_step < t_end) ? tile + t_step : tile; const int dn = (tn & 15) * 64, mn = (tn >> 4) * 64;
#pragma unroll
          for (int r = 0; r < 8; ++r) { const int dd = r * 8 + (lane >> 3), ch = lane & 7; wq[r] = *(const v4u*)(OT + (size_t)(dn + dd) * M + mn + 8 * ch); } }
        LDS_WAIT(); asm volatile("" ::: "memory");
#pragma unroll
        for (int r = 0; r < 8; ++r) { const int tk = r * 8 + (lane >> 3), ch = lane & 7; unsigned e[8];
#pragma unroll
            for (int i = 0; i < 8; ++i) e[i] = *(const LAS unsigned short*)(scr + (ch * 8 + i) * 136 + tk * 2);
            v4u w; w.x = e[0] | (e[1] << 16); w.y = e[2] | (e[3] << 16); w.z = e[4] | (e[5] << 16); w.w = e[6] | (e[7] << 16);
            *(v4u*)(AB + (size_t)(m0 + tk) * 1024 + d0 + 8 * ch) = w; }
        LDS_WAIT(); asm volatile("" ::: "memory");
    }
}

HD void gla_scan_naive(const Frame& F, ArgsP a, int j) {
    constexpr int CH = 32;
    LAS float* qs = (LAS float*)F.lds;
    LAS float* ks = qs + CH * 128;
    LAS float* as = ks + CH * 128;
    LAS float* vs = as + CH * 128;
    const bf16* QK = (const bf16*)(F.ws + WS_QKVG); const float* glow = (const float*)(F.ws + WS_GLOW);
    const float* gw2 = a->in[IN_GW2] + (size_t)j * 2 * 16 * 512; const float* gb = a->in[IN_GGB] + (size_t)j * 2 * 512;
    const int e = F.tid >> 1, half = F.tid & 1;
    for (int item = blockIdx.x; item < 128; item += F.G) {
        const int dir = item & 1, h = (item >> 1) & 3, b = item >> 3;
        bf16* O = (bf16*)(F.ws + (dir ? WS_OB : WS_OF));
        f32x2 S[32];
#pragma unroll
        for (int i = 0; i < 32; ++i) S[i] = (f32x2){0.f, 0.f};
        for (int cc = 0; cc < SEQ / CH; ++cc) {
            const int c = dir ? (SEQ / CH - 1 - cc) : cc; const int mbase = b * SEQ + c * CH;
            __syncthreads();
            for (int i = F.tid; i < CH * 128; i += NT) { const int tt = i >> 7, dd = i & 127; const size_t m = (size_t)(mbase + tt);
                qs[i] = bf2f(QK[m * 3072 + h * 128 + dd]); ks[i] = bf2f(QK[m * 3072 + 512 + h * 128 + dd]);
                float lg = gb[dir * 512 + h * 128 + dd]; const float* gl = glow + m * 32 + dir * 16;
#pragma unroll
                for (int r = 0; r < 16; ++r) lg += gl[r] * gw2[(dir * 16 + r) * 512 + h * 128 + dd];
                const float ls = fminf(lg, 0.f) - log1pf(expf(-fabsf(lg)));
                as[i] = expf(ls * (1.f / 16.f)); }
            for (int i = F.tid; i < CH * 256; i += NT) { const int tt = i >> 8, ee = i & 255; vs[i] = bf2f(QK[(size_t)(mbase + tt) * 3072 + 1024 + h * 256 + ee]); }
            __syncthreads();
            for (int s = 0; s < CH; ++s) {
                const int tt = dir ? (CH - 1 - s) : s;
                const LAS f32x2* q2 = (const LAS f32x2*)(qs + tt * 128 + half * 64); const LAS f32x2* k2 = (const LAS f32x2*)(ks + tt * 128 + half * 64); const LAS f32x2* a2 = (const LAS f32x2*)(as + tt * 128 + half * 64);
                const float ve = vs[tt * 256 + e];
                f32x2 o2 = (f32x2){0.f, 0.f};
                if (dir) {
#pragma unroll
                    for (int i = 0; i < 32; ++i) { S[i] = S[i] * a2[i]; o2 += q2[i] * S[i]; S[i] += k2[i] * ve; }
                } else {
#pragma unroll
                    for (int i = 0; i < 32; ++i) { S[i] = S[i] * a2[i] + k2[i] * ve; o2 += q2[i] * S[i]; }
                }
                float o = o2[0] + o2[1]; o += __shfl_xor(o, 1);
                if (half == 0) O[(size_t)(mbase + tt) * 1024 + h * 256 + e] = (bf16)f2bf(o);
            }
        }
    }
}
HD void gla_prep(const Frame& F, ArgsP a, int j) {
    LAS unsigned short* QR = (LAS unsigned short*)F.lds;
    LAS unsigned short* KR = QR + 64 * 512;
    LAS float* GL = (LAS float*)(F.lds + 139264);
    static_assert(139264 >= LDS_TEXP + MAXTILES * 2 && 139264 + 8192 <= LDS_BYTES, "gla prep lds");
    const bf16* QK = (const bf16*)(F.ws + WS_QKVG); const float* glow = (const float*)(F.ws + WS_GLOW);
    bf16* QT2 = (bf16*)(F.ws + WS_QT2); bf16* KT2 = (bf16*)(F.ws + WS_KT2); float* GS2 = (float*)(F.ws + WS_GS2);
    const float* gw2 = a->in[IN_GW2] + (size_t)j * 2 * 16 * 512; const float* gb = a->in[IN_GGB] + (size_t)j * 2 * 512;
    const int d = F.tid;
    float w2[2][16], gbv[2];
#pragma unroll
    for (int dir = 0; dir < 2; ++dir) { gbv[dir] = gb[dir * 512 + d];
#pragma unroll
        for (int r = 0; r < 16; ++r) w2[dir][r] = gw2[(dir * 16 + r) * 512 + d]; }
    v4u rq[8], rk[8]; f32x4 rgl;
    { const int it0 = (blockIdx.x < NB * 64) ? (int)blockIdx.x : 0; const size_t mb = (size_t)it0 * 64;
      rgl = *(const f32x4*)(glow + mb * 32 + 4 * F.tid);
#pragma unroll
      for (int i = 0; i < 8; ++i) { const int p = F.tid + 512 * i, t = p >> 6, ch = p & 63; rq[i] = *(const v4u*)(QK + (mb + t) * 3072 + 8 * ch); rk[i] = *(const v4u*)(QK + (mb + t) * 3072 + 512 + 8 * ch); } }
    for (int item = blockIdx.x; item < NB * 64; item += F.G) {
        const size_t mbase = (size_t)item * 64;
        __syncthreads();
        *(LAS f32x4*)(GL + 4 * F.tid) = rgl;
#pragma unroll
        for (int i = 0; i < 8; ++i) { const int p = F.tid + 512 * i, t = p >> 6, ch = p & 63;
            *(LAS v4u*)(QR + t * 512 + 8 * ch) = rq[i];
            *(LAS v4u*)(KR + t * 512 + 8 * ch) = rk[i]; }
        __syncthreads();
        { const int itn = (item + F.G < NB * 64) ? item + F.G : item; const size_t mb = (size_t)itn * 64;
          rgl = *(const f32x4*)(glow + mb * 32 + 4 * F.tid);
#pragma unroll
          for (int i = 0; i < 8; ++i) { const int p = F.tid + 512 * i, t = p >> 6, ch = p & 63; rq[i] = *(const v4u*)(QK + (mb + t) * 3072 + 8 * ch); rk[i] = *(const v4u*)(QK + (mb + t) * 3072 + 512 + 8 * ch); } }
#pragma unroll
        for (int dir = 0; dir < 2; ++dir) {
            float run = 0.f;
#pragma unroll 1
            for (int s0 = 0; s0 < 64; s0 += 4) {
                f32x4 gvv[4][4]; unsigned short qr[4], kr[4];
                const int tlo = dir ? 60 - s0 : s0;
                unsigned ga = (unsigned)(size_t)(GL + tlo * 32 + dir * 16); asm volatile("" : "+v"(ga));
                const LAS f32x4* gb = (const LAS f32x4*)(size_t)ga; const LAS unsigned short* qb = QR + tlo * 512 + d; const LAS unsigned short* kb = KR + tlo * 512 + d;
#pragma unroll
                for (int u = 0; u < 4; ++u) { const int o = dir ? 3 - u : u;
#pragma unroll
                    for (int q4 = 0; q4 < 4; ++q4) gvv[u][q4] = gb[o * 8 + q4];
                    qr[u] = qb[o * 512]; kr[u] = kb[o * 512]; }
                __builtin_amdgcn_sched_barrier(0);
#pragma unroll
                for (int u = 0; u < 4; ++u) { const int t = dir ? 63 - (s0 + u) : s0 + u; float lg = gbv[dir];
#pragma unroll
                    for (int q4 = 0; q4 < 4; ++q4) { const f32x4 gv = gvv[u][q4];
                        lg = __builtin_fmaf(gv[0], w2[dir][4 * q4], lg); lg = __builtin_fmaf(gv[1], w2[dir][4 * q4 + 1], lg); lg = __builtin_fmaf(gv[2], w2[dir][4 * q4 + 2], lg); lg = __builtin_fmaf(gv[3], w2[dir][4 * q4 + 3], lg); }
                    const float sp = __builtin_amdgcn_logf(1.f + __builtin_amdgcn_exp2f(-1.4426950408889634f * fabsf(lg))) * 0.6931471805599453f;
                    run += (fminf(lg, 0.f) - sp) * (1.f / 16.f);
                    const float r2 = run * 1.4426950408889634f; const float ex = __builtin_amdgcn_exp2f(r2), exn = __builtin_amdgcn_exp2f(-r2);
                    const size_t m = mbase + t; const float q = bf2f(qr[u]), k = bf2f(kr[u]);
                    const unsigned qk = pk2(q * ex, k * exn); QT2[((size_t)dir * M + m) * 512 + d] = (bf16)(qk & 0xffffu); KT2[((size_t)dir * M + m) * 512 + d] = (bf16)(qk >> 16); } }
            GS2[((size_t)dir * 1024 + item) * 512 + d] = __expf(run);
        }
    }
}
HD s16x4 tr16(const LAS unsigned char* p) { return __builtin_amdgcn_ds_read_tr16_b64_v4i16((LAS s16x4*)p); }
HD bf16x8 cat8(s16x4 a, s16x4 b) { return (bf16x8){a[0], a[1], a[2], a[3], b[0], b[1], b[2], b[3]}; }
HD void gla_scan_mfma(const Frame& F, ArgsP a, int j) {
    constexpr int PQ = 272, PV = 288;
    constexpr int OFF_QT = 0, OFF_KT = OFF_QT + 64 * PQ, OFF_V = OFF_KT + 64 * PQ, OFF_ST = OFF_V + 64 * PV, OFF_GS = OFF_ST + 128 * PQ;
    static_assert(OFF_GS + 512 <= RING_BYTES, "gla lds");
    LAS unsigned char* const QT = F.lds + OFF_QT; LAS unsigned char* const KT = F.lds + OFF_KT; LAS unsigned char* const VL = F.lds + OFF_V; LAS unsigned char* const ST = F.lds + OFF_ST;
    LAS float* const GS = (LAS float*)(F.lds + OFF_GS);
    const bf16* QK = (const bf16*)(F.ws + WS_QKVG); const bf16* QT2 = (const bf16*)(F.ws + WS_QT2); const bf16* KT2 = (const bf16*)(F.ws + WS_KT2); const float* GS2 = (const float*)(F.ws + WS_GS2);
    const int tid = F.tid, lane = F.lane, w = F.wave, g = lane >> 4, l15 = lane & 15, tq = l15 >> 2, tp = l15 & 3;
    for (int item = blockIdx.x; item < 256; item += F.G) {
        const int dir = item & 1, sl = (item >> 1) & 1, h = (item >> 2) & 3, b = item >> 4;
        bf16* Og = (bf16*)(F.ws + (dir ? WS_OB : WS_OF));
        const bf16* Qd = QT2 + (size_t)dir * M * 512 + h * 128; const bf16* Kd = KT2 + (size_t)dir * M * 512 + h * 128; const float* Gd = GS2 + (size_t)dir * 1024 * 512 + h * 128;
        f32x4 Sacc[8];
#pragma unroll
        for (int et = 0; et < 8; ++et) Sacc[et] = (f32x4){0.f, 0.f, 0.f, 0.f};
        const int pt0 = tid >> 4, pch = tid & 15;
        v4u rq[2], rk[2], rv[2]; f32x4 rg = (f32x4){0.f, 0.f, 0.f, 0.f};
        {   const int c = dir ? 63 : 0; const size_t mb = (size_t)b * SEQ + c * 64;
#pragma unroll
            for (int i = 0; i < 2; ++i) { const size_t m = mb + pt0 + 32 * i; rq[i] = *(const v4u*)(Qd + m * 512 + 8 * pch); rk[i] = *(const v4u*)(Kd + m * 512 + 8 * pch); rv[i] = *(const v4u*)(QK + m * 3072 + 1024 + h * 256 + sl * 128 + 8 * pch); }
            if (tid < 32) rg = *(const f32x4*)(Gd + (size_t)(b * 64 + c) * 512 + 4 * tid); }
        for (int cc = 0; cc < 64; ++cc) {
            const int c = dir ? 63 - cc : cc; const size_t mbase = (size_t)b * SEQ + c * 64;
#pragma unroll
            for (int i = 0; i < 2; ++i) { const int t = pt0 + 32 * i; *(LAS v4u*)(QT + t * PQ + 16 * pch) = rq[i]; *(LAS v4u*)(KT + t * PQ + 16 * pch) = rk[i]; *(LAS v4u*)(VL + t * PV + 16 * pch) = rv[i]; }
            if (tid < 32) *(LAS f32x4*)(GS + 4 * tid) = rg;
#pragma unroll
            for (int et = 0; et < 8; ++et) { v2u pw; pw.x = pk2(Sacc[et][0], Sacc[et][1]); pw.y = pk2(Sacc[et][2], Sacc[et][3]); *(LAS v2u*)(ST + (16 * et + l15) * PQ + (16 * w + 4 * g) * 2) = pw; }
            __syncthreads();
            if (cc + 1 < 64) { const int cn = dir ? 62 - cc : cc + 1; const size_t mb = (size_t)b * SEQ + cn * 64;
#pragma unroll
                for (int i = 0; i < 2; ++i) { const size_t m = mb + pt0 + 32 * i; rq[i] = *(const v4u*)(Qd + m * 512 + 8 * pch); rk[i] = *(const v4u*)(Kd + m * 512 + 8 * pch); rv[i] = *(const v4u*)(QK + m * 3072 + 1024 + h * 256 + sl * 128 + 8 * pch); }
                if (tid < 32) rg = *(const f32x4*)(Gd + (size_t)(b * 64 + cn) * 512 + 4 * tid); }
            {   const int it = w & 3, eg = w >> 2;
                bf16x8 Bq[4], Kfr[16];
#pragma unroll
                for (int ks = 0; ks < 4; ++ks) Bq[ks] = *(const LAS bf16x8*)(QT + (16 * it + l15) * PQ + ks * 64 + g * 16);
#pragma unroll
                for (int jt = 0; jt < 4; ++jt)
#pragma unroll
                    for (int ks = 0; ks < 4; ++ks) Kfr[jt * 4 + ks] = *(const LAS bf16x8*)(KT + (16 * jt + l15) * PQ + ks * 64 + g * 16);
                __builtin_amdgcn_sched_barrier(0);
                s16x4 pk[4];
#pragma unroll
                for (int jt = 0; jt < 4; ++jt) { f32x4 acc = (f32x4){0.f, 0.f, 0.f, 0.f};
#pragma unroll
                    for (int ks = 0; ks < 4; ++ks) acc = __builtin_amdgcn_mfma_f32_16x16x32_bf16(Kfr[jt * 4 + ks], Bq[ks], acc, 0, 0, 0);
                    const int ii = 16 * it + l15;
#pragma unroll
                    for (int r = 0; r < 4; ++r) { const int jj = 16 * jt + 4 * g + r; const bool keep = dir ? (jj > ii) : (jj <= ii); acc[r] = keep ? acc[r] : 0.f; }
                    const unsigned p0 = pk2(acc[0], acc[1]), p1 = pk2(acc[2], acc[3]);
                    pk[jt] = (s16x4){(short)(p0 & 0xffff), (short)(p0 >> 16), (short)(p1 & 0xffff), (short)(p1 >> 16)}; }
                const bf16x8 Bp0 = cat8(pk[0], pk[1]), Bp1 = cat8(pk[2], pk[3]);
                bf16x8 Avf[4][2], Asf[4][4];
#pragma unroll
                for (int e4 = 0; e4 < 4; ++e4) { const int et = 4 * eg + e4;
                    Avf[e4][0] = cat8(tr16(VL + (0 + 4 * g + tq) * PV + (16 * et + 4 * tp) * 2), tr16(VL + (16 + 4 * g + tq) * PV + (16 * et + 4 * tp) * 2));
                    Avf[e4][1] = cat8(tr16(VL + (32 + 4 * g + tq) * PV + (16 * et + 4 * tp) * 2), tr16(VL + (48 + 4 * g + tq) * PV + (16 * et + 4 * tp) * 2));
#pragma unroll
                    for (int ks = 0; ks < 4; ++ks) Asf[e4][ks] = *(const LAS bf16x8*)(ST + (16 * et + l15) * PQ + ks * 64 + g * 16); }
                __builtin_amdgcn_sched_barrier(0);
#pragma unroll
                for (int e4 = 0; e4 < 4; ++e4) { const int et = 4 * eg + e4; f32x4 acc = (f32x4){0.f, 0.f, 0.f, 0.f};
                    acc = __builtin_amdgcn_mfma_f32_16x16x32_bf16(Avf[e4][0], Bp0, acc, 0, 0, 0);
                    acc = __builtin_amdgcn_mfma_f32_16x16x32_bf16(Avf[e4][1], Bp1, acc, 0, 0, 0);
#pragma unroll
                    for (int ks = 0; ks < 4; ++ks) acc = __builtin_amdgcn_mfma_f32_16x16x32_bf16(Asf[e4][ks], Bq[ks], acc, 0, 0, 0);
                    { v2u ow; ow.x = pk2(acc[0], acc[1]); ow.y = pk2(acc[2], acc[3]); *(v2u*)(Og + (mbase + 16 * it + l15) * 1024 + h * 256 + sl * 128 + 16 * et + 4 * g) = ow; } }
                bf16x8 Ak[2];
#pragma unroll
                for (int k2 = 0; k2 < 2; ++k2) Ak[k2] = cat8(tr16(KT + (32 * k2 + 8 * g + tq) * PQ + (16 * w + 4 * tp) * 2), tr16(KT + (32 * k2 + 8 * g + 4 + tq) * PQ + (16 * w + 4 * tp) * 2));
                const f32x4 gs = *(const LAS f32x4*)(GS + 16 * w + 4 * g);
                bf16x8 Bvf[8][2];
#pragma unroll
                for (int et = 0; et < 8; ++et)
#pragma unroll
                    for (int k2 = 0; k2 < 2; ++k2) Bvf[et][k2] = cat8(tr16(VL + (32 * k2 + 8 * g + tq) * PV + (16 * et + 4 * tp) * 2), tr16(VL + (32 * k2 + 8 * g + 4 + tq) * PV + (16 * et + 4 * tp) * 2));
                __builtin_amdgcn_sched_barrier(0);
#pragma unroll
                for (int et = 0; et < 8; ++et) {
#pragma unroll
                    for (int k2 = 0; k2 < 2; ++k2) Sacc[et] = __builtin_amdgcn_mfma_f32_16x16x32_bf16(Ak[k2], Bvf[et][k2], Sacc[et], 0, 0, 0);
                    Sacc[et] = Sacc[et] * gs; }
            }
            __syncthreads();
        }
    }
}
HD void unpack8(const v4u w, float (&f)[8]) { f[0] = bflo(w.x); f[1] = bfhi(w.x); f[2] = bflo(w.y); f[3] = bfhi(w.y); f[4] = bflo(w.z); f[5] = bfhi(w.z); f[6] = bflo(w.w); f[7] = bfhi(w.w); }
HD v4u pack8f(const float (&f)[8]) { v4u w; w.x = pk2(f[0], f[1]); w.y = pk2(f[2], f[3]); w.z = pk2(f[4], f[5]); w.w = pk2(f[6], f[7]); return w; }
HD void unpack8_fp8(const v2u w, float (&f)[8]) {
    f[0] = __builtin_amdgcn_cvt_f32_fp8((int)w.x, 0); f[1] = __builtin_amdgcn_cvt_f32_fp8((int)w.x, 1); f[2] = __builtin_amdgcn_cvt_f32_fp8((int)w.x, 2); f[3] = __builtin_amdgcn_cvt_f32_fp8((int)w.x, 3);
    f[4] = __builtin_amdgcn_cvt_f32_fp8((int)w.y, 0); f[5] = __builtin_amdgcn_cvt_f32_fp8((int)w.y, 1); f[6] = __builtin_amdgcn_cvt_f32_fp8((int)w.y, 2); f[7] = __builtin_amdgcn_cvt_f32_fp8((int)w.y, 3);
}
HD float half_sum(float v) {
#pragma unroll
    for (int o = 1; o < 32; o <<= 1) v += __shfl_xor(v, o);
    return v;
}
HD void gla_gate(const Frame& F, ArgsP a, int j, int m_first, int m_end, int m_step) {
    const bf16* OFp = (const bf16*)(F.ws + WS_OF); const bf16* OBp = (const bf16*)(F.ws + WS_OB); const bf16* QK = (const bf16*)(F.ws + WS_QKVG); bf16* AB = (bf16*)(F.ws + WS_AB);
    float ng[8];
    { const float* np = a->in[IN_GNG] + (size_t)j * 256 + 8 * (F.lane & 31); const f32x4 n0 = *(const f32x4*)np, n1 = *(const f32x4*)(np + 4); ng[0] = n0[0]; ng[1] = n0[1]; ng[2] = n0[2]; ng[3] = n0[3]; ng[4] = n1[0]; ng[5] = n1[1]; ng[6] = n1[2]; ng[7] = n1[3]; }
#pragma unroll 2
    for (int m = m_first; m < m_end; m += m_step) {
        v4u fw[2], bw[2], gw_[2];
#pragma unroll
        for (int c = 0; c < 2; ++c) { const size_t off = (size_t)m * 1024 + 512 * c + 8 * F.lane; fw[c] = *(const v4u*)(OFp + off); bw[c] = *(const v4u*)(OBp + off); gw_[c] = *(const v4u*)(QK + (size_t)m * 3072 + 2048 + 512 * c + 8 * F.lane); }
#pragma unroll
        for (int c = 0; c < 2; ++c) {
            float f[8], b[8], g[8], r[8]; unpack8(fw[c], f); unpack8(bw[c], b); unpack8(gw_[c], g);
            float ss = 0.f;
#pragma unroll
            for (int i = 0; i < 8; ++i) { f[i] += b[i]; ss += f[i] * f[i]; }
            const float rs = 1.f / sqrtf(half_sum(ss) * (1.f / 256.f) + 1e-6f);
#pragma unroll
            for (int i = 0; i < 8; ++i) { const float sg = g[i] * __builtin_amdgcn_rcpf(1.f + __expf(-g[i])); r[i] = (f[i] * rs * ng[i]) * sg; }
            *(v4u*)(AB + (size_t)m * 1024 + 512 * c + 8 * F.lane) = pack8f(r);
        }
    }
}

HD void na_attn_naive(const Frame& F, ArgsP a) {
    const bf16* QH = (const bf16*)(F.ws + WS_QH); const bf16* KH = (const bf16*)(F.ws + WS_KH); const bf16* VH = (const bf16*)(F.ws + WS_VH); bf16* AB = (bf16*)(F.ws + WS_AB);
    const float* rpb = a->in[IN_NRPB];
    for (int item = F.gw; item < NB * 32 * 64; item += F.NGW) {
        const int r = item & 63, h = (item >> 6) & 31, b = item >> 11, c = F.lane;
        const size_t hb = (size_t)(b * 32 + h) * 4096;
        float q[32];
        { const v4u* qp = (const v4u*)(QH + (hb + r * 64 + c) * 32);
#pragma unroll
          for (int i = 0; i < 4; ++i) { const v4u w = qp[i]; q[8 * i] = bflo(w.x); q[8 * i + 1] = bfhi(w.x); q[8 * i + 2] = bflo(w.y); q[8 * i + 3] = bfhi(w.y); q[8 * i + 4] = bflo(w.z); q[8 * i + 5] = bfhi(w.z); q[8 * i + 6] = bflo(w.w); q[8 * i + 7] = bfhi(w.w); } }
        const int rs = min(max(r - 4, 0), 56), cs = min(max(c - 8, 0), 48);
        float mx = -3.0e38f, sum = 0.f, o[32];
#pragma unroll
        for (int i = 0; i < 32; ++i) o[i] = 0.f;
        for (int kr = 0; kr < 8; ++kr)
            for (int kc = 0; kc < 16; ++kc) {
                const int krow = rs + kr, kcol = cs + kc; const size_t kt = hb + krow * 64 + kcol;
                const v4u* kp = (const v4u*)(KH + kt * 32); float s = 0.f;
#pragma unroll
                for (int i = 0; i < 4; ++i) { const v4u w = kp[i];
                    s += q[8 * i] * bflo(w.x) + q[8 * i + 1] * bfhi(w.x) + q[8 * i + 2] * bflo(w.y) + q[8 * i + 3] * bfhi(w.y) + q[8 * i + 4] * bflo(w.z) + q[8 * i + 5] * bfhi(w.z) + q[8 * i + 6] * bflo(w.w) + q[8 * i + 7] * bfhi(w.w); }
                s += rpb[(h * 15 + (krow - r + 7)) * 31 + (kcol - c + 15)];
                const float mn = fmaxf(mx, s), sc = __expf(mx - mn), p = __expf(s - mn); mx = mn; sum = sum * sc + p;
                const v4u* vp = (const v4u*)(VH + kt * 32);
#pragma unroll
                for (int i = 0; i < 4; ++i) { const v4u w = vp[i];
                    o[8 * i] = o[8 * i] * sc + p * bflo(w.x); o[8 * i + 1] = o[8 * i + 1] * sc + p * bfhi(w.x); o[8 * i + 2] = o[8 * i + 2] * sc + p * bflo(w.y); o[8 * i + 3] = o[8 * i + 3] * sc + p * bfhi(w.y);
                    o[8 * i + 4] = o[8 * i + 4] * sc + p * bflo(w.z); o[8 * i + 5] = o[8 * i + 5] * sc + p * bfhi(w.z); o[8 * i + 6] = o[8 * i + 6] * sc + p * bflo(w.w); o[8 * i + 7] = o[8 * i + 7] * sc + p * bfhi(w.w); }
            }
        const float inv = 1.f / sum;
        v4u* op = (v4u*)(AB + ((size_t)b * 4096 + r * 64 + c) * 1024 + h * 32);
#pragma unroll
        for (int i = 0; i < 4; ++i) { v4u w; w.x = pk2(o[8 * i] * inv, o[8 * i + 1] * inv); w.y = pk2(o[8 * i + 2] * inv, o[8 * i + 3] * inv); w.z = pk2(o[8 * i + 4] * inv, o[8 * i + 5] * inv); w.w = pk2(o[8 * i + 6] * inv, o[8 * i + 7] * inv); op[i] = w; }
    }
}

HD void na_attn_mfma(const Frame& F, ArgsP a) {
    constexpr int OFF_RPB = 15 * 64 * 64;
    static_assert(OFF_RPB + 2048 <= RING_BYTES, "na lds");
    LAS unsigned char* const VL = F.lds; LAS float* const RP = (LAS float*)(F.lds + OFF_RPB);
    const bf16* QH = (const bf16*)(F.ws + WS_QH); const bf16* KH = (const bf16*)(F.ws + WS_KH); const bf16* VH = (const bf16*)(F.ws + WS_VH); bf16* AB = (bf16*)(F.ws + WS_AB);
    const float* rpb = a->in[IN_NRPB];
    const int tid = F.tid, lane = F.lane, w = F.wave, g = lane >> 4, l15 = lane & 15, tq = l15 >> 2, tp = l15 & 3;
    bf16x8 Kf[16], Bqn;
    auto ldk = [&](int item_, int cb_) {
        const int rg_ = item_ & 7, h_ = (item_ >> 3) & 31, b_ = item_ >> 8; const size_t hb_ = (size_t)(b_ * 32 + h_) * 4096;
        const int r_ = 8 * rg_ + w, rs_ = min(max(r_ - 4, 0), 56), bs_ = min(max(16 * cb_ - 8, 0), 32), qc_ = 16 * cb_ + l15;
        Bqn = *(const bf16x8*)(QH + (hb_ + r_ * 64 + qc_) * 32 + 8 * g);
#pragma unroll
        for (int t = 0; t < 16; ++t) { const int kr = t >> 1, kc0 = bs_ + 16 * (t & 1); Kf[t] = *(const bf16x8*)(KH + (hb_ + (rs_ + kr) * 64 + kc0 + l15) * 32 + 8 * g); }
    };
    { const int it0 = (blockIdx.x < NB * 32 * 8) ? (int)blockIdx.x : 0; ldk(it0, 0); }
    v2u pend[2]; pend[0] = (v2u){0u, 0u}; pend[1] = pend[0]; size_t pidx = 0; bool hasp = false;
    auto flush = [&]() {
#pragma unroll
        for (int dt = 0; dt < 2; ++dt) {
            if (FP8_NAOUT) *(unsigned*)((unsigned char*)AB + pidx + 16 * dt) = pend[dt].x;
            else *(v2u*)(AB + pidx + 16 * dt) = pend[dt]; }
    };
    for (int item = blockIdx.x; item < NB * 32 * 8; item += F.G) {
        const int rg = item & 7, h = (item >> 3) & 31, b = item >> 8, r0 = 8 * rg;
        const size_t hb = (size_t)(b * 32 + h) * 4096;
        const int klo = min(max(r0 - 4, 0), 56), khi = min(max(r0 + 3, 0), 56) + 7, nrows = khi - klo + 1;
        __syncthreads();
        { const v4u* src = (const v4u*)(VH + (hb + (size_t)klo * 64) * 32); const int npc = nrows * 256;
          v4u vv[8];
#pragma unroll
          for (int i = 0; i < 8; ++i) { const int p = tid + NT * i; vv[i] = src[p < npc ? p : npc - 1]; }
          const float rpv = rpb[h * 465 + (tid < 465 ? tid : 464)];
          __builtin_amdgcn_sched_barrier(0);
#pragma unroll
          for (int i = 0; i < 8; ++i) { const int p = tid + NT * i; if (p < npc) *(LAS v4u*)(VL + p * 16) = vv[i]; }
          if (tid < 465) RP[tid] = rpv; }
        __syncthreads();
        const int r = r0 + w, rs = min(max(r - 4, 0), 56);
#pragma unroll 1
        for (int cb = 0; cb < 4; ++cb) {
            const int bs = min(max(16 * cb - 8, 0), 32), qc = 16 * cb + l15, cs = min(max(qc - 8, 0), 48);
            f32x4 sc[16];
#pragma unroll
            for (int t = 0; t < 16; ++t) sc[t] = __builtin_amdgcn_mfma_f32_16x16x32_bf16(Kf[t], Bqn, (f32x4){0.f, 0.f, 0.f, 0.f}, 0, 0, 0);
            { int ni = item, nc = cb + 1; if (nc == 4) { nc = 0; ni = (item + F.G < NB * 32 * 8) ? item + F.G : item; } ldk(ni, nc); }
            if (hasp) flush();
            bool sel0[4]; int dix[4];
#pragma unroll
            for (int rr = 0; rr < 4; ++rr) { const int kcol0 = bs + 4 * g + rr; sel0[rr] = kcol0 >= cs; dix[rr] = (sel0[rr] ? kcol0 : kcol0 + 16) - qc + 15; }
            float pv[8][4]; float mx = -3.0e38f;
#pragma unroll
            for (int kr = 0; kr < 8; ++kr) { const LAS float* rp = RP + (rs + kr - r + 7) * 31;
#pragma unroll
                for (int rr = 0; rr < 4; ++rr) { const float v = (sel0[rr] ? sc[2 * kr][rr] : sc[2 * kr + 1][rr]) + rp[dix[rr]]; pv[kr][rr] = v; mx = fmaxf(mx, v); } }
            mx = fmaxf(mx, __shfl_xor(mx, 16)); mx = fmaxf(mx, __shfl_xor(mx, 32));
            float sum = 0.f;
#pragma unroll
            for (int kr = 0; kr < 8; ++kr)
#pragma unroll
                for (int rr = 0; rr < 4; ++rr) { const float p = __expf(pv[kr][rr] - mx); pv[kr][rr] = p; sum += p; }
            sum += __shfl_xor(sum, 16); sum += __shfl_xor(sum, 32);
            const float inv = 1.f / sum;
            bf16x8 Bp[8];
#pragma unroll
            for (int kr = 0; kr < 8; ++kr) { unsigned q[4];
#pragma unroll
                for (int rr = 0; rr < 4; rr += 2) { const unsigned w2_ = pk2(pv[kr][rr], pv[kr][rr + 1]); q[rr] = w2_ & 0xffffu; q[rr + 1] = w2_ >> 16; }
                unsigned short e0[4], e1[4];
#pragma unroll
                for (int rr = 0; rr < 4; ++rr) { e0[rr] = (unsigned short)(sel0[rr] ? q[rr] : 0u); e1[rr] = (unsigned short)(sel0[rr] ? 0u : q[rr]); }
                Bp[kr] = (bf16x8){(short)e0[0], (short)e0[1], (short)e0[2], (short)e0[3], (short)e1[0], (short)e1[1], (short)e1[2], (short)e1[3]}; }
#pragma unroll
            for (int dt = 0; dt < 2; ++dt) { f32x4 acc = (f32x4){0.f, 0.f, 0.f, 0.f};
#pragma unroll
                for (int kr = 0; kr < 8; ++kr) { const int rowb = (rs + kr - klo) * 64 + bs + 4 * g + tq;
                    const bf16x8 A = cat8(tr16(VL + rowb * 64 + (16 * dt + 4 * tp) * 2), tr16(VL + (rowb + 16) * 64 + (16 * dt + 4 * tp) * 2));
                    acc = __builtin_amdgcn_mfma_f32_16x16x32_bf16(A, Bp[kr], acc, 0, 0, 0); }
                if (FP8_NAOUT) { const float i16 = inv * 16.f; pend[dt].x = pk4_fp8(acc[0] * i16, acc[1] * i16, acc[2] * i16, acc[3] * i16); }
                else { pend[dt].x = pk2(acc[0] * inv, acc[1] * inv); pend[dt].y = pk2(acc[2] * inv, acc[3] * inv); } }
            pidx = ((size_t)b * 4096 + r * 64 + qc) * 1024 + h * 32 + 4 * g; hasp = true;
        }
    }
    if (hasp) flush();
}

HD void ln1_phase(const Frame& F, const float* xin, const bf16* xinb, const float* g, const float* bta, bf16* xob, unsigned char* xo8, int m_first, int m_end, int m_step) {
    const bf16* HP = (const bf16*)(F.ws + WS_HPRE);
    float gv[16], bv[16];
#pragma unroll
    for (int c = 0; c < 2; ++c)
#pragma unroll
        for (int q = 0; q < 2; ++q) { const f32x4 a4 = *(const f32x4*)(g + 512 * c + 8 * F.lane + 4 * q), b4 = *(const f32x4*)(bta + 512 * c + 8 * F.lane + 4 * q);
#pragma unroll
            for (int i = 0; i < 4; ++i) { gv[8 * c + 4 * q + i] = a4[i]; bv[8 * c + 4 * q + i] = b4[i]; } }
#pragma unroll 2
    for (int m = m_first; m < m_end; m += m_step) {
        float v[16]; float s = 0.f;
#pragma unroll
        for (int c = 0; c < 2; ++c) { const size_t off = (size_t)m * D + 512 * c + 8 * F.lane; float x[8], h[8];
            if (xin) { const f32x4 x0 = *(const f32x4*)(xin + off), x1 = *(const f32x4*)(xin + off + 4); x[0] = x0[0]; x[1] = x0[1]; x[2] = x0[2]; x[3] = x0[3]; x[4] = x1[0]; x[5] = x1[1]; x[6] = x1[2]; x[7] = x1[3]; }
            else unpack8(*(const v4u*)(xinb + off), x);
            unpack8(*(const v4u*)(HP + off), h);
#pragma unroll
            for (int i = 0; i < 8; ++i) { v[8 * c + i] = x[i] * DN_ALPHA + h[i]; s += v[8 * c + i]; } }
        const float mean = wave_sum(s) * (1.f / D); float s2 = 0.f;
#pragma unroll
        for (int i = 0; i < 16; ++i) { v[i] -= mean; s2 += v[i] * v[i]; }
        const float rstd = 1.f / sqrtf(wave_sum(s2) * (1.f / D) + LN_EPS);
#pragma unroll
        for (int c = 0; c < 2; ++c) { const size_t off = (size_t)m * D + 512 * c + 8 * F.lane; float y[8];
#pragma unroll
            for (int i = 0; i < 8; ++i) y[i] = v[8 * c + i] * rstd * gv[8 * c + i] + bv[8 * c + i];
            *(v4u*)(xob + off) = pack8f(y);
            v2u w8; w8.x = pk4_fp8(y[0] * 16.f, y[1] * 16.f, y[2] * 16.f, y[3] * 16.f); w8.y = pk4_fp8(y[4] * 16.f, y[5] * 16.f, y[6] * 16.f, y[7] * 16.f);
            *(v2u*)(xo8 + off) = w8; }
    }
}
HD void topk_rows(const Frame& F, const float* rb, int layer, int row0) {
    LAS int* hist = (LAS int*)F.lds; LAS int* base = hist + 32;
    const float* LG = (const float*)(F.ws + WS_LOGIT); int* tokl = (int*)(F.ws + WS_TOKL); int* sel = (int*)(F.ws + WS_SEL); float* gate = (float*)(F.ws + WS_GATE);
    unsigned* gcnt = F.ctl + CW_CNT + layer * 32;
    {
        __syncthreads();
        if (F.tid < 32) hist[F.tid] = 0;
        __syncthreads();
        const bool act = F.tid < 256; const int m = row0 + (act ? F.tid : 0);
        float lg[32];
        __builtin_amdgcn_fence(__ATOMIC_ACQUIRE, "agent");
        { f32x4 l4[8];
#pragma unroll
          for (int q4 = 0; q4 < 8; ++q4) l4[q4] = *(const f32x4*)(LG + (size_t)m * 32 + 4 * q4);
#pragma unroll
          for (int q4 = 0; q4 < 8; ++q4)
#pragma unroll
              for (int i = 0; i < 4; ++i) lg[4 * q4 + i] = l4[q4][i] + rb[4 * q4 + i]; }
        int ti[4]; float tv[4];
#pragma unroll
        for (int k = 0; k < 4; ++k) { float best = -3.0e38f; int bi = 0;
#pragma unroll
            for (int e = 0; e < 32; ++e) { const bool take = lg[e] > best; best = take ? lg[e] : best; bi = take ? e : bi; }
            ti[k] = bi; tv[k] = best;
#pragma unroll
            for (int e = 0; e < 32; ++e) lg[e] = (e == bi) ? -3.0e38f : lg[e]; }
        float ex[4], es = 0.f;
#pragma unroll
        for (int k = 0; k < 4; ++k) { ex[k] = expf(tv[k] - tv[0]); es += ex[k]; }
        int rk[4];
#pragma unroll
        for (int k = 0; k < 4; ++k) rk[k] = act ? __hip_atomic_fetch_add(&hist[ti[k]], 1, __ATOMIC_RELAXED, __HIP_MEMORY_SCOPE_WORKGROUP) : 0;
        __syncthreads();
        if (F.tid < 32) base[F.tid] = (int)atomicAdd(&gcnt[F.tid], (unsigned)hist[F.tid]);
        __syncthreads();
        if (act)
#pragma unroll
        for (int k = 0; k < 4; ++k) { const int slot = base[ti[k]] + rk[k]; tokl[(size_t)ti[k] * 65536 + slot] = m; sel[((size_t)m * 4 + k) * 2] = ti[k]; sel[((size_t)m * 4 + k) * 2 + 1] = slot; gate[(size_t)m * 4 + k] = ex[k] / es; }
    }
}
HD int moe_tables(const Frame& F, int layer) {
    LAS int* ecnt = (LAS int*)(F.lds + LDS_ECNT); LAS int* tbase = (LAS int*)(F.lds + LDS_TBASE); LAS unsigned short* texp = (LAS unsigned short*)(F.lds + LDS_TEXP);
    __syncthreads();
    if (F.tid < 32) ecnt[F.tid] = (int)__hip_atomic_load(F.ctl + CW_CNT + layer * 32 + F.tid, __ATOMIC_RELAXED, __HIP_MEMORY_SCOPE_AGENT);
    __syncthreads();
    if (F.tid == 0) { int acc = 0; for (int e = 0; e < 32; ++e) { tbase[e] = acc; acc += (ecnt[e] + 255) >> 8; } tbase[32] = acc; }
    __syncthreads();
    if (F.tid < 32) { const int t0 = tbase[F.tid], t1 = tbase[F.tid + 1]; for (int t = t0; t < t1 && t < MAXTILES; ++t) texp[t] = (unsigned short)F.tid; }
    __syncthreads();
    const int T = tbase[32]; return T < MAXTILES ? T : MAXTILES;
}
HD void moe_scatter(const Frame& F) {
    const LAS int* tbase = (const LAS int*)(F.lds + LDS_TBASE);
    const unsigned char* X8 = F.ws + WS_X8; unsigned char* XS = F.ws + WS_XS; const int* sel = (const int*)(F.ws + WS_SEL);
    for (int m = F.gw; m < M; m += F.NGW) {
        const v4u row = *((const v4u*)(X8 + (size_t)m * 1024) + F.lane);
        const i32x4 s0 = *(const i32x4*)(sel + (size_t)m * 8), s1 = *(const i32x4*)(sel + (size_t)m * 8 + 4);
        *((v4u*)(XS + ((size_t)tbase[s0[0]] * 256 + s0[1]) * 1024) + F.lane) = row;
        *((v4u*)(XS + ((size_t)tbase[s0[2]] * 256 + s0[3]) * 1024) + F.lane) = row;
        *((v4u*)(XS + ((size_t)tbase[s1[0]] * 256 + s1[1]) * 1024) + F.lane) = row;
        *((v4u*)(XS + ((size_t)tbase[s1[2]] * 256 + s1[3]) * 1024) + F.lane) = row;
    }
}
HD void ln2_phase(const Frame& F, const bf16* xinb, const float* g, const float* bta, float* xo, bf16* xob, unsigned char* xo8) {
    const LAS int* tbase = (const LAS int*)(F.lds + LDS_TBASE);
    const bf16* Y = (const bf16*)(F.ws + WS_YBUF); const int* sel = (const int*)(F.ws + WS_SEL); const float* gate = (const float*)(F.ws + WS_GATE);
    float gv[16], bv[16];
#pragma unroll
    for (int c = 0; c < 2; ++c)
#pragma unroll
        for (int q = 0; q < 2; ++q) { const f32x4 a4 = *(const f32x4*)(g + 512 * c + 8 * F.lane + 4 * q), b4 = *(const f32x4*)(bta + 512 * c + 8 * F.lane + 4 * q);
#pragma unroll
            for (int i = 0; i < 4; ++i) { gv[8 * c + 4 * q + i] = a4[i]; bv[8 * c + 4 * q + i] = b4[i]; } }
    i32x4 s0n, s1n; f32x4 gtn;
    { const int m0 = (F.gw < M) ? F.gw : 0; s0n = *(const i32x4*)(sel + (size_t)m0 * 8); s1n = *(const i32x4*)(sel + (size_t)m0 * 8 + 4); gtn = *(const f32x4*)(gate + (size_t)m0 * 4); }
    for (int m = F.gw; m < M; m += F.NGW) {
        const i32x4 s0 = s0n, s1 = s1n; const f32x4 gt = gtn;
        { const int mn = (m + F.NGW < M) ? m + F.NGW : m; s0n = *(const i32x4*)(sel + (size_t)mn * 8); s1n = *(const i32x4*)(sel + (size_t)mn * 8 + 4); gtn = *(const f32x4*)(gate + (size_t)mn * 4); }
        size_t rows[4]; rows[0] = (size_t)tbase[s0[0]] * 256 + s0[1]; rows[1] = (size_t)tbase[s0[2]] * 256 + s0[3]; rows[2] = (size_t)tbase[s1[0]] * 256 + s1[1]; rows[3] = (size_t)tbase[s1[2]] * 256 + s1[3];
        v4u xw[2]; v2u yw[4][2];
#pragma unroll
        for (int c = 0; c < 2; ++c) { xw[c] = *(const v4u*)(xinb + (size_t)m * D + 512 * c + 8 * F.lane);
#pragma unroll
            for (int k = 0; k < 4; ++k) yw[k][c] = *(const v2u*)((const unsigned char*)Y + rows[k] * 1024 + 512 * c + 8 * F.lane); }
        float v[16]; float s = 0.f;
#pragma unroll
        for (int c = 0; c < 2; ++c) { float x[8]; unpack8(xw[c], x);
#pragma unroll
            for (int i = 0; i < 8; ++i) v[8 * c + i] = x[i] * DN_ALPHA;
#pragma unroll
            for (int k = 0; k < 4; ++k) { float y[8]; unpack8_fp8(yw[k][c], y); const float gk = gt[k] * 0.03125f;
#pragma unroll
                for (int i = 0; i < 8; ++i) v[8 * c + i] += y[i] * gk; }
#pragma unroll
            for (int i = 0; i < 8; ++i) s += v[8 * c + i]; }
        const float mean = wave_sum(s) * (1.f / D); float s2 = 0.f;
#pragma unroll
        for (int i = 0; i < 16; ++i) { v[i] -= mean; s2 += v[i] * v[i]; }
        const float rstd = 1.f / sqrtf(wave_sum(s2) * (1.f / D) + LN_EPS);
#pragma unroll
        for (int c = 0; c < 2; ++c) { const size_t off = (size_t)m * D + 512 * c + 8 * F.lane; float y[8];
#pragma unroll
            for (int i = 0; i < 8; ++i) y[i] = v[8 * c + i] * rstd * gv[8 * c + i] + bv[8 * c + i];
            if (xo) { *(f32x4*)(xo + off) = (f32x4){y[0], y[1], y[2], y[3]}; *(f32x4*)(xo + off + 4) = (f32x4){y[4], y[5], y[6], y[7]}; }
            else { *(v4u*)(xob + off) = pack8f(y);
                if (xo8) { v2u w8; w8.x = pk4_fp8(y[0] * 16.f, y[1] * 16.f, y[2] * 16.f, y[3] * 16.f); w8.y = pk4_fp8(y[4] * 16.f, y[5] * 16.f, y[6] * 16.f, y[7] * 16.f); *(v2u*)(xo8 + off) = w8; } } }
    }
}

__global__ void __launch_bounds__(NT, 2) enc_fwd(Args args_by_value) {
    extern __shared__ __attribute__((aligned(16))) unsigned char lds_raw[];
    LAS unsigned char* const lds = (LAS unsigned char*)lds_raw;
    { const int t0 = threadIdx.x; for (int u = t0; u < 64; u += NT) ((LAS unsigned*)(lds + LDS_MISC))[u] = 0u;
      if ((t0 & 63) == 0) ((LAS int*)(lds + LDS_WTAB))[hw_slot()] = t0 >> 6; }
    __syncthreads();
    int lo, hi; { ArgsP ap = argp(); lo = ap->ph_lo; hi = ap->ph_hi; }
    const bool multi = (hi - lo) > 1;
    if (multi) (void)xcd_barrier_post((unsigned*)(argp()->ws + WS_CTL) + CW_BAR, (volatile LAS unsigned*)(lds + LDS_MISC) + 8);
#define IN(k) (lo <= (k) && (k) < hi)
#define SEAM(k) do { if (multi && (k) + 1 < hi) { XcdBarrier bar_; bar_.bar = (unsigned*)(argp()->ws + WS_CTL) + CW_BAR; bar_.x = xb_xcc_id(); bar_.st = (volatile LAS unsigned*)(lds + LDS_MISC) + 8; xcd_barrier(bar_); } } while (0)
#define FRAME() ArgsP ap = argp(); const Frame F = mkframe(ap, lds); unsigned char* const ws = F.ws; (void)ws

    if (IN(0)) { { FRAME(); if (PEN(0)) REP(0) p0_prologue(F, ap); } { FRAME(); if (PEN(17)) REP(17) p0_hyena_filters(F, ap); } SEAM(0); }

    for (int layer = 0; layer < DEPTH; ++layer) {
        const int pb = 1 + 16 * layer, mixer = layer % 3, jj = layer / 3;
        if (mixer == 0) {
            if (IN(pb + 0)) {
                if (PEN(1)) REP(1) { FRAME();
                    constexpr int RB = FP8_GLA ? 1024 : 2048;
                    g8::DenseSched S{(const bf16*)(ws + (FP8_GLA ? WS_X8 : WS_XAB)), (const bf16*)(ws + WS_WGIN + (size_t)jj * GLA_NPAD * RB), M / 256, GLA_NPAD / 256, F.G, (int)blockIdx.x, RB};
                    g8::EpiGlaIn E{(bf16*)(ws + WS_QKVG), (float*)(ws + WS_GLOW), 0.08838834764831845f, FP8_GLA ? 4.8828125e-4f : 1.f};
                    g8::gemm_phase<g8::EpiGlaIn, g8::DenseSched, false, FP8_GLA != 0>(F.lds, S, E); }
                if (PEN(16) && layer == 0) REP(16) { FRAME(); hyena_filter_fft(F); }
                SEAM(pb + 0);
            }
            if (IN(pb + 1)) { if (PEN(19)) REP(19) { FRAME(); gla_prep(F, ap, jj); } if (multi) SEAM(-1000);
                if (PEN(2)) REP(2) { FRAME(); if (GLA_NAIVE) gla_scan_naive(F, ap, jj); else gla_scan_mfma(F, ap, jj); } SEAM(pb + 1); }
        } else if (mixer == 1) {
            if (IN(pb + 0)) { if (PEN(4)) REP(4) { FRAME();
                constexpr int RB = FP8_HY ? 1024 : 2048;
                g8::DenseSched S{(const bf16*)(ws + WS_WHIN), (const bf16*)(ws + (FP8_HY ? WS_X8 : WS_XAB)), 3072 / 256, M / 256, F.G, (int)blockIdx.x, RB};
                g8::EpiHyIn E{(bf16*)(ws + WS_PT), ap->in[IN_HBIN], FP8_HY ? 4.8828125e-4f : 1.f};
                g8::gemm_phase<g8::EpiHyIn, g8::DenseSched, false, FP8_HY != 0>(F.lds, S, E); }
                SEAM(pb + 0);
            }
            if (IN(pb + 1)) { if (PEN(5)) REP(5) { FRAME(); hyena_core(F, ap); } SEAM(pb + 1); }
        } else {
            if (IN(pb + 0)) { if (PEN(7)) REP(7) { FRAME();
                constexpr int RB = FP8_NA ? 1024 : 2048;
                g8::DenseSched S{(const bf16*)(ws + (FP8_NA ? WS_X8 : WS_XAB)), (const bf16*)(ws + WS_WNIN), M / 256, 3072 / 256, F.G, (int)blockIdx.x, RB};
                g8::EpiNaIn E{(bf16*)(ws + WS_QH), (size_t)(WS_KH - WS_QH) / 2, ap->in[IN_NBIN], 0.17677669529663687f, FP8_NA ? 4.8828125e-4f : 1.f};
                g8::gemm_phase<g8::EpiNaIn, g8::DenseSched, false, FP8_NA != 0>(F.lds, S, E); }
                SEAM(pb + 0);
            }
            if (IN(pb + 1)) { if (PEN(8)) REP(8) { FRAME(); if (NA_NAIVE) na_attn_naive(F, ap); else na_attn_mfma(F, ap); } SEAM(pb + 1); }
        }
        if (IN(pb + 3)) { if (PEN(9)) REP(9) {
            for (int pm = blockIdx.x; pm < M / 256; pm += 256) {
                const int r0 = pm * 256;
                if (mixer == 0) { FRAME(); gla_gate(F, ap, jj, r0 + F.wave, r0 + 256, NWAVES); }
                else if (mixer == 1) { FRAME(); hyena_transpose(F, 64 * pm + F.wave, 64 * pm + 64, NWAVES); }
                VM_WAIT(); __syncthreads();
                { FRAME();
                  const bf16* wout = (mixer == 0) ? (const bf16*)(ws + WS_WGOUT) + (size_t)jj * 1024 * 1024 : (mixer == 1) ? (const bf16*)(ws + WS_WHOUT) : (const bf16*)(ws + WS_WNOUT);
                  const float* bout = (mixer == 0) ? nullptr : (mixer == 1) ? ap->in[IN_HBOUT] : ap->in[IN_NBOUT];
                  if (FP8_NAOUT && mixer == 2) {
                      g8::PanelSched S{(const bf16*)(ws + WS_AB), wout, pm, 4, 1024};
                      g8::EpiBf16 E{(bf16*)(ws + WS_HPRE), 1024, bout, 4, 2.44140625e-4f};
                      g8::gemm_phase<g8::EpiBf16, g8::PanelSched, false, true>(F.lds, S, E);
                  } else {
                  g8::PanelSched S{(const bf16*)(ws + WS_AB), wout, pm, 4};
                  g8::EpiBf16 E{(bf16*)(ws + WS_HPRE), 1024, bout, 0, 1.f};
                  g8::gemm_phase<g8::EpiBf16, g8::PanelSched, false>(F.lds, S, E); } }
                VM_WAIT(); __syncthreads();
                { FRAME();
                  const float* xin = (layer == 0) ? ap->in[IN_X] : nullptr;
                  ln1_phase(F, xin, (const bf16*)(ws + WS_XAB), ap->in[IN_LN1G] + layer * D, ap->in[IN_LN1B] + layer * D, (bf16*)(ws + WS_XBB), ws + WS_X8, r0 + F.wave, r0 + 256, NWAVES); }
                VM_WAIT(); __syncthreads();
                { FRAME();
                  g8::PanelSched S{(const bf16*)(ws + WS_XBB), (const bf16*)(ws + WS_WR) + (size_t)layer * 256 * 1024, pm, 1};
                  g8::EpiF32Cols32 E{(float*)(ws + WS_LOGIT)};
                  g8::gemm_phase<g8::EpiF32Cols32, g8::PanelSched, false>(F.lds, S, E);
                  VM_WAIT(); __syncthreads();
                  topk_rows(F, ap->in[IN_RB] + layer * 32, layer, r0); }
                __syncthreads();
            } }
            SEAM(pb + 3);
        }
        if (IN(pb + 8)) { if (PEN(13)) REP(13) { FRAME();
            const int T = moe_tables(F, layer);
            g8::MoeSched S{(const bf16*)(ws + WS_X8), (const bf16*)(ws + WS_WGU + (size_t)layer * 32 * 2048 * 1024), (size_t)2048 * 1024, (const int*)(ws + WS_TOKL),
                           (const LAS int*)(F.lds + LDS_ECNT), (const LAS int*)(F.lds + LDS_TBASE), (const LAS unsigned short*)(F.lds + LDS_TEXP), T, 8, F.G, (int)blockIdx.x, true, 1024};
            g8::EpiMoe1 E{(bf16*)(ws + WS_HBUF), ap->in[IN_BGU] + (size_t)layer * 32 * 2048};
            g8::gemm_phase<g8::EpiMoe1, g8::MoeSched, true, true>(F.lds, S, E); }
            SEAM(pb + 8);
        }
        if (IN(pb + 9)) { if (PEN(14)) REP(14) { FRAME();
            const int T = moe_tables(F, layer);
            g8::MoeSched S{(const bf16*)(ws + WS_HBUF), (const bf16*)(ws + WS_WDN + (size_t)layer * 32 * 1024 * 1024), (size_t)1024 * 1024, (const int*)(ws + WS_TOKL),
                           (const LAS int*)(F.lds + LDS_ECNT), (const LAS int*)(F.lds + LDS_TBASE), (const LAS unsigned short*)(F.lds + LDS_TEXP), T, 4, F.G, (int)blockIdx.x, false, 1024};
            g8::EpiMoe2 E{(bf16*)(ws + WS_YBUF), ap->in[IN_BDN] + (size_t)layer * 32 * 1024};
            g8::gemm_phase<g8::EpiMoe2, g8::MoeSched, false, true>(F.lds, S, E); }
            SEAM(pb + 9);
        }
        if (IN(pb + 10)) { const bool lastl = (layer == DEPTH - 1);
            if (PEN(15)) REP(15) { FRAME();
            (void)moe_tables(F, layer);
            ln2_phase(F, (const bf16*)(ws + WS_XBB), ap->in[IN_LN2G] + layer * D, ap->in[IN_LN2B] + layer * D, lastl ? ap->out : nullptr, lastl ? nullptr : (bf16*)(ws + WS_XAB), (((layer + 1) % 3 == 0) ? FP8_GLA : ((layer + 1) % 3 == 1) ? FP8_HY : FP8_NA) ? ws + WS_X8 : nullptr); }
            if (!lastl) SEAM(pb + 10);
        }
    }
#undef IN
#undef SEAM
#undef FRAME
}

extern "C" void kernel_launch(void* const* d_in, const int* in_sizes, int n_in, void* d_out, int out_size, void* d_ws, size_t ws_size, hipStream_t stream) {
    static int grid = 0;
    if (grid == 0) {
        if (n_in != 34 || out_size != M * D || ws_size < WS_NEED) { fprintf(stderr, "kernel_launch: unexpected shapes (n_in %d out %d ws %zu need %zu)\n", n_in, out_size, ws_size, (size_t)WS_NEED); grid = -1; return; }
        int dev = 0, cus = 0, per_cu = 0;
        if (hipGetDevice(&dev) != hipSuccess || hipDeviceGetAttribute(&cus, hipDeviceAttributeMultiprocessorCount, dev) != hipSuccess) { grid = -1; return; }
        if (hipFuncSetAttribute((const void*)enc_fwd, hipFuncAttributeMaxDynamicSharedMemorySize, LDS_BYTES) != hipSuccess) { fprintf(stderr, "kernel_launch: hipFuncSetAttribute failed\n"); grid = -1; return; }
        if (hipOccupancyMaxActiveBlocksPerMultiprocessor(&per_cu, (const void*)enc_fwd, NT, LDS_BYTES) != hipSuccess || per_cu < 1) fprintf(stderr, "kernel_launch: occupancy query reports %d\n", per_cu);
        (void)hipGetLastError();
        grid = 256;
        if (cus < 256) fprintf(stderr, "kernel_launch: %d CUs < 256: the persistent grid is not resident\n", cus);
    }
    if (grid < 0) return;
    (void)hipMemsetAsync((char*)d_ws + WS_CTL, 0, CTL_ZERO_BYTES, stream);
    Args a{};
    for (int i = 0; i < 34; ++i) a.in[i] = (const float*)d_in[i];
    a.out = (float*)d_out; a.ws = (unsigned char*)d_ws;
#if MK_ONE_LAUNCH
    a.ph_lo = 0; a.ph_hi = 1000;
    hipLaunchKernelGGL(enc_fwd, dim3(grid), dim3(NT), LDS_BYTES, stream, a);
#else
    int phases[64]; int np = 0;
    phases[np++] = 0;
    for (int l = 0; l < DEPTH; ++l) { const int pb = 1 + 16 * l, mixer = l % 3; for (int k = 0; k < 11; ++k) { if (k == 2 || k == 4 || k == 5 || k == 6 || k == 7) continue; phases[np++] = pb + k; } }
    for (int i = 0; i < np; ++i) { a.ph_lo = phases[i]; a.ph_hi = phases[i] + 1; hipLaunchKernelGGL(enc_fwd, dim3(grid), dim3(NT), LDS_BYTES, stream, a); }
#endif
}
```

```cpp
#include <hip/hip_runtime.h>
#include <cstdio>
#include <cstdint>

#ifndef PHASE_MASK
#define PHASE_MASK 0xFFFFFFFFu
#endif
#define PEN(k) ((PHASE_MASK >> (k)) & 1u)
#ifndef REPEAT_MASK
#define REPEAT_MASK 0u
#endif
#define REP(k) for (int rep_ = 0; rep_ < 1 + (int)((REPEAT_MASK >> (k)) & 1u); ++rep_)
#ifndef GLA_NAIVE
#define GLA_NAIVE 0
#endif
#ifndef NA_NAIVE
#define NA_NAIVE 0
#endif
#ifndef FP8_GLA
#define FP8_GLA 0
#endif
#ifndef FP8_NAOUT
#define FP8_NAOUT 1
#endif
#ifndef FP8_HY
#define FP8_HY 0
#endif
#ifndef FP8_NA
#define FP8_NA 1
#endif
#ifndef MK_ONE_LAUNCH
#define MK_ONE_LAUNCH 1
#endif

#define GAS __attribute__((address_space(1)))
#define LAS __attribute__((address_space(3)))
#define HD __device__ __forceinline__
typedef unsigned short bf16;
typedef unsigned v4u __attribute__((ext_vector_type(4)));
typedef unsigned v2u __attribute__((ext_vector_type(2)));
typedef float f32x4 __attribute__((ext_vector_type(4)));
typedef float f32x2 __attribute__((ext_vector_type(2)));
typedef short bf16x8 __attribute__((ext_vector_type(8)));
typedef short s16x4 __attribute__((ext_vector_type(4)));
typedef int i32x8 __attribute__((ext_vector_type(8)));
typedef int i32x4 __attribute__((ext_vector_type(4)));

constexpr int D = 1024, NB = 16, SEQ = 4096, M = NB * SEQ, DEPTH = 4;
constexpr int NEXP = 32, TOPK = 4;
constexpr int GLA_NIN = 3104, GLA_NPAD = 3328;
constexpr float LN_EPS = 1e-5f;
constexpr float DN_ALPHA = 1.6817928305074290f;
constexpr int NWAVES = 8, NT = 512;
constexpr int MAXTILES = 1088;
constexpr int MOE_ROWS = MAXTILES * 256;

constexpr size_t MiB = 1ull << 20;
constexpr size_t WS_CTL = 0, CTL_ZERO_BYTES = 1 * MiB;
constexpr size_t WS_WGIN = 2 * MiB;
constexpr size_t WS_WGOUT = WS_WGIN + 14 * MiB;
constexpr size_t WS_WHIN = WS_WGOUT + 4 * MiB;
constexpr size_t WS_WHOUT = WS_WHIN + 6 * MiB;
constexpr size_t WS_WNIN = WS_WHOUT + 2 * MiB;
constexpr size_t WS_WNOUT = WS_WNIN + 6 * MiB;
constexpr size_t WS_WR = WS_WNOUT + 2 * MiB;
constexpr size_t WS_WGU = WS_WR + 2 * MiB;
constexpr size_t WS_WDN = WS_WGU + 512 * MiB;
constexpr size_t WS_HFB = WS_WDN + 256 * MiB;
constexpr size_t WS_HSPEC = WS_HFB + 64 * MiB;
constexpr size_t WS_XA = WS_HSPEC + 128 * MiB;
constexpr size_t WS_XB = WS_XA + 256 * MiB;
constexpr size_t WS_XAB = WS_XB + 256 * MiB;
constexpr size_t WS_XBB = WS_XAB + 128 * MiB;
constexpr size_t WS_HPRE = WS_XBB + 128 * MiB;
constexpr size_t WS_AB = WS_HPRE + 128 * MiB;
constexpr size_t WS_BIG = WS_AB + 128 * MiB;
constexpr size_t WS_QKVG = WS_BIG;
constexpr size_t WS_GLOW = WS_QKVG + 384 * MiB;
constexpr size_t WS_OF = WS_GLOW + 8 * MiB;
constexpr size_t WS_OB = WS_OF + 256 * MiB;
constexpr size_t WS_QT2 = WS_OF + 128 * MiB;
constexpr size_t WS_KT2 = WS_OB + 128 * MiB;
constexpr size_t WS_GS2 = WS_OB + 256 * MiB;
constexpr size_t WS_PT = WS_BIG;
constexpr size_t WS_OUTT = WS_PT + 384 * MiB;
constexpr size_t WS_QH = WS_BIG, WS_KH = WS_QH + 128 * MiB, WS_VH = WS_KH + 128 * MiB;
constexpr size_t WS_HBUF = WS_BIG;
constexpr size_t WS_YBUF = WS_HBUF + (size_t)MOE_ROWS * 2048;
constexpr size_t WS_TOKL = WS_YBUF + (size_t)MOE_ROWS * 2048;
constexpr size_t WS_SEL = WS_TOKL + 8 * MiB;
constexpr size_t WS_GATE = WS_SEL + 2 * MiB;
constexpr size_t WS_LOGIT = WS_GATE + 1 * MiB;
constexpr size_t WS_X8 = WS_LOGIT + 8 * MiB;
constexpr size_t WS_XS = WS_X8 + 64 * MiB;
constexpr size_t WS_END = WS_XS + (size_t)MOE_ROWS * 1024;
static_assert(WS_OB + 256 * MiB <= WS_END + 64 * MiB, "map");
constexpr size_t WS_NEED = (WS_END > WS_OB + 256 * MiB ? WS_END : WS_OB + 256 * MiB);
constexpr int CW_TMO = 0;
constexpr int CW_CNT = 64;
constexpr int CW_BAR = 4096;

constexpr int RING_BYTES = 131072;
constexpr int LDS_MISC = RING_BYTES;
constexpr int LDS_WTAB = LDS_MISC + 1024;
constexpr int LDS_ECNT = LDS_MISC + 1280;
constexpr int LDS_TBASE = LDS_ECNT + 128;
constexpr int LDS_TEXP = LDS_TBASE + 144;
constexpr int LDS_BYTES = 147456;
static_assert(LDS_TEXP + MAXTILES * 2 <= LDS_BYTES && LDS_MISC == 131072 && LDS_WTAB == 131072 + 1024, "lds");

#define LDS_WAIT() asm volatile("s_waitcnt lgkmcnt(0)" ::: "memory")
#define VM_WAIT() asm volatile("s_waitcnt vmcnt(0)" ::: "memory")
typedef __bf16 hwbf16x2 __attribute__((ext_vector_type(2)));
HD unsigned pk2(float lo, float hi) { const hwbf16x2 r = __builtin_convertvector((f32x2){lo, hi}, hwbf16x2); return __builtin_bit_cast(unsigned, r); }
HD unsigned f2bf(float f) { return pk2(f, 0.f) & 0xffffu; }
HD float clamp8(float v) { return fminf(fmaxf(v, -448.f), 448.f); }
HD unsigned pk4_fp8(float a, float b, float c, float d) { int w = 0; w = __builtin_amdgcn_cvt_pk_fp8_f32(clamp8(a), clamp8(b), w, false); w = __builtin_amdgcn_cvt_pk_fp8_f32(clamp8(c), clamp8(d), w, true); return (unsigned)w; }
HD float bf2f(unsigned b) { return __builtin_bit_cast(float, b << 16); }
HD float bflo(unsigned w) { return __builtin_bit_cast(float, w << 16); }
HD float bfhi(unsigned w) { return __builtin_bit_cast(float, w & 0xffff0000u); }
HD float sin_rev(float r) { r -= rintf(r); return __builtin_amdgcn_sinf(r); }
HD float cos_rev(float r) { r -= rintf(r); return __builtin_amdgcn_cosf(r); }
HD float sin_rad(float x) { return sin_rev(x * 0.15915494309189535f); }
HD int hw_slot() { const unsigned h = (unsigned)__builtin_amdgcn_s_getreg((6 << 11) | 4); return (int)(h & 0x3fu); }
HD int my_tid(const LAS unsigned char* lds_) {
    const int lane = (int)__builtin_amdgcn_mbcnt_hi(~0u, __builtin_amdgcn_mbcnt_lo(~0u, 0u));
    const int wv = __builtin_amdgcn_readfirstlane(((const LAS int*)(lds_ + 131072 + 1024))[hw_slot()]);
    return wv * 64 + lane;
}
template <int CTRL> HD float dpp_add(float v) { const int t = __builtin_amdgcn_update_dpp(0, __builtin_bit_cast(int, v), CTRL, 0xf, 0xf, true); return v + __builtin_bit_cast(float, t); }
HD float wave_sum(float v) {
    v = dpp_add<0xB1>(v); v = dpp_add<0x4E>(v); v = dpp_add<0x141>(v); v = dpp_add<0x140>(v);
    const int iv = __builtin_bit_cast(int, v);
    return (__builtin_bit_cast(float, __builtin_amdgcn_readlane(iv, 0)) + __builtin_bit_cast(float, __builtin_amdgcn_readlane(iv, 16)))
         + (__builtin_bit_cast(float, __builtin_amdgcn_readlane(iv, 32)) + __builtin_bit_cast(float, __builtin_amdgcn_readlane(iv, 48)));
}

#define XB_TMO      128
#define XB_XCNT(j)  (256  + 64 * (j))
#define XB_XSUB(j)  (1280 + 64 * (j))
#define XB_XGEN(j)  (2304 + 64 * (j))
#define XB_TOP      3328
#define XB_TOPGEN   3392
#define XCD_BAR_WORDS 3456
#define XB_SPIN_CAP (1u << 18)
__device__ __forceinline__ unsigned xb_ld(unsigned* p)              { return __hip_atomic_load(p, __ATOMIC_RELAXED, __HIP_MEMORY_SCOPE_AGENT); }
__device__ __forceinline__ unsigned xb_add(unsigned* p, unsigned v) { return __hip_atomic_fetch_add(p, v, __ATOMIC_RELAXED, __HIP_MEMORY_SCOPE_AGENT); }
__device__ __forceinline__ unsigned xb_xcc_id() { return (unsigned)__builtin_amdgcn_s_getreg((3 << 11) | 20) & 0xFu; }
#define XB_SPIN(cond, bar) do { unsigned _sp = 0; while (cond) { __builtin_amdgcn_s_sleep(1); \
    if ((++_sp & 255u) == 0u) { if (xb_ld(&(bar)[XB_TMO])) break; if (_sp > XB_SPIN_CAP) { atomicAdd(&(bar)[XB_TMO], 1u); break; } } } } while (0)
struct XcdBarrier { unsigned* bar; unsigned x; volatile LAS unsigned* st; };
__device__ __forceinline__ XcdBarrier xcd_barrier_post(unsigned* bar, volatile LAS unsigned* st) {
    XcdBarrier b; b.bar = bar; b.x = xb_xcc_id(); b.st = st;
    if (my_tid((const LAS unsigned char*)st - (131072 + 32)) == 0) (void)xb_add(&bar[XB_XCNT(b.x)], 1u);
    return b;
}
__device__ __forceinline__ void xcd_barrier_complete(unsigned* bar, unsigned x, unsigned& nloc, unsigned& nx) {
    const unsigned G = gridDim.x * gridDim.y * gridDim.z;
    unsigned sum, cnt, mine, sp = 0u;
    for (;;) {
        sum = 0u; cnt = 0u; mine = 0u;
#pragma unroll
        for (unsigned j = 0; j < 16; ++j) { const unsigned c = xb_ld(&bar[XB_XCNT(j)]); sum += c; cnt += (c > 0u) ? 1u : 0u; mine = (j == x) ? c : mine; }
        if (sum == G) break;
        __builtin_amdgcn_s_sleep(1);
        if ((++sp & 255u) == 0u) { if (xb_ld(&bar[XB_TMO])) break; if (sp > XB_SPIN_CAP) { atomicAdd(&bar[XB_TMO], 1u); break; } }
    }
    nloc = mine > 0u ? mine : 1u; nx = cnt > 0u ? cnt : 1u;
}
__device__ __forceinline__ void xcd_barrier(const XcdBarrier& b) {
    asm volatile("s_waitcnt vmcnt(0)" ::: "memory");
    __syncthreads();
    if (my_tid((const LAS unsigned char*)b.st - (131072 + 32)) == 0) {
        unsigned* bar = b.bar;
        __builtin_amdgcn_s_waitcnt(0);
        unsigned nloc = b.st[0], nx = b.st[1];
        if (nloc == 0u) { xcd_barrier_complete(bar, b.x, nloc, nx); b.st[0] = nloc; b.st[1] = nx; }
        const unsigned old = xb_add(&bar[XB_XSUB(b.x)], 1u);
        const unsigned gen = old / nloc;
        if (old + 1u == (gen + 1u) * nloc) {
            __builtin_amdgcn_fence(__ATOMIC_RELEASE, "agent");
            asm volatile("s_waitcnt vmcnt(0)" ::: "memory");
            const unsigned og = xb_add(&bar[XB_TOP], 1u);
            const unsigned tg = og / nx;
            if (og + 1u == (tg + 1u) * nx) xb_add(&bar[XB_TOPGEN], 1u);
            else XB_SPIN(xb_ld(&bar[XB_TOPGEN]) == tg, bar);
            __builtin_amdgcn_fence(__ATOMIC_ACQUIRE, "agent");
            xb_add(&bar[XB_XGEN(b.x)], 1u);
            asm volatile("s_waitcnt vmcnt(0)" ::: "memory");
        } else {
            XB_SPIN(xb_ld(&bar[XB_XGEN(b.x)]) == gen, bar);
            __builtin_amdgcn_fence(__ATOMIC_ACQUIRE, "agent");
            asm volatile("s_waitcnt vmcnt(0)" ::: "memory");
        }
    }
    __syncthreads();
}

namespace g8 {
constexpr int BM = 256, BK = 64, HALF = 128, HTB = HALF * BK * 2, STAGE_BYTES = 8 * HTB, NXCD = 8, WGM = 8, K = 1024;
HD int lds_byte(int r, int c) { const int st = (r >> 4) * 2 + (c >> 5), rr = r & 15, cc = c & 31, ob = rr * 64 + cc * 2; return st * 1024 + (ob ^ (((ob >> 9) & 1) << 5)); }
HD void stage_rc(int b, int& R, int& C) { const int st = b / 1024, sb = b % 1024, swz = sb ^ (((sb >> 9) & 1) << 5); R = (st >> 1) * 16 + swz / 64; C = (st & 1) * 32 + (swz % 64) / 2; }
HD int perm32(int rho) { const int n = rho >> 4, i = rho & 15; return 8 * (i >> 2) + 4 * n + (i & 3); }
struct UnitD { const char* A; const char* B; int pm, pn, e, mt, cnt, rowbase; };
HD int fdiv(int a, int b) { int q = (int)((float)a * __builtin_amdgcn_rcpf((float)b)); const int r = a - q * b; q += (r >= b) ? 1 : 0; q -= (r < 0) ? 1 : 0; return q; }
HD void order_map(int L, int nM, int nN, int& pm, int& pn) {
    const int nwg = nM * nN; int wgid = L;
    { const int q = nwg / NXCD, r = nwg % NXCD, xcd = wgid % NXCD, off = wgid / NXCD; wgid = (xcd < r ? xcd * (q + 1) : r * (q + 1) + (xcd - r) * q) + off; }
    const int nig = WGM * nN, gid = fdiv(wgid, nig), fm = gid * WGM, gsz = (nM - fm) < WGM ? (nM - fm) : WGM;
    const int rem = wgid - gid * nig, pq = (gsz == WGM) ? (rem >> 3) : fdiv(rem, gsz);
    pm = fm + (rem - pq * gsz); pn = pq;
}
struct DenseSched {
    const bf16* A; const bf16* Bt; int nM, nN, G, c; int rowb = 2048;
    HD bool next(int i, UnitD& u) const {
        const long L = (long)i * G + c; if (L >= (long)nM * nN) return false;
        int pm, pn; order_map((int)L, nM, nN, pm, pn);
        u.pm = pm; u.pn = pn; u.e = 0; u.mt = 0; u.cnt = 256; u.rowbase = pm * 256;
        u.A = (const char*)A + (size_t)pm * (256 * rowb); u.B = (const char*)Bt + (size_t)pn * (256 * rowb); return true;
    }
    HD void rows(const UnitD&, int, unsigned (&)[2][2]) const {}
    HD unsigned off(unsigned raw, unsigned) const { return raw; }
};
struct PanelSched {
    const bf16* A; const bf16* Bt; int pm, nN; int rowb = 2048;
    HD bool next(int i, UnitD& u) const {
        if (i >= nN) return false;
        u.pm = pm; u.pn = i; u.e = 0; u.mt = 0; u.cnt = 256; u.rowbase = pm * 256;
        u.A = (const char*)A + (size_t)pm * (256 * rowb); u.B = (const char*)Bt + (size_t)i * (256 * rowb); return true;
    }
    HD void rows(const UnitD&, int, unsigned (&)[2][2]) const {}
    HD unsigned off(unsigned raw, unsigned) const { return raw; }
};
struct MoeSched {
    const bf16* Abase; const bf16* W; size_t wstride;
    const int* tokl; const LAS int* ecnt; const LAS int* tbase; const LAS unsigned short* texp;
    int T, nN, G, c; bool gather; int rowb;
    HD bool next(int i, UnitD& u) const {
        const long L = (long)i * G + c; if (L >= (long)T * nN) return false;
        int pm, pn; order_map((int)L, T, nN, pm, pn);
        const int e = __builtin_amdgcn_readfirstlane((int)texp[pm]), mt = pm - __builtin_amdgcn_readfirstlane(tbase[e]);
        u.pm = pm; u.pn = pn; u.e = e; u.mt = mt; u.cnt = __builtin_amdgcn_readfirstlane(ecnt[e]) - mt * 256; u.rowbase = pm * 256;
        u.A = gather ? (const char*)Abase : (const char*)Abase + (size_t)pm * (256 * rowb);
        u.B = (const char*)W + (size_t)e * wstride + (size_t)pn * (256 * rowb); return true;
    }
    HD void rows(const UnitD& u, int tid, unsigned (&v)[2][2]) const {
        const int* tl = tokl + (size_t)u.e * 65536 + u.mt * 256; int R, C; stage_rc(tid * 16, R, C); (void)C;
#pragma unroll
        for (int h = 0; h < 2; ++h)
#pragma unroll
            for (int i = 0; i < 2; ++i) { const int r = h * 128 + 64 * i + R; v[h][i] = (unsigned)tl[(r < u.cnt) ? r : 0]; }
    }
    HD unsigned off(unsigned raw, unsigned c2) const { return raw * (unsigned)rowb + c2; }
};

HD void glds16x2(const char* sbase, const char* sbase2, unsigned v0, unsigned lds_dst) {
    unsigned keep;
    const unsigned lds_dst2 = lds_dst + 0x2000u;
    asm volatile("s_mov_b32 %0, m0\n\ts_mov_b32 m0, %4\n\ts_nop 0\n\tglobal_load_lds_dwordx4 %1, %2\n\ts_mov_b32 m0, %5\n\ts_nop 0\n\tglobal_load_lds_dwordx4 %1, %3\n\ts_mov_b32 m0, %0"
                 : "=&s"(keep) : "v"(v0), "s"(sbase), "s"(sbase2), "s"(lds_dst), "s"(lds_dst2) : "memory");
}
HD void glds16x2g(const char* sbase, unsigned v0, unsigned v1, unsigned lds_dst) {
    unsigned keep;
    const unsigned lds_dst2 = lds_dst + 0x2000u;
    asm volatile("s_mov_b32 %0, m0\n\ts_mov_b32 m0, %4\n\ts_nop 0\n\tglobal_load_lds_dwordx4 %1, %3\n\ts_mov_b32 m0, %5\n\ts_nop 0\n\tglobal_load_lds_dwordx4 %2, %3\n\ts_mov_b32 m0, %0"
                 : "=&s"(keep) : "v"(v0), "v"(v1), "s"(sbase), "s"(lds_dst), "s"(lds_dst2) : "memory");
}
HD i32x8 cat32(bf16x8 lo, bf16x8 hi) { const i32x4 a = __builtin_bit_cast(i32x4, lo), b = __builtin_bit_cast(i32x4, hi); return (i32x8){a[0], a[1], a[2], a[3], b[0], b[1], b[2], b[3]}; }
template <class Epi, class Sched, bool GATHER, bool F8 = false>
__device__ __forceinline__ void gemm_phase(LAS unsigned char* lds, const Sched& S, const Epi& E) {
    int tid = my_tid(lds); asm volatile("" : "+v"(tid));
    const int wid = __builtin_amdgcn_readfirstlane(tid >> 6), lane = tid & 63, wr = wid >> 2, wc = wid & 3, fr = lane & 15, fq = lane >> 4;
    constexpr int ROWB = F8 ? 1024 : 2048;
    constexpr int nt = ROWB / 128;
    unsigned voffB, voffA0;
    { int R, C; stage_rc(tid * 16, R, C); const int Rb = (R & ~31) + perm32(R & 31); voffA0 = (unsigned)(R * ROWB + C * 2); voffB = (unsigned)(Rb * ROWB + C * 2); }
    constexpr size_t kstep = (size_t)(BK * 2);
    constexpr size_t hstep = (size_t)HALF * ROWB;
    const unsigned ldsw = (unsigned)wid * 1024u; const unsigned ldsbase = (unsigned)(size_t)lds;
    const int fcol = fq * 8;
    const int aoff = lds_byte(wr * 64 + fr, fcol), boff = lds_byte(wc * 32 + fr, fcol);

#define PG8_SA(b, h) (((b) * 2 + (h)) * HTB)
#define PG8_SB(b, h) ((4 + (b) * 2 + (h)) * HTB)
#define PG8_STAGE(bufoff, gbase, voff) glds16x2((const char*)(gbase), (const char*)(gbase) + 64 * ROWB, (voff), ldsbase + (unsigned)(bufoff) + ldsw)
#define PG8_STAGE_A(bufoff, gbase, vv) do { if constexpr (GATHER) glds16x2g((const char*)(gbase), (vv)[0], (vv)[1], ldsbase + (unsigned)(bufoff) + ldsw); else PG8_STAGE(bufoff, gbase, (vv)[0]); } while (0)
#define PG8_LDA(dst, b, h) do { if constexpr (F8) { _Pragma("unroll") for (int m = 0; m < 4; ++m) dst##8[m] = cat32(*(const LAS bf16x8*)(lds + PG8_SA(b, h) + aoff + m * 2048), *(const LAS bf16x8*)(lds + PG8_SA(b, h) + aoff + m * 2048 + 1024)); } \
        else { _Pragma("unroll") for (int m = 0; m < 4; ++m) _Pragma("unroll") for (int k = 0; k < 2; ++k) dst[m][k] = *(const LAS bf16x8*)(lds + PG8_SA(b, h) + aoff + m * 2048 + k * 1024); } } while (0)
#define PG8_LDB(dst, b, h) do { if constexpr (F8) { _Pragma("unroll") for (int n = 0; n < 2; ++n) dst##8[n] = cat32(*(const LAS bf16x8*)(lds + PG8_SB(b, h) + boff + n * 2048), *(const LAS bf16x8*)(lds + PG8_SB(b, h) + boff + n * 2048 + 1024)); } \
        else { _Pragma("unroll") for (int n = 0; n < 2; ++n) _Pragma("unroll") for (int k = 0; k < 2; ++k) dst[n][k] = *(const LAS bf16x8*)(lds + PG8_SB(b, h) + boff + n * 2048 + k * 1024); } } while (0)
#define PG8_MMA(ai, bj, At, Bt) do { __builtin_amdgcn_s_setprio(1); _Pragma("unroll") for (int m = 0; m < 4; ++m) _Pragma("unroll") for (int n = 0; n < 2; ++n) { \
        if constexpr (F8) asm volatile("v_mfma_scale_f32_16x16x128_f8f6f4 %0, %1, %2, %0, %3, %3 op_sel_hi:[0,0,0]" : "+v"(acc[ai][bj][m][n]) : "v"(Bt##8[n]), "v"(At##8[m]), "v"(scl8)); \
        else { _Pragma("unroll") for (int k = 0; k < 2; ++k) acc[ai][bj][m][n] = __builtin_amdgcn_mfma_f32_16x16x32_bf16(Bt[n][k], At[m][k], acc[ai][bj][m][n], 0, 0, 0); } } __builtin_amdgcn_s_setprio(0); } while (0)
#define PG8_WAIT_V(n) asm volatile("s_waitcnt vmcnt(" #n ")" ::: "memory")
#define PG8_WAIT_L(n) asm volatile("s_waitcnt lgkmcnt(" #n ")" ::: "memory")
#define PG8_WAIT_VR(relax) do { if constexpr (Epi::NST == 16) { if (relax) PG8_WAIT_V(24); else PG8_WAIT_V(8); } else if constexpr (Epi::NST == 8) { if (relax) PG8_WAIT_V(16); else PG8_WAIT_V(8); } else PG8_WAIT_V(8); } while (0)
#define PG8_BAR __builtin_amdgcn_s_barrier()
#define PG8_SCHED __builtin_amdgcn_sched_barrier(0)
    UnitD cur, nxt; int ui = 0; bool relaxU = false;
    if (!S.next(0, cur)) return;
    f32x4 acc[2][2][4][2];
    bf16x8 At[4][2], B0[2][2], B1[2][2]; i32x8 At8[4], B08[2], B18[2]; unsigned scl8 = 0x7F7F7F7Fu; asm volatile("" : "+v"(scl8));
    unsigned vA[2][2], vN[2][2], vNN[2][2];
    constexpr size_t ah = GATHER ? 0 : hstep;
    if constexpr (GATHER) { UnitD nn; S.rows(cur, tid, vA); const bool has_nn = S.next(1, nn); if (has_nn) S.rows(nn, tid, vN);
#pragma unroll
        for (int h = 0; h < 2; ++h)
#pragma unroll
            for (int i = 0; i < 2; ++i) { if (!has_nn) vN[h][i] = vA[h][i]; vNN[h][i] = vN[h][i]; vA[h][i] = S.off(vA[h][i], voffB & 127u); vN[h][i] = S.off(vN[h][i], voffB & 127u); } }
    else {
#pragma unroll
        for (int h = 0; h < 2; ++h)
#pragma unroll
            for (int i = 0; i < 2; ++i) { vA[h][i] = voffA0; vN[h][i] = voffA0; vNN[h][i] = voffA0; }
    }
    const char* cA = cur.A; const char* cB = cur.B;
    typename Epi::Pre preN;
    { int l2 = (int)__builtin_amdgcn_mbcnt_hi(~0u, __builtin_amdgcn_mbcnt_lo(~0u, 0u)); asm volatile("" : "+v"(l2)); preN = E.pre(cur, wr, wc, l2 & 15, l2 >> 4); E.init(acc, preN, cur); }
    PG8_STAGE(PG8_SB(0, 0), cB, voffB); PG8_STAGE(PG8_SB(0, 1), cB + hstep, voffB); PG8_STAGE_A(PG8_SA(0, 0), cA, vA[0]); PG8_STAGE_A(PG8_SA(0, 1), cA + ah, vA[1]);
    if (wr == 1) PG8_BAR;
    PG8_WAIT_V(2); PG8_BAR;
    PG8_STAGE(PG8_SB(1, 0), cB + kstep, voffB); PG8_STAGE_A(PG8_SA(1, 0), cA + kstep, vA[0]); PG8_STAGE(PG8_SB(1, 1), cB + hstep + kstep, voffB);
    PG8_WAIT_V(6); PG8_BAR;
    for (;;) {
        const bool has_next = S.next(ui + 1, nxt);
        const char* nA = has_next ? nxt.A : cA; const char* nB = has_next ? nxt.B : cB;
        if constexpr (GATHER) { UnitD n2; if (S.next(ui + 2, n2)) S.rows(n2, tid, vNN); }
#pragma unroll 1
        for (int t = 0; t < nt; t += 2) {
            const bool last = (t == nt - 2);
            const char* a1 = cA + (size_t)(t + 1) * kstep;
            const char* a2 = last ? nA : cA + (size_t)(t + 2) * kstep; const char* b2 = last ? nB : cB + (size_t)(t + 2) * kstep;
            const char* a3 = a2 + kstep; const char* b3 = b2 + kstep;
            unsigned v2[2][2];
#pragma unroll
            for (int h = 0; h < 2; ++h)
#pragma unroll
                for (int i = 0; i < 2; ++i) v2[h][i] = GATHER ? (last ? vN[h][i] : vA[h][i]) : vA[h][i];
            const bool relax = relaxU && (t == 0);
            PG8_LDB(B0, 0, 0); PG8_LDB(B1, 0, 1); PG8_SCHED; PG8_LDA(At, 0, 0); PG8_STAGE_A(PG8_SA(1, 1), a1 + ah, vA[1]);
            PG8_WAIT_VR(relax); PG8_WAIT_L(0); PG8_BAR; PG8_MMA(0, 0, At, B0); PG8_MMA(0, 1, At, B1); PG8_BAR; PG8_SCHED;
            PG8_LDA(At, 0, 1); PG8_STAGE(PG8_SB(0, 0), b2, voffB); PG8_STAGE(PG8_SB(0, 1), b2 + hstep, voffB); PG8_STAGE_A(PG8_SA(0, 0), a2, v2[0]);
            PG8_WAIT_VR(relax); PG8_WAIT_L(0); PG8_BAR; PG8_MMA(1, 0, At, B0); PG8_MMA(1, 1, At, B1); PG8_BAR; PG8_SCHED;
            PG8_LDB(B0, 1, 0); PG8_LDB(B1, 1, 1); PG8_SCHED; PG8_LDA(At, 1, 0); PG8_STAGE_A(PG8_SA(0, 1), a2 + ah, v2[1]);
            PG8_WAIT_V(8); PG8_WAIT_L(0); PG8_BAR; PG8_MMA(0, 0, At, B0); PG8_MMA(0, 1, At, B1); PG8_BAR; PG8_SCHED;
            PG8_LDA(At, 1, 1); PG8_STAGE(PG8_SB(1, 0), b3, voffB); PG8_STAGE(PG8_SB(1, 1), b3 + hstep, voffB); PG8_STAGE_A(PG8_SA(1, 0), a3, v2[0]);
            PG8_WAIT_V(8); PG8_WAIT_L(0); PG8_BAR; PG8_MMA(1, 0, At, B0); PG8_MMA(1, 1, At, B1); PG8_BAR; PG8_SCHED;
        }
        if (wr == 0) PG8_BAR;
        if constexpr (F8) asm volatile("s_nop 15\n\ts_nop 15" ::: "memory");
        { int l2 = (int)__builtin_amdgcn_mbcnt_hi(~0u, __builtin_amdgcn_mbcnt_lo(~0u, 0u)); asm volatile("" : "+v"(l2)); preN = E.pre(has_next ? nxt : cur, wr, wc, l2 & 15, l2 >> 4); E(acc, cur, wr, wc, l2 & 15, l2 >> 4); }
        if (!has_next) break;
        E.init(acc, preN, nxt);
        relaxU = E.stored(cur, wc);
        cur = nxt; cA = nA; cB = nB; ++ui;
#pragma unroll
        for (int h = 0; h < 2; ++h)
#pragma unroll
            for (int i = 0; i < 2; ++i) { vA[h][i] = vN[h][i]; vN[h][i] = GATHER ? S.off(vNN[h][i], voffB & 127u) : vNN[h][i]; }
        asm volatile("" :: "v"(acc[0][0][0][0]), "v"(acc[0][0][0][1]), "v"(acc[0][1][0][0]), "v"(acc[0][1][0][1]), "v"(vN[0][0]), "v"(vN[0][1]), "v"(vN[1][0]), "v"(vN[1][1]) : "memory");
        if (wr == 1) PG8_BAR;
    }
    PG8_WAIT_V(0);
    PG8_BAR;
#undef PG8_SA
#undef PG8_SB
#undef PG8_STAGE
#undef PG8_STAGE_A
#undef PG8_LDA
#undef PG8_LDB
#undef PG8_MMA
#undef PG8_WAIT_V
#undef PG8_WAIT_VR
#undef PG8_WAIT_L
#undef PG8_BAR
#undef PG8_SCHED
}

HD v4u pack8(const f32x4 a, const f32x4 b) { v4u w; w.x = pk2(a[0], a[1]); w.y = pk2(a[2], a[3]); w.z = pk2(b[0], b[1]); w.w = pk2(b[2], b[3]); return w; }
typedef f32x4 AccT[2][2][4][2];
struct Pre16 { f32x4 v[4]; };
struct Pre0 {};
HD void acc_zero(AccT& acc) {
#pragma unroll
    for (int a = 0; a < 2; ++a)
#pragma unroll
        for (int b = 0; b < 2; ++b)
#pragma unroll
            for (int m = 0; m < 4; ++m)
#pragma unroll
                for (int n = 0; n < 2; ++n) acc[a][b][m][n] = (f32x4){0.f, 0.f, 0.f, 0.f};
}
HD void acc_colbias(AccT& acc, const Pre16& p, float s) {
    f32x4 q[4];
#pragma unroll
    for (int k = 0; k < 4; ++k) q[k] = p.v[k] * s;
#pragma unroll
    for (int a = 0; a < 2; ++a)
#pragma unroll
        for (int b = 0; b < 2; ++b)
#pragma unroll
            for (int m = 0; m < 4; ++m)
#pragma unroll
                for (int n = 0; n < 2; ++n) acc[a][b][m][n] = q[b * 2 + n];
}

struct EpiBf16 {
    bf16* O; int ldc; const float* bias; int nscale; float scale;
    static constexpr int NST = 16; HD bool stored(const UnitD&, int) const { return true; }
    typedef Pre16 Pre;
    HD Pre pre(const UnitD& u, int wr, int wc, int fr, int fq) const { Pre p; const int col0 = u.pn * 256 + wc * 32 + 8 * fq;
#pragma unroll
        for (int bj = 0; bj < 2; ++bj)
#pragma unroll
            for (int n = 0; n < 2; ++n) p.v[bj * 2 + n] = *(const f32x4*)((bias ? bias : (const float*)O) + col0 + bj * HALF + 4 * n);
        return p; }
    HD void init(AccT& acc, const Pre& p, const UnitD& u) const { if (bias) acc_colbias(acc, p, 1.f / ((u.pn < nscale) ? scale : 1.f)); else acc_zero(acc); }
    HD void operator()(const AccT& acc, const UnitD& u, int wr, int wc, int fr, int fq) const {
        const int row0 = u.rowbase + wr * 64 + fr, col0 = u.pn * 256 + wc * 32 + 8 * fq;
        const float sc = (u.pn < nscale) ? scale : 1.f;
#pragma unroll
        for (int ai = 0; ai < 2; ++ai)
#pragma unroll
            for (int m = 0; m < 4; ++m) { bf16* rowp = O + (size_t)(row0 + ai * HALF + m * 16) * ldc + col0;
#pragma unroll
                for (int bj = 0; bj < 2; ++bj) *(v4u*)(rowp + bj * HALF) = pack8(acc[ai][bj][m][0] * sc, acc[ai][bj][m][1] * sc); }
    }
};
struct EpiGlaIn {
    bf16* O; float* glow; float qscale; float ascale;
    static constexpr int NST = 16; HD bool stored(const UnitD& u, int wc) const { return u.pn < 12 || wc == 0; }
    typedef Pre0 Pre; HD Pre pre(const UnitD&, int, int, int, int) const { return Pre(); }
    HD void init(AccT& acc, const Pre&, const UnitD&) const { acc_zero(acc); }
    HD void operator()(const AccT& acc, const UnitD& u, int wr, int wc, int fr, int fq) const {
        const int row0 = u.rowbase + wr * 64 + fr;
        if (u.pn < 12) {
            const int col0 = u.pn * 256 + wc * 32 + 8 * fq; const float sc = ((u.pn < 2) ? qscale : 1.f) * ascale;
#pragma unroll
            for (int ai = 0; ai < 2; ++ai)
#pragma unroll
                for (int m = 0; m < 4; ++m) { bf16* rowp = O + (size_t)(row0 + ai * HALF + m * 16) * 3072 + col0;
#pragma unroll
                    for (int bj = 0; bj < 2; ++bj) *(v4u*)(rowp + bj * HALF) = pack8(acc[ai][bj][m][0] * sc, acc[ai][bj][m][1] * sc); }
        } else if (wc == 0) {
#pragma unroll
            for (int ai = 0; ai < 2; ++ai)
#pragma unroll
                for (int m = 0; m < 4; ++m) { float* rowp = glow + (size_t)(row0 + ai * HALF + m * 16) * 32 + 8 * fq;
                    *(f32x4*)(rowp) = acc[ai][0][m][0] * ascale; *(f32x4*)(rowp + 4) = acc[ai][0][m][1] * ascale; }
        }
    }
};
struct EpiF32Cols32 {
    float* O;
    static constexpr int NST = 0; HD bool stored(const UnitD&, int) const { return false; }
    typedef Pre0 Pre; HD Pre pre(const UnitD&, int, int, int, int) const { return Pre(); }
    HD void init(AccT& acc, const Pre&, const UnitD&) const { acc_zero(acc); }
    HD void operator()(const AccT& acc, const UnitD& u, int wr, int wc, int fr, int fq) const {
        if (u.pn != 0 || wc != 0) return;
        const int row0 = u.rowbase + wr * 64 + fr;
#pragma unroll
        for (int ai = 0; ai < 2; ++ai)
#pragma unroll
            for (int m = 0; m < 4; ++m) { float* rowp = O + (size_t)(row0 + ai * HALF + m * 16) * 32 + 8 * fq;
                *(f32x4*)(rowp) = acc[ai][0][m][0]; *(f32x4*)(rowp + 4) = acc[ai][0][m][1]; }
    }
};
struct EpiHyIn {
    bf16* O; const float* bias; float ascale;
    static constexpr int NST = 16; HD bool stored(const UnitD&, int) const { return true; }
    typedef Pre16 Pre;
    HD Pre pre(const UnitD& u, int wr, int wc, int fr, int fq) const { Pre p; const int row0 = u.rowbase + wr * 64 + fr;
#pragma unroll
        for (int ai = 0; ai < 2; ++ai)
#pragma unroll
            for (int m = 0; m < 4; ++m) p.v[ai][m] = bias[row0 + ai * HALF + m * 16];
        p.v[2] = (f32x4){0.f, 0.f, 0.f, 0.f}; p.v[3] = p.v[2]; return p; }
    HD void init(AccT& acc, const Pre& p, const UnitD&) const {
#pragma unroll
        for (int a = 0; a < 2; ++a)
#pragma unroll
            for (int b = 0; b < 2; ++b)
#pragma unroll
                for (int m = 0; m < 4; ++m)
#pragma unroll
                    for (int n = 0; n < 2; ++n) { const float v = p.v[a][m] * (1.f / ascale); acc[a][b][m][n] = (f32x4){v, v, v, v}; } }
    HD void operator()(const AccT& acc, const UnitD& u, int wr, int wc, int fr, int fq) const {
        const int row0 = u.rowbase + wr * 64 + fr, col0 = u.pn * 256 + wc * 32 + 8 * fq;
#pragma unroll
        for (int ai = 0; ai < 2; ++ai)
#pragma unroll
            for (int m = 0; m < 4; ++m) { const int r = row0 + ai * HALF + m * 16; bf16* rowp = O + (size_t)r * M + col0;
#pragma unroll
                for (int bj = 0; bj < 2; ++bj) *(v4u*)(rowp + bj * HALF) = pack8(acc[ai][bj][m][0] * ascale, acc[ai][bj][m][1] * ascale); }
    }
};
struct EpiNaIn {
    bf16* O; size_t tstride; const float* bias; float qscale; float ascale;
    static constexpr int NST = 16; HD bool stored(const UnitD&, int) const { return true; }
    typedef Pre16 Pre;
    HD Pre pre(const UnitD& u, int wr, int wc, int fr, int fq) const { Pre p;
#pragma unroll
        for (int bj = 0; bj < 2; ++bj) { const int bcol = u.pn * 256 + bj * HALF + wc * 32 + 8 * fq; p.v[bj * 2] = *(const f32x4*)(bias + bcol); p.v[bj * 2 + 1] = *(const f32x4*)(bias + bcol + 4); }
        return p; }
    HD void init(AccT& acc, const Pre& p, const UnitD&) const { acc_colbias(acc, p, 1.f / ascale); }
    HD void operator()(const AccT& acc, const UnitD& u, int wr, int wc, int fr, int fq) const {
        const int row0 = u.rowbase + wr * 64 + fr; const float sc = (u.pn < 4) ? qscale : 1.f;
        const int ten = u.pn >> 2; bf16* base = O + (size_t)ten * tstride;
#pragma unroll
        for (int bj = 0; bj < 2; ++bj) {
            const int colt = (u.pn & 3) * 256 + bj * HALF + wc * 32;
            const int h = colt >> 5; const int bcol = u.pn * 256 + bj * HALF + wc * 32 + 8 * fq;
            (void)bcol;
#pragma unroll
            for (int ai = 0; ai < 2; ++ai)
#pragma unroll
                for (int m = 0; m < 4; ++m) { const int r = row0 + ai * HALF + m * 16; const int b = r >> 12, tok = r & 4095;
                    bf16* p = base + ((size_t)(b * 32 + h) * 4096 + tok) * 32 + 8 * fq;
                    *(v4u*)p = pack8(acc[ai][bj][m][0] * (ascale * sc), acc[ai][bj][m][1] * (ascale * sc)); }
        }
    }
};
struct EpiMoe1 {
    bf16* O; const float* bgu;
    static constexpr int NST = 8; HD bool stored(const UnitD&, int) const { return true; }
    typedef Pre16 Pre;
    HD Pre pre(const UnitD& u, int wr, int wc, int fr, int fq) const { Pre p; const float* bb = bgu + (size_t)u.e * 2048 + u.pn * 128 + wc * 32 + 8 * fq;
#pragma unroll
        for (int n = 0; n < 2; ++n) { p.v[n] = *(const f32x4*)(bb + 4 * n); p.v[2 + n] = *(const f32x4*)(bb + 1024 + 4 * n); }
        return p; }
    HD void init(AccT& acc, const Pre& p, const UnitD&) const { acc_colbias(acc, p, 2048.f); }
    HD void operator()(const AccT& acc, const UnitD& u, int wr, int wc, int fr, int fq) const {
        const int row0 = u.rowbase + wr * 64 + fr, colh = u.pn * 128 + wc * 32 + 8 * fq;
#pragma unroll
        for (int ai = 0; ai < 2; ++ai)
#pragma unroll
            for (int m = 0; m < 4; ++m) {
                unsigned w8a[2];
#pragma unroll
                for (int n = 0; n < 2; ++n) { const f32x4 g4 = acc[ai][0][m][n] * 4.8828125e-4f, l4 = acc[ai][1][m][n] * 4.8828125e-4f;
                    f32x2 o2[2];
#pragma unroll
                    for (int jp = 0; jp < 2; ++jp) {
                        const f32x2 gg = (f32x2){fminf(g4[2 * jp], 7.f), fminf(g4[2 * jp + 1], 7.f)};
                        const f32x2 ll = (f32x2){fminf(fmaxf(l4[2 * jp], -7.f), 7.f), fminf(fmaxf(l4[2 * jp + 1], -7.f), 7.f)};
                        const f32x2 t = gg * -2.4554669595930156f;
                        const f32x2 d = (f32x2){__builtin_amdgcn_exp2f(t[0]), __builtin_amdgcn_exp2f(t[1])} + 1.f;
                        const f32x2 r = (f32x2){__builtin_amdgcn_rcpf(d[0]), __builtin_amdgcn_rcpf(d[1])};
                        o2[jp] = (gg * r) * (ll * 4.f + 4.f); }
                    int w = 0; w = __builtin_amdgcn_cvt_pk_fp8_f32(o2[0][0], o2[0][1], w, false); w = __builtin_amdgcn_cvt_pk_fp8_f32(o2[1][0], o2[1][1], w, true); w8a[n] = (unsigned)w; }
                v2u w8; w8.x = w8a[0]; w8.y = w8a[1];
                *(v2u*)((unsigned char*)O + (size_t)(row0 + ai * HALF + m * 16) * 1024 + colh) = w8;
            }
    }
};
struct EpiMoe2 {
    bf16* O; const float* bdn;
    static constexpr int NST = 16; HD bool stored(const UnitD&, int) const { return true; }
    typedef Pre16 Pre;
    HD Pre pre(const UnitD& u, int wr, int wc, int fr, int fq) const { Pre p; const float* bb = bdn + (size_t)u.e * 1024 + u.pn * 256 + wc * 32 + 8 * fq;
#pragma unroll
        for (int bj = 0; bj < 2; ++bj)
#pragma unroll
            for (int n = 0; n < 2; ++n) p.v[bj * 2 + n] = *(const f32x4*)(bb + bj * HALF + 4 * n);
        return p; }
    HD void init(AccT& acc, const Pre& p, const UnitD&) const { acc_colbias(acc, p, 1024.f); }
    HD void operator()(const AccT& acc, const UnitD& u, int wr, int wc, int fr, int fq) const {
        const int row0 = u.rowbase + wr * 64 + fr, col0 = u.pn * 256 + wc * 32 + 8 * fq;
#pragma unroll
        for (int ai = 0; ai < 2; ++ai)
#pragma unroll
            for (int m = 0; m < 4; ++m) { unsigned char* rowp = (unsigned char*)O + (size_t)(row0 + ai * HALF + m * 16) * 1024 + col0;
#pragma unroll
                for (int bj = 0; bj < 2; ++bj) { const f32x4 a0 = acc[ai][bj][m][0] * 0.03125f, a1 = acc[ai][bj][m][1] * 0.03125f; v2u w; w.x = pk4_fp8(a0[0], a0[1], a0[2], a0[3]); w.y = pk4_fp8(a1[0], a1[1], a1[2], a1[3]); *(v2u*)(rowp + bj * HALF) = w; } }
    }
};
}

typedef float cf __attribute__((ext_vector_type(2)));
HD cf cf_mk(float a, float b) { return (cf){a, b}; }
HD cf cadd(cf a, cf b) { return cf_mk(a.x + b.x, a.y + b.y); }
HD cf csub(cf a, cf b) { return cf_mk(a.x - b.x, a.y - b.y); }
HD cf cmul(cf a, cf b) { return cf_mk(a.x * b.x - a.y * b.y, a.x * b.y + a.y * b.x); }
HD cf cmulc(cf a, cf b) { return cf_mk(a.x * b.x + a.y * b.y, a.y * b.x - a.x * b.y); }
template <bool INV> HD void r4(cf& a0, cf& a1, cf& a2, cf& a3) {
    const cf t0 = cadd(a0, a2), t1 = csub(a0, a2), t2 = cadd(a1, a3), t3 = csub(a1, a3);
    a0 = cadd(t0, t2); a2 = csub(t0, t2);
    const cf mit3 = INV ? cf_mk(-t3.y, t3.x) : cf_mk(t3.y, -t3.x);
    a1 = cadd(t1, mit3); a3 = csub(t1, mit3);
}
template <bool INV> HD void dft16(cf (&x)[16]) {
    const float C1 = 0.92387953251128674f, S1 = 0.38268343236508977f, R2 = 0.70710678118654752f;
#pragma unroll
    for (int n0 = 0; n0 < 4; ++n0) r4<INV>(x[n0], x[n0 + 4], x[n0 + 8], x[n0 + 12]);
    const cf w1 = cf_mk(C1, INV ? S1 : -S1), w2 = cf_mk(R2, INV ? R2 : -R2), w3 = cf_mk(S1, INV ? C1 : -C1);
    const cf w4 = cf_mk(0.f, INV ? 1.f : -1.f), w6 = cf_mk(-R2, INV ? R2 : -R2), w9 = cf_mk(-C1, INV ? -S1 : S1);
    x[1 + 4] = cmul(x[1 + 4], w1); x[1 + 8] = cmul(x[1 + 8], w2); x[1 + 12] = cmul(x[1 + 12], w3);
    x[2 + 4] = cmul(x[2 + 4], w2); x[2 + 8] = cmul(x[2 + 8], w4); x[2 + 12] = cmul(x[2 + 12], w6);
    x[3 + 4] = cmul(x[3 + 4], w3); x[3 + 8] = cmul(x[3 + 8], w6); x[3 + 12] = cmul(x[3 + 12], w9);
    cf y[16];
#pragma unroll
    for (int k0 = 0; k0 < 4; ++k0) {
        cf b0 = x[0 + 4 * k0], b1 = x[1 + 4 * k0], b2 = x[2 + 4 * k0], b3 = x[3 + 4 * k0];
        r4<INV>(b0, b1, b2, b3);
        y[k0] = b0; y[k0 + 4] = b1; y[k0 + 8] = b2; y[k0 + 12] = b3;
    }
#pragma unroll
    for (int i = 0; i < 16; ++i) x[i] = y[i];
}
#define FFT_HALF_STRIDE 4352
#define FFT_LDS_COMPLEX (2 * FFT_HALF_STRIDE)
constexpr int FFT_TW_OFF = FFT_LDS_COMPLEX * 8;
static_assert(FFT_TW_OFF + 32768 <= RING_BYTES, "fft lds");
HD int fpos(int hf, int p) { return hf * FFT_HALF_STRIDE + p + (p >> 4); }
HD cf tw8192(const LAS cf* TW, int i) { i &= 8191; const cf t = TW[i & 4095]; return (i & 4096) ? cf_mk(-t.x, -t.y) : t; }
HD void fft_fwd_p1(LAS cf* buf, const LAS cf* TW, int tid) {
    const int hf = tid >> 8, j = tid & 255; cf x[16];
#pragma unroll
    for (int n2 = 0; n2 < 16; ++n2) x[n2] = buf[fpos(hf, n2 * 256 + j)];
    dft16<false>(x);
#pragma unroll
    for (int k0 = 0; k0 < 16; ++k0) { const cf v = k0 ? cmul(x[k0], tw8192(TW, 2 * j * k0)) : x[0]; buf[fpos(hf, k0 * 256 + j)] = v; }
}
HD void fft_fwd_p2(LAS cf* buf, const LAS cf* TW, int tid) {
    const int hf = tid >> 8, j = tid & 255, k0 = j >> 4, n0 = j & 15; cf x[16];
#pragma unroll
    for (int n1 = 0; n1 < 16; ++n1) x[n1] = buf[fpos(hf, k0 * 256 + n1 * 16 + n0)];
    dft16<false>(x);
#pragma unroll
    for (int k1 = 0; k1 < 16; ++k1) { const cf v = k1 ? cmul(x[k1], tw8192(TW, 32 * n0 * k1)) : x[0]; buf[fpos(hf, k0 * 256 + k1 * 16 + n0)] = v; }
}
HD void fft_fwd_p3(LAS cf* buf, int tid, cf (&x)[16]) {
    const int hf = tid >> 8, j = tid & 255;
#pragma unroll
    for (int n0 = 0; n0 < 16; ++n0) x[n0] = buf[fpos(hf, 16 * j + n0)];
    dft16<false>(x);
}
HD void fft_inv_p1(LAS cf* buf, int tid, cf (&x)[16]) {
    const int hf = tid >> 8, j = tid & 255;
    dft16<true>(x);
#pragma unroll
    for (int n0 = 0; n0 < 16; ++n0) buf[fpos(hf, 16 * j + n0)] = x[n0];
}
HD void fft_inv_p2(LAS cf* buf, const LAS cf* TW, int tid) {
    const int hf = tid >> 8, j = tid & 255, k0 = j >> 4, n0 = j & 15; cf x[16];
#pragma unroll
    for (int k1 = 0; k1 < 16; ++k1) { const cf v = buf[fpos(hf, k0 * 256 + k1 * 16 + n0)]; x[k1] = k1 ? cmulc(v, tw8192(TW, 32 * n0 * k1)) : v; }
    dft16<true>(x);
#pragma unroll
    for (int n1 = 0; n1 < 16; ++n1) buf[fpos(hf, k0 * 256 + n1 * 16 + n0)] = x[n1];
}
HD void fft_inv_p3(LAS cf* buf, const LAS cf* TW, int tid) {
    const int hf = tid >> 8, j = tid & 255; cf x[16];
#pragma unroll
    for (int k0 = 0; k0 < 16; ++k0) { const cf v = buf[fpos(hf, k0 * 256 + j)]; x[k0] = k0 ? cmulc(v, tw8192(TW, 2 * j * k0)) : v; }
    dft16<true>(x);
#pragma unroll
    for (int n2 = 0; n2 < 16; ++n2) buf[fpos(hf, n2 * 256 + j)] = x[n2];
}

struct Args { const float* in[34]; float* out; unsigned char* ws; int ph_lo, ph_hi; };
typedef const Args __attribute__((address_space(4)))* ArgsP;
HD ArgsP argp() { ArgsP p = (ArgsP)__builtin_amdgcn_kernarg_segment_ptr(); asm volatile("" : "+s"(p)); return p; }
struct Frame {
    LAS unsigned char* lds; unsigned char* ws; unsigned* ctl;
    int tid, lane, wave, G, gw, NGW;
};
HD Frame mkframe(ArgsP a, LAS unsigned char* lds) {
    Frame F; { unsigned lb = (unsigned)(size_t)lds; asm volatile("" : "+s"(lb)); lds = (LAS unsigned char*)(size_t)lb; }
    int tid = my_tid(lds); asm volatile("" : "+v"(tid));
    F.lds = lds; F.ws = a->ws; F.ctl = (unsigned*)(a->ws + WS_CTL);
    F.tid = tid; F.lane = tid & 63; F.wave = __builtin_amdgcn_readfirstlane(tid >> 6); F.G = gridDim.x; F.gw = blockIdx.x * NWAVES + F.wave; F.NGW = F.G * NWAVES;
    return F;
}
enum { IN_X = 0, IN_LN1G, IN_LN1B, IN_LN2G, IN_LN2B, IN_GWIN, IN_GW2, IN_GGB, IN_GNG, IN_GWOUT, IN_HWIN, IN_HBIN, IN_HCW, IN_HCB, IN_HW1, IN_HB1, IN_HSF, IN_HW2, IN_HB2, IN_HW3, IN_HFB,
       IN_HWOUT, IN_HBOUT, IN_NWIN, IN_NBIN, IN_NRPB, IN_NWOUT, IN_NBOUT, IN_RW, IN_RB, IN_WGU, IN_BGU, IN_WDN, IN_BDN };

HD void transpose_item(const float* W, int Kd, int N, bf16* WT, int item, int mode, LAS float* scr, int lane) {
    const int nblk = N / 32, kb = item / nblk, nb = item % nblk, k0 = 64 * kb, n0 = 32 * nb;
    float stg[32];
#pragma unroll
    for (int i = 0; i < 32; ++i) { const int kk = 2 * i + (lane >> 5); stg[i] = W[(size_t)(k0 + kk) * N + n0 + (lane & 31)]; }
#pragma unroll
    for (int i = 0; i < 32; ++i) { const int kk = 2 * i + (lane >> 5); scr[kk * 33 + (lane & 31)] = stg[i]; }
    LDS_WAIT(); asm volatile("" ::: "memory");
    int r0 = n0;
    if (mode == 1) r0 = (n0 < 1024) ? 256 * (n0 >> 7) + (n0 & 127) : 256 * ((n0 - 1024) >> 7) + 128 + ((n0 - 1024) & 127);
    const int c = lane & 7;
#pragma unroll
    for (int j = 0; j < 4; ++j) { const int n = (lane >> 3) + 8 * j; const LAS float* s = scr + (8 * c) * 33 + n;
        v4u o; o.x = pk2(s[0 * 33], s[1 * 33]); o.y = pk2(s[2 * 33], s[3 * 33]); o.z = pk2(s[4 * 33], s[5 * 33]); o.w = pk2(s[6 * 33], s[7 * 33]);
        *(v4u*)(WT + (size_t)(r0 + n) * Kd + k0 + 8 * c) = o; }
    LDS_WAIT(); asm volatile("" ::: "memory");
}
HD void transpose_item8(const float* W, int N, unsigned char* WT, int item, int mode, float scale, LAS float* scr, int lane) {
    const int nblk = N / 32, kb = item / nblk, nb = item % nblk, k0 = 64 * kb, n0 = 32 * nb;
    float stg[32];
#pragma unroll
    for (int i = 0; i < 32; ++i) { const int kk = 2 * i + (lane >> 5); stg[i] = W[(size_t)(k0 + kk) * N + n0 + (lane & 31)]; }
#pragma unroll
    for (int i = 0; i < 32; ++i) { const int kk = 2 * i + (lane >> 5); scr[kk * 33 + (lane & 31)] = stg[i]; }
    LDS_WAIT(); asm volatile("" ::: "memory");
    int r0 = n0;
    if (mode == 1) r0 = (n0 < 1024) ? 256 * (n0 >> 7) + (n0 & 127) : 256 * ((n0 - 1024) >> 7) + 128 + ((n0 - 1024) & 127);
    const int n = lane >> 1, hh = lane & 1; const LAS float* sp = scr + (32 * hh) * 33 + n;
    v4u o[2];
#pragma unroll
    for (int q = 0; q < 2; ++q)
#pragma unroll
        for (int d = 0; d < 4; ++d) { const int kk = 16 * q + 4 * d; o[q][d] = pk4_fp8(sp[kk * 33] * scale, sp[(kk + 1) * 33] * scale, sp[(kk + 2) * 33] * scale, sp[(kk + 3) * 33] * scale); }
    unsigned char* dst = WT + (size_t)(r0 + n) * 1024 + k0 + 32 * hh;
    *(v4u*)dst = o[0]; *(v4u*)(dst + 16) = o[1];
    LDS_WAIT(); asm volatile("" ::: "memory");
}
HD void p0_prologue(const Frame& F, ArgsP a) {
    LAS float* scr = (LAS float*)(F.lds + F.wave * 16384);
    bf16* wgin = (bf16*)(F.ws + WS_WGIN); bf16* wgout = (bf16*)(F.ws + WS_WGOUT); bf16* whin = (bf16*)(F.ws + WS_WHIN); bf16* whout = (bf16*)(F.ws + WS_WHOUT);
    bf16* wnin = (bf16*)(F.ws + WS_WNIN); bf16* wnout = (bf16*)(F.ws + WS_WNOUT); bf16* wr = (bf16*)(F.ws + WS_WR); unsigned char* wgu = F.ws + WS_WGU; unsigned char* wdn = F.ws + WS_WDN;
    constexpr int I_GIN = 16 * 97, I_SQ = 16 * 32, I_IN3 = 16 * 96, I_R = 16, I_GU = 16 * 64;
    constexpr int NSMALL = 2 * I_GIN + 2 * I_SQ + I_IN3 + I_SQ + I_IN3 + I_SQ + 4 * I_R;
    constexpr int NITEMS = NSMALL + 128 * I_GU + 128 * I_SQ;
    for (int it = F.gw; it < NITEMS; it += F.NGW) {
        int r = it;
        if (r < 2 * I_GIN) { const int j = r / I_GIN; if (FP8_GLA) transpose_item8(a->in[IN_GWIN] + (size_t)j * 1024 * GLA_NIN, GLA_NIN, (unsigned char*)wgin + (size_t)j * GLA_NPAD * 1024, r % I_GIN, 0, 128.f, scr, F.lane); else transpose_item(a->in[IN_GWIN] + (size_t)j * 1024 * GLA_NIN, 1024, GLA_NIN, wgin + (size_t)j * GLA_NPAD * 1024, r % I_GIN, 0, scr, F.lane); continue; } r -= 2 * I_GIN;
        if (r < 2 * I_SQ) { const int j = r / I_SQ; transpose_item(a->in[IN_GWOUT] + (size_t)j * 1024 * 1024, 1024, 1024, wgout + (size_t)j * 1024 * 1024, r % I_SQ, 0, scr, F.lane); continue; } r -= 2 * I_SQ;
        if (r < I_IN3) { if (FP8_HY) transpose_item8(a->in[IN_HWIN], 3072, (unsigned char*)whin, r, 0, 128.f, scr, F.lane); else transpose_item(a->in[IN_HWIN], 1024, 3072, whin, r, 0, scr, F.lane); continue; } r -= I_IN3;
        if (r < I_SQ) { transpose_item(a->in[IN_HWOUT], 1024, 1024, whout, r, 0, scr, F.lane); continue; } r -= I_SQ;
        if (r < I_IN3) { if (FP8_NA) transpose_item8(a->in[IN_NWIN], 3072, (unsigned char*)wnin, r, 0, 128.f, scr, F.lane); else transpose_item(a->in[IN_NWIN], 1024, 3072, wnin, r, 0, scr, F.lane); continue; } r -= I_IN3;
        if (r < I_SQ) { if (FP8_NAOUT) transpose_item8(a->in[IN_NWOUT], 1024, (unsigned char*)wnout, r, 0, 256.f, scr, F.lane); else transpose_item(a->in[IN_NWOUT], 1024, 1024, wnout, r, 0, scr, F.lane); continue; } r -= I_SQ;
        if (r < 4 * I_R) { const int j = r / I_R; transpose_item(a->in[IN_RW] + (size_t)j * 1024 * 32, 1024, 32, wr + (size_t)j * 256 * 1024, r % I_R, 0, scr, F.lane); continue; } r -= 4 * I_R;
        if (r < 128 * I_GU) { const int j = r / I_GU; transpose_item8(a->in[IN_WGU] + (size_t)j * 1024 * 2048, 2048, wgu + (size_t)j * 2048 * 1024, r % I_GU, 1, 128.f, scr, F.lane); continue; } r -= 128 * I_GU;
        { const int j = r / I_SQ; transpose_item8(a->in[IN_WDN] + (size_t)j * 1024 * 1024, 1024, wdn + (size_t)j * 1024 * 1024, r % I_SQ, 0, 256.f, scr, F.lane); }
    }
    { const f32x4* x4 = (const f32x4*)a->in[IN_X]; v2u* o = (v2u*)(F.ws + WS_XAB); unsigned* o8 = (unsigned*)(F.ws + WS_X8);
      for (size_t i = (size_t)blockIdx.x * NT + F.tid; i < (size_t)M * D / 4; i += (size_t)F.G * NT) { const f32x4 v = x4[i];
          if (FP8_GLA) o8[i] = pk4_fp8(v[0] * 16.f, v[1] * 16.f, v[2] * 16.f, v[3] * 16.f); else { v2u w; w.x = pk2(v[0], v[1]); w.y = pk2(v[2], v[3]); o[i] = w; } } }
}
HD void p0_hyena_filters(const Frame& F, ArgsP a) {
    __syncthreads();
    constexpr int TB = 16;
    LAS float* pe = (LAS float*)(F.lds);
    LAS float* h1 = pe + TB * 33 + 16;
    LAS float* h2 = h1 + TB * 64;
    const float* w1 = a->in[IN_HW1]; const float* b1 = a->in[IN_HB1]; const float* sf = a->in[IN_HSF]; const float* w2 = a->in[IN_HW2]; const float* b2 = a->in[IN_HB2]; const float* w3 = a->in[IN_HW3];
    float* hfb = (float*)(F.ws + WS_HFB);
    for (int item = blockIdx.x; item < (SEQ / TB) * 8; item += F.G) {
        const int tb = item >> 3, cb = item & 7, t0 = tb * TB;
        for (int i = F.tid; i < TB * 33; i += NT) { const int tt = i / 33, q = i % 33; const float t = (float)(t0 + tt); float v;
            if (q == 0) v = t / 4095.f;
            else { const int bnd = (q - 1) & 15; const float fr = 1e-4f + (float)bnd * ((15.f - 1e-4f) / 15.f); const float rev = t * fr * (1.f / 4096.f); v = (q <= 16) ? cos_rev(rev) : -sin_rev(rev); }
            pe[tt * 33 + q] = v; }
        __syncthreads();
        { const int tt = F.tid >> 5, j0 = (F.tid & 31) * 2;
#pragma unroll
          for (int q = 0; q < 2; ++q) { const int j = j0 + q; float z = b1[j];
#pragma unroll 1
              for (int i = 0; i < 33; ++i) z += pe[tt * 33 + i] * w1[i * 64 + j];
              h1[tt * 64 + j] = sin_rad(sf[j] * z); } }
        __syncthreads();
        { const int tt = F.tid >> 5, j0 = (F.tid & 31) * 2;
#pragma unroll
          for (int q = 0; q < 2; ++q) { const int j = j0 + q; float z = b2[j];
#pragma unroll 1
              for (int k = 0; k < 64; ++k) z += h1[tt * 64 + k] * w2[k * 64 + j];
              h2[tt * 64 + j] = sin_rad(sf[64 + j] * z); } }
        __syncthreads();
        { const int col = cb * 512 + F.tid; float acc[TB];
#pragma unroll
          for (int tt = 0; tt < TB; ++tt) acc[tt] = 0.f;
#pragma unroll 2
          for (int k = 0; k < 64; ++k) { const float w = w3[(size_t)k * 4096 + col];
#pragma unroll
              for (int tt = 0; tt < TB; ++tt) acc[tt] += h2[tt * 64 + k] * w; }
          const int o = col >> 11, dir = (col >> 10) & 1, d = col & 1023;
          const float delta = 3.0701134573253944f + (float)d * ((15.350567286626972f - 3.0701134573253944f) / 1023.f);
          float* dst = hfb + ((size_t)dir * 2048 + o * 1024 + d) * 4096 + t0;
#pragma unroll
          for (int q = 0; q < TB / 4; ++q) { f32x4 v;
#pragma unroll
              for (int j = 0; j < 4; ++j) { const int tt = 4 * q + j; const float tn = (float)(t0 + tt) / 4095.f; v[j] = acc[tt] * (__expf(-tn * delta) + 0.05f); }
              *(f32x4*)(dst + 4 * q) = v; } }
        __syncthreads();
    }
}
HD void fft_build_tw(const Frame& F) {
    LAS cf* TW = (LAS cf*)(F.lds + FFT_TW_OFF);
    for (int i = F.tid; i < 4096; i += NT) { const float r = (float)i * (1.f / 8192.f); TW[i] = cf_mk(__builtin_amdgcn_cosf(r), -__builtin_amdgcn_sinf(r)); }
    __syncthreads();
}
HD void hyena_filter_fft(const Frame& F) {
    LAS cf* buf = (LAS cf*)F.lds; const LAS cf* TW = (const LAS cf*)(F.lds + FFT_TW_OFF);
    const float* hfb = (const float*)(F.ws + WS_HFB); cf* spec = (cf*)(F.ws + WS_HSPEC);
    fft_build_tw(F);
    for (int od = blockIdx.x; od < 2048; od += F.G) {
        const float* hf = hfb + (size_t)od * 4096; const float* hb = hfb + ((size_t)2048 + od) * 4096;
#pragma unroll
        for (int i = 0; i < 8; ++i) { const int n = F.tid + 512 * i; const float xa = hf[n], xb = (n == 0) ? 0.f : hb[4096 - n];
            buf[fpos(0, n)] = cf_mk(xa + xb, 0.f); buf[fpos(1, n)] = cmul(cf_mk(xa - xb, 0.f), tw8192(TW, n)); }
        __syncthreads();
        fft_fwd_p1(buf, TW, F.tid); __syncthreads();
        fft_fwd_p2(buf, TW, F.tid); __syncthreads();
        { cf x[16]; fft_fwd_p3(buf, F.tid, x); cf* dst = spec + (size_t)od * 8192 + (F.tid >> 8) * 4096 + 16 * (F.tid & 255);
#pragma unroll
          for (int k = 0; k < 8; ++k) *(f32x4*)(dst + 2 * k) = (f32x4){x[2 * k].x, x[2 * k].y, x[2 * k + 1].x, x[2 * k + 1].y}; }
        __syncthreads();
    }
}

struct HyRaw { v4u w; unsigned short lo, hi; };
HD HyRaw hy_raw(const bf16* PT, int c, int b, int j) {
    const bf16* row = PT + (size_t)c * M + (size_t)b * 4096; HyRaw r;
    r.w = *(const v4u*)(row + 8 * j);
    r.lo = row[8 * j - ((j > 0) ? 1 : 0)]; r.hi = row[8 * j + ((j < 511) ? 8 : 7)];
    return r;
}
HD void hy_conv3(const HyRaw& r, int j, int c, const float* cw, const float* cb, float (&u)[8]) {
    float p[10];
    p[0] = (j > 0) ? bflo((unsigned)r.lo) : 0.f; p[9] = (j < 511) ? bflo((unsigned)r.hi) : 0.f;
    p[1] = bflo(r.w.x); p[2] = bfhi(r.w.x); p[3] = bflo(r.w.y); p[4] = bfhi(r.w.y); p[5] = bflo(r.w.z); p[6] = bfhi(r.w.z); p[7] = bflo(r.w.w); p[8] = bfhi(r.w.w);
    const float w0 = cw[c], w1 = cw[3072 + c], w2 = cw[6144 + c], bb = cb[c];
#pragma unroll
    for (int i = 0; i < 8; ++i) u[i] = w0 * p[i] + w1 * p[i + 1] + w2 * p[i + 2] + bb;
}
constexpr int FFT_T1_OFF = FFT_LDS_COMPLEX * 8, FFT_T2_OFF = FFT_T1_OFF + 32768;
static_assert(FFT_T2_OFF + 2048 <= RING_BYTES, "fft lds 2");
HD void fftc_build(const Frame& F) {
    LAS cf* T1 = (LAS cf*)(F.lds + FFT_T1_OFF); LAS cf* T2 = (LAS cf*)(F.lds + FFT_T2_OFF);
    for (int i = F.tid; i < 4096; i += NT) { const int k0 = i >> 8, j = i & 255; const float r = (float)((j * k0) & 4095) * (1.f / 4096.f); T1[i] = cf_mk(__builtin_amdgcn_cosf(r), -__builtin_amdgcn_sinf(r)); }
    for (int i = F.tid; i < 256; i += NT) { const int k1 = i >> 4, n0 = i & 15; const float r = (float)((n0 * k1) & 255) * (1.f / 256.f); T2[i] = cf_mk(__builtin_amdgcn_cosf(r), -__builtin_amdgcn_sinf(r)); }
    __syncthreads();
}
HD cf tw_direct(int n) { const float r = (float)n * (1.f / 8192.f); return cf_mk(__builtin_amdgcn_cosf(r), -__builtin_amdgcn_sinf(r)); }
HD void fftc_fwd_p1(LAS cf* buf, const LAS cf* T1, int tid) {
    const int hf = tid >> 8, j = tid & 255; cf x[16];
#pragma unroll
    for (int n2 = 0; n2 < 16; ++n2) x[n2] = buf[fpos(hf, n2 * 256 + j)];
    dft16<false>(x);
#pragma unroll
    for (int k0 = 0; k0 < 16; ++k0) buf[fpos(hf, k0 * 256 + j)] = k0 ? cmul(x[k0], T1[k0 * 256 + j]) : x[0];
}
HD void fftc_fwd_p2(LAS cf* buf, const LAS cf* T2, int tid) {
    const int hf = tid >> 8, j = tid & 255, k0 = j >> 4, n0 = j & 15; cf x[16];
#pragma unroll
    for (int n1 = 0; n1 < 16; ++n1) x[n1] = buf[fpos(hf, k0 * 256 + n1 * 16 + n0)];
    dft16<false>(x);
#pragma unroll
    for (int k1 = 0; k1 < 16; ++k1) buf[fpos(hf, k0 * 256 + k1 * 16 + n0)] = k1 ? cmul(x[k1], T2[k1 * 16 + n0]) : x[0];
}
HD void fftc_inv_p2(LAS cf* buf, const LAS cf* T2, int tid) {
    const int hf = tid >> 8, j = tid & 255, k0 = j >> 4, n0 = j & 15; cf x[16];
#pragma unroll
    for (int k1 = 0; k1 < 16; ++k1) { const cf v = buf[fpos(hf, k0 * 256 + k1 * 16 + n0)]; x[k1] = k1 ? cmulc(v, T2[k1 * 16 + n0]) : v; }
    dft16<true>(x);
#pragma unroll
    for (int n1 = 0; n1 < 16; ++n1) buf[fpos(hf, k0 * 256 + n1 * 16 + n0)] = x[n1];
}
HD void fftc_inv_p3(LAS cf* buf, const LAS cf* T1, int tid) {
    const int hf = tid >> 8, j = tid & 255; cf x[16];
#pragma unroll
    for (int k0 = 0; k0 < 16; ++k0) { const cf v = buf[fpos(hf, k0 * 256 + j)]; x[k0] = k0 ? cmulc(v, T1[k0 * 256 + j]) : v; }
    dft16<true>(x);
#pragma unroll
    for (int n2 = 0; n2 < 16; ++n2) buf[fpos(hf, n2 * 256 + j)] = x[n2];
}
HD void hy_fftconv(const Frame& F, LAS cf* buf, const LAS cf* T1, const LAS cf* T2, const cf* spec, const float (&in)[2][8], float (&y)[2][8]) {
    int tid = F.tid; asm volatile("" : "+v"(tid));
#pragma unroll
    for (int i = 0; i < 8; ++i) { const int n = 8 * tid + i; const cf c = cf_mk(in[0][i], in[1][i]); buf[fpos(0, n)] = c; buf[fpos(1, n)] = cmul(c, tw_direct(n)); }
    __syncthreads();
    fftc_fwd_p1(buf, T1, tid); __syncthreads();
    f32x4 hv[8];
    { const cf* sp = spec + (tid >> 8) * 4096 + 16 * (tid & 255);
#pragma unroll
      for (int k = 0; k < 8; ++k) hv[k] = *(const f32x4*)(sp + 2 * k); }
    fftc_fwd_p2(buf, T2, tid); __syncthreads();
    { cf x[16]; fft_fwd_p3(buf, tid, x);
#pragma unroll
      for (int k = 0; k < 8; ++k) { x[2 * k] = cmul(x[2 * k], cf_mk(hv[k][0], hv[k][1])); x[2 * k + 1] = cmul(x[2 * k + 1], cf_mk(hv[k][2], hv[k][3])); }
      fft_inv_p1(buf, tid, x); }
    __syncthreads();
    fftc_inv_p2(buf, T2, tid); __syncthreads();
    fftc_inv_p3(buf, T1, tid); __syncthreads();
#pragma unroll
    for (int i = 0; i < 8; ++i) { const int n = 8 * tid + i; const cf E = buf[fpos(0, n)], O = buf[fpos(1, n)]; const cf r = cadd(E, cmulc(O, tw_direct(n)));
        y[0][i] = r.x * (1.f / 8192.f); y[1][i] = r.y * (1.f / 8192.f); }
    __syncthreads();
}
HD void hyena_core(const Frame& F, ArgsP a) {
    LAS cf* buf = (LAS cf*)F.lds; const LAS cf* T1 = (const LAS cf*)(F.lds + FFT_T1_OFF); const LAS cf* T2 = (const LAS cf*)(F.lds + FFT_T2_OFF);
    const bf16* PT = (const bf16*)(F.ws + WS_PT); bf16* OT = (bf16*)(F.ws + WS_OUTT); const cf* spec = (const cf*)(F.ws + WS_HSPEC);
    const float* cw = a->in[IN_HCW]; const float* cb = a->in[IN_HCB]; const float* fb = a->in[IN_HFB];
    fftc_build(F);
    const int per = (8192 + F.G - 1) / F.G;
    const int it0 = blockIdx.x * per, it1 = min((blockIdx.x + 1) * per, 8192);
    HyRaw rv[2];
    if (it0 < it1) { rv[0] = hy_raw(PT, it0 >> 3, 2 * (it0 & 7), F.tid); rv[1] = hy_raw(PT, it0 >> 3, 2 * (it0 & 7) + 1, F.tid); }
    for (int it = it0; it < it1; ++it) {
        const int d = it >> 3, bp = it & 7, b0 = 2 * bp;
        float v[2][8], y[2][8], z[2][8], g[2][8];
        HyRaw r1[2]; r1[0] = hy_raw(PT, 1024 + d, b0, F.tid); r1[1] = hy_raw(PT, 1024 + d, b0 + 1, F.tid);
        hy_conv3(rv[0], F.tid, d, cw, cb, v[0]); hy_conv3(rv[1], F.tid, d, cw, cb, v[1]);
        hy_fftconv(F, buf, T1, T2, spec + (size_t)d * 8192, v, y);
        HyRaw r2[2]; r2[0] = hy_raw(PT, 2048 + d, b0, F.tid); r2[1] = hy_raw(PT, 2048 + d, b0 + 1, F.tid);
        { const int itn = (it + 1 < it1) ? it + 1 : it; const int dn = itn >> 3, bn = 2 * (itn & 7); rv[0] = hy_raw(PT, dn, bn, F.tid); rv[1] = hy_raw(PT, dn, bn + 1, F.tid); }
        hy_conv3(r1[0], F.tid, 1024 + d, cw, cb, g[0]); hy_conv3(r1[1], F.tid, 1024 + d, cw, cb, g[1]);
        const float fb0 = fb[d], fb1 = fb[1024 + d];
#pragma unroll
        for (int b = 0; b < 2; ++b)
#pragma unroll
            for (int i = 0; i < 8; ++i) z[b][i] = g[b][i] * (y[b][i] + v[b][i] * fb0);
        hy_fftconv(F, buf, T1, T2, spec + (size_t)(1024 + d) * 8192, z, y);
        hy_conv3(r2[0], F.tid, 2048 + d, cw, cb, g[0]); hy_conv3(r2[1], F.tid, 2048 + d, cw, cb, g[1]);
#pragma unroll
        for (int b = 0; b < 2; ++b) { float o[8];
#pragma unroll
            for (int i = 0; i < 8; ++i) o[i] = g[b][i] * (y[b][i] + z[b][i] * fb1);
            v4u w; w.x = pk2(o[0], o[1]); w.y = pk2(o[2], o[3]); w.z = pk2(o[4], o[5]); w.w = pk2(o[6], o[7]);
            *(v4u*)(OT + (size_t)d * M + (size_t)(b0 + b) * 4096 + 8 * F.tid) = w; }
    }
}
HD void hyena_transpose(const Frame& F, int t_first, int t_end, int t_step) {
    LAS unsigned char* scr = F.lds + F.wave * 8704;
    const bf16* OT = (const bf16*)(F.ws + WS_OUTT); bf16* AB = (bf16*)(F.ws + WS_AB);
    const int lane = F.lane;
    v4u wq[8];
    { const int tile = (t_first < t_end) ? t_first : 0; const int d0 = (tile & 15) * 64, m0 = (tile >> 4) * 64;
#pragma unroll
      for (int r = 0; r < 8; ++r) { const int dd = r * 8 + (lane >> 3), ch = lane & 7; wq[r] = *(const v4u*)(OT + (size_t)(d0 + dd) * M + m0 + 8 * ch); } }
    for (int tile = t_first; tile < t_end; tile += t_step) {
        const int dt = tile & 15, tt = tile >> 4, d0 = dt * 64, m0 = tt * 64;
#pragma unroll
        for (int r = 0; r < 8; ++r) { const int dd = r * 8 + (lane >> 3), ch = lane & 7; const v4u w = wq[r];
            LAS v2u* p = (LAS v2u*)(scr + dd * 136 + ch * 16); p[0] = (v2u){w.x, w.y}; p[1] = (v2u){w.z, w.w}; }
        { const int tn = (tile + t_step < t_end) ? tile + t_step : tile; const int dn = (tn & 15) * 64, mn = (tn >> 4) * 64;
#pragma unroll
          for (int r = 0; r < 8; ++r) { const int dd = r * 8 + (lane >> 3), ch = lane & 7; wq[r] = *(const v4u*)(OT + (size_t)(dn + dd) * M + mn + 8 * ch); } }
        LDS_WAIT(); asm volatile("" ::: "memory");
#pragma unroll
        for (int r = 0; r < 8; ++r) { const int tk = r * 8 + (lane >> 3), ch = lane & 7; unsigned e[8];
#pragma unroll
            for (int i = 0; i < 8; ++i) e[i] = *(const LAS unsigned short*)(scr + (ch * 8 + i) * 136 + tk * 2);
            v4u w; w.x = e[0] | (e[1] << 16); w.y = e[2] | (e[3] << 16); w.z = e[4] | (e[5] << 16); w.w = e[6] | (e[7] << 16);
            *(v4u*)(AB + (size_t)(m0 + tk) * 1024 + d0 + 8 * ch) = w; }
        LDS_WAIT(); asm volatile("" ::: "memory");
    }
}

HD void gla_scan_naive(const Frame& F, ArgsP a, int j) {
    constexpr int CH = 32;
    LAS float* qs = (LAS float*)F.lds;
    LAS float* ks = qs + CH * 128;
    LAS float* as = ks + CH * 128;
    LAS float* vs = as + CH * 128;
    const bf16* QK = (const bf16*)(F.ws + WS_QKVG); const float* glow = (const float*)(F.ws + WS_GLOW);
    const float* gw2 = a->in[IN_GW2] + (size_t)j * 2 * 16 * 512; const float* gb = a->in[IN_GGB] + (size_t)j * 2 * 512;
    const int e = F.tid >> 1, half = F.tid & 1;
    for (int item = blockIdx.x; item < 128; item += F.G) {
        const int dir = item & 1, h = (item >> 1) & 3, b = item >> 3;
        bf16* O = (bf16*)(F.ws + (dir ? WS_OB : WS_OF));
        f32x2 S[32];
#pragma unroll
        for (int i = 0; i < 32; ++i) S[i] = (f32x2){0.f, 0.f};
        for (int cc = 0; cc < SEQ / CH; ++cc) {
            const int c = dir ? (SEQ / CH - 1 - cc) : cc; const int mbase = b * SEQ + c * CH;
            __syncthreads();
            for (int i = F.tid; i < CH * 128; i += NT) { const int tt = i >> 7, dd = i & 127; const size_t m = (size_t)(mbase + tt);
                qs[i] = bf2f(QK[m * 3072 + h * 128 + dd]); ks[i] = bf2f(QK[m * 3072 + 512 + h * 128 + dd]);
                float lg = gb[dir * 512 + h * 128 + dd]; const float* gl = glow + m * 32 + dir * 16;
#pragma unroll
                for (int r = 0; r < 16; ++r) lg += gl[r] * gw2[(dir * 16 + r) * 512 + h * 128 + dd];
                const float ls = fminf(lg, 0.f) - log1pf(expf(-fabsf(lg)));
                as[i] = expf(ls * (1.f / 16.f)); }
            for (int i = F.tid; i < CH * 256; i += NT) { const int tt = i >> 8, ee = i & 255; vs[i] = bf2f(QK[(size_t)(mbase + tt) * 3072 + 1024 + h * 256 + ee]); }
            __syncthreads();
            for (int s = 0; s < CH; ++s) {
                const int tt = dir ? (CH - 1 - s) : s;
                const LAS f32x2* q2 = (const LAS f32x2*)(qs + tt * 128 + half * 64); const LAS f32x2* k2 = (const LAS f32x2*)(ks + tt * 128 + half * 64); const LAS f32x2* a2 = (const LAS f32x2*)(as + tt * 128 + half * 64);
                const float ve = vs[tt * 256 + e];
                f32x2 o2 = (f32x2){0.f, 0.f};
                if (dir) {
#pragma unroll
                    for (int i = 0; i < 32; ++i) { S[i] = S[i] * a2[i]; o2 += q2[i] * S[i]; S[i] += k2[i] * ve; }
                } else {
#pragma unroll
                    for (int i = 0; i < 32; ++i) { S[i] = S[i] * a2[i] + k2[i] * ve; o2 += q2[i] * S[i]; }
                }
                float o = o2[0] + o2[1]; o += __shfl_xor(o, 1);
                if (half == 0) O[(size_t)(mbase + tt) * 1024 + h * 256 + e] = (bf16)f2bf(o);
            }
        }
    }
}
HD void gla_prep(const Frame& F, ArgsP a, int j) {
    LAS unsigned short* QR = (LAS unsigned short*)F.lds;
    LAS unsigned short* KR = QR + 64 * 512;
    LAS float* GL = (LAS float*)(F.lds + 139264);
    static_assert(139264 >= LDS_TEXP + MAXTILES * 2 && 139264 + 8192 <= LDS_BYTES, "gla prep lds");
    const bf16* QK = (const bf16*)(F.ws + WS_QKVG); const float* glow = (const float*)(F.ws + WS_GLOW);
    bf16* QT2 = (bf16*)(F.ws + WS_QT2); bf16* KT2 = (bf16*)(F.ws + WS_KT2); float* GS2 = (float*)(F.ws + WS_GS2);
    const float* gw2 = a->in[IN_GW2] + (size_t)j * 2 * 16 * 512; const float* gb = a->in[IN_GGB] + (size_t)j * 2 * 512;
    const int d = F.tid;
    float w2[2][16], gbv[2];
#pragma unroll
    for (int dir = 0; dir < 2; ++dir) { gbv[dir] = gb[dir * 512 + d];
#pragma unroll
        for (int r = 0; r < 16; ++r) w2[dir][r] = gw2[(dir * 16 + r) * 512 + d]; }
    v4u rq[8], rk[8]; f32x4 rgl;
    { const int it0 = (blockIdx.x < NB * 64) ? (int)blockIdx.x : 0; const size_t mb = (size_t)it0 * 64;
      rgl = *(const f32x4*)(glow + mb * 32 + 4 * F.tid);
#pragma unroll
      for (int i = 0; i < 8; ++i) { const int p = F.tid + 512 * i, t = p >> 6, ch = p & 63; rq[i] = *(const v4u*)(QK + (mb + t) * 3072 + 8 * ch); rk[i] = *(const v4u*)(QK + (mb + t) * 3072 + 512 + 8 * ch); } }
    for (int item = blockIdx.x; item < NB * 64; item += F.G) {
        const size_t mbase = (size_t)item * 64;
        __syncthreads();
        *(LAS f32x4*)(GL + 4 * F.tid) = rgl;
#pragma unroll
        for (int i = 0; i < 8; ++i) { const int p = F.tid + 512 * i, t = p >> 6, ch = p & 63;
            *(LAS v4u*)(QR + t * 512 + 8 * ch) = rq[i];
            *(LAS v4u*)(KR + t * 512 + 8 * ch) = rk[i]; }
        __syncthreads();
        { const int itn = (item + F.G < NB * 64) ? item + F.G : item; const size_t mb = (size_t)itn * 64;
          rgl = *(const f32x4*)(glow + mb * 32 + 4 * F.tid);
#pragma unroll
          for (int i = 0; i < 8; ++i) { const int p = F.tid + 512 * i, t = p >> 6, ch = p & 63; rq[i] = *(const v4u*)(QK + (mb + t) * 3072 + 8 * ch); rk[i] = *(const v4u*)(QK + (mb + t) * 3072 + 512 + 8 * ch); } }
#pragma unroll
        for (int dir = 0; dir < 2; ++dir) {
            float run = 0.f;
#pragma unroll 1
            for (int s0 = 0; s0 < 64; s0 += 4) {
                f32x4 gvv[4][4]; unsigned short qr[4], kr[4];
                const int tlo = dir ? 60 - s0 : s0;
                unsigned ga = (unsigned)(size_t)(GL + tlo * 32 + dir * 16); asm volatile("" : "+v"(ga));
                const LAS f32x4* gb = (const LAS f32x4*)(size_t)ga; const LAS unsigned short* qb = QR + tlo * 512 + d; const LAS unsigned short* kb = KR + tlo * 512 + d;
#pragma unroll
                for (int u = 0; u < 4; ++u) { const int o = dir ? 3 - u : u;
#pragma unroll
                    for (int q4 = 0; q4 < 4; ++q4) gvv[u][q4] = gb[o * 8 + q4];
                    qr[u] = qb[o * 512]; kr[u] = kb[o * 512]; }
                __builtin_amdgcn_sched_barrier(0);
#pragma unroll
                for (int u = 0; u < 4; ++u) { const int t = dir ? 63 - (s0 + u) : s0 + u; float lg = gbv[dir];
#pragma unroll
                    for (int q4 = 0; q4 < 4; ++q4) { const f32x4 gv = gvv[u][q4];
                        lg = __builtin_fmaf(gv[0], w2[dir][4 * q4], lg); lg = __builtin_fmaf(gv[1], w2[dir][4 * q4 + 1], lg); lg = __builtin_fmaf(gv[2], w2[dir][4 * q4 + 2], lg); lg = __builtin_fmaf(gv[3], w2[dir][4 * q4 + 3], lg); }
                    const float sp = __builtin_amdgcn_logf(1.f + __builtin_amdgcn_exp2f(-1.4426950408889634f * fabsf(lg))) * 0.6931471805599453f;
                    run += (fminf(lg, 0.f) - sp) * (1.f / 16.f);
                    const float r2 = run * 1.4426950408889634f; const float ex = __builtin_amdgcn_exp2f(r2), exn = __builtin_amdgcn_exp2f(-r2);
                    const size_t m = mbase + t; const float q = bf2f(qr[u]), k = bf2f(kr[u]);
                    const unsigned qk = pk2(q * ex, k * exn); QT2[((size_t)dir * M + m) * 512 + d] = (bf16)(qk & 0xffffu); KT2[((size_t)dir * M + m) * 512 + d] = (bf16)(qk >> 16); } }
            GS2[((size_t)dir * 1024 + item) * 512 + d] = __expf(run);
        }
    }
}
HD s16x4 tr16(const LAS unsigned char* p) { return __builtin_amdgcn_ds_read_tr16_b64_v4i16((LAS s16x4*)p); }
HD bf16x8 cat8(s16x4 a, s16x4 b) { return (bf16x8){a[0], a[1], a[2], a[3], b[0], b[1], b[2], b[3]}; }
HD void gla_scan_mfma(const Frame& F, ArgsP a, int j) {
    constexpr int PQ = 272, PV = 288;
    constexpr int OFF_QT = 0, OFF_KT = OFF_QT + 64 * PQ, OFF_V = OFF_KT + 64 * PQ, OFF_ST = OFF_V + 64 * PV, OFF_GS = OFF_ST + 128 * PQ;
    static_assert(OFF_GS + 512 <= RING_BYTES, "gla lds");
    LAS unsigned char* const QT = F.lds + OFF_QT; LAS unsigned char* const KT = F.lds + OFF_KT; LAS unsigned char* const VL = F.lds + OFF_V; LAS unsigned char* const ST = F.lds + OFF_ST;
    LAS float* const GS = (LAS float*)(F.lds + OFF_GS);
    const bf16* QK = (const bf16*)(F.ws + WS_QKVG); const bf16* QT2 = (const bf16*)(F.ws + WS_QT2); const bf16* KT2 = (const bf16*)(F.ws + WS_KT2); const float* GS2 = (const float*)(F.ws + WS_GS2);
    const int tid = F.tid, lane = F.lane, w = F.wave, g = lane >> 4, l15 = lane & 15, tq = l15 >> 2, tp = l15 & 3;
    for (int item = blockIdx.x; item < 256; item += F.G) {
        const int dir = item & 1, sl = (item >> 1) & 1, h = (item >> 2) & 3, b = item >> 4;
        bf16* Og = (bf16*)(F.ws + (dir ? WS_OB : WS_OF));
        const bf16* Qd = QT2 + (size_t)dir * M * 512 + h * 128; const bf16* Kd = KT2 + (size_t)dir * M * 512 + h * 128; const float* Gd = GS2 + (size_t)dir * 1024 * 512 + h * 128;
        f32x4 Sacc[8];
#pragma unroll
        for (int et = 0; et < 8; ++et) Sacc[et] = (f32x4){0.f, 0.f, 0.f, 0.f};
        const int pt0 = tid >> 4, pch = tid & 15;
        v4u rq[2], rk[2], rv[2]; f32x4 rg = (f32x4){0.f, 0.f, 0.f, 0.f};
        {   const int c = dir ? 63 : 0; const size_t mb = (size_t)b * SEQ + c * 64;
#pragma unroll
            for (int i = 0; i < 2; ++i) { const size_t m = mb + pt0 + 32 * i; rq[i] = *(const v4u*)(Qd + m * 512 + 8 * pch); rk[i] = *(const v4u*)(Kd + m * 512 + 8 * pch); rv[i] = *(const v4u*)(QK + m * 3072 + 1024 + h * 256 + sl * 128 + 8 * pch); }
            if (tid < 32) rg = *(const f32x4*)(Gd + (size_t)(b * 64 + c) * 512 + 4 * tid); }
        for (int cc = 0; cc < 64; ++cc) {
            const int c = dir ? 63 - cc : cc; const size_t mbase = (size_t)b * SEQ + c * 64;
#pragma unroll
            for (int i = 0; i < 2; ++i) { const int t = pt0 + 32 * i; *(LAS v4u*)(QT + t * PQ + 16 * pch) = rq[i]; *(LAS v4u*)(KT + t * PQ + 16 * pch) = rk[i]; *(LAS v4u*)(VL + t * PV + 16 * pch) = rv[i]; }
            if (tid < 32) *(LAS f32x4*)(GS + 4 * tid) = rg;
#pragma unroll
            for (int et = 0; et < 8; ++et) { v2u pw; pw.x = pk2(Sacc[et][0], Sacc[et][1]); pw.y = pk2(Sacc[et][2], Sacc[et][3]); *(LAS v2u*)(ST + (16 * et + l15) * PQ + (16 * w + 4 * g) * 2) = pw; }
            __syncthreads();
            if (cc + 1 < 64) { const int cn = dir ? 62 - cc : cc + 1; const size_t mb = (size_t)b * SEQ + cn * 64;
#pragma unroll
                for (int i = 0; i < 2; ++i) { const size_t m = mb + pt0 + 32 * i; rq[i] = *(const v4u*)(Qd + m * 512 + 8 * pch); rk[i] = *(const v4u*)(Kd + m * 512 + 8 * pch); rv[i] = *(const v4u*)(QK + m * 3072 + 1024 + h * 256 + sl * 128 + 8 * pch); }
                if (tid < 32) rg = *(const f32x4*)(Gd + (size_t)(b * 64 + cn) * 512 + 4 * tid); }
            {   const int it = w & 3, eg = w >> 2;
                bf16x8 Bq[4], Kfr[16];
#pragma unroll
                for (int ks = 0; ks < 4; ++ks) Bq[ks] = *(const LAS bf16x8*)(QT + (16 * it + l15) * PQ + ks * 64 + g * 16);
#pragma unroll
                for (int jt = 0; jt < 4; ++jt)
#pragma unroll
                    for (int ks = 0; ks < 4; ++ks) Kfr[jt * 4 + ks] = *(const LAS bf16x8*)(KT + (16 * jt + l15) * PQ + ks * 64 + g * 16);
                __builtin_amdgcn_sched_barrier(0);
                s16x4 pk[4];
#pragma unroll
                for (int jt = 0; jt < 4; ++jt) { f32x4 acc = (f32x4){0.f, 0.f, 0.f, 0.f};
#pragma unroll
                    for (int ks = 0; ks < 4; ++ks) acc = __builtin_amdgcn_mfma_f32_16x16x32_bf16(Kfr[jt * 4 + ks], Bq[ks], acc, 0, 0, 0);
                    const int ii = 16 * it + l15;
#pragma unroll
                    for (int r = 0; r < 4; ++r) { const int jj = 16 * jt + 4 * g + r; const bool keep = dir ? (jj > ii) : (jj <= ii); acc[r] = keep ? acc[r] : 0.f; }
                    const unsigned p0 = pk2(acc[0], acc[1]), p1 = pk2(acc[2], acc[3]);
                    pk[jt] = (s16x4){(short)(p0 & 0xffff), (short)(p0 >> 16), (short)(p1 & 0xffff), (short)(p1 >> 16)}; }
                const bf16x8 Bp0 = cat8(pk[0], pk[1]), Bp1 = cat8(pk[2], pk[3]);
                bf16x8 Avf[4][2], Asf[4][4];
#pragma unroll
                for (int e4 = 0; e4 < 4; ++e4) { const int et = 4 * eg + e4;
                    Avf[e4][0] = cat8(tr16(VL + (0 + 4 * g + tq) * PV + (16 * et + 4 * tp) * 2), tr16(VL + (16 + 4 * g + tq) * PV + (16 * et + 4 * tp) * 2));
                    Avf[e4][1] = cat8(tr16(VL + (32 + 4 * g + tq) * PV + (16 * et + 4 * tp) * 2), tr16(VL + (48 + 4 * g + tq) * PV + (16 * et + 4 * tp) * 2));
#pragma unroll
                    for (int ks = 0; ks < 4; ++ks) Asf[e4][ks] = *(const LAS bf16x8*)(ST + (16 * et + l15) * PQ + ks * 64 + g * 16); }
                __builtin_amdgcn_sched_barrier(0);
#pragma unroll
                for (int e4 = 0; e4 < 4; ++e4) { const int et = 4 * eg + e4; f32x4 acc = (f32x4){0.f, 0.f, 0.f, 0.f};
                    acc = __builtin_amdgcn_mfma_f32_16x16x32_bf16(Avf[e4][0], Bp0, acc, 0, 0, 0);
                    acc = __builtin_amdgcn_mfma_f32_16x16x32_bf16(Avf[e4][1], Bp1, acc, 0, 0, 0);
#pragma unroll
                    for (int ks = 0; ks < 4; ++ks) acc = __builtin_amdgcn_mfma_f32_16x16x32_bf16(Asf[e4][ks], Bq[ks], acc, 0, 0, 0);
                    { v2u ow; ow.x = pk2(acc[0], acc[1]); ow.y = pk2(acc[2], acc[3]); *(v2u*)(Og + (mbase + 16 * it + l15) * 1024 + h * 256 + sl * 128 + 16 * et + 4 * g) = ow; } }
                bf16x8 Ak[2];
#pragma unroll
                for (int k2 = 0; k2 < 2; ++k2) Ak[k2] = cat8(tr16(KT + (32 * k2 + 8 * g + tq) * PQ + (16 * w + 4 * tp) * 2), tr16(KT + (32 * k2 + 8 * g + 4 + tq) * PQ + (16 * w + 4 * tp) * 2));
                const f32x4 gs = *(const LAS f32x4*)(GS + 16 * w + 4 * g);
                bf16x8 Bvf[8][2];
#pragma unroll
                for (int et = 0; et < 8; ++et)
#pragma unroll
                    for (int k2 = 0; k2 < 2; ++k2) Bvf[et][k2] = cat8(tr16(VL + (32 * k2 + 8 * g + tq) * PV + (16 * et + 4 * tp) * 2), tr16(VL + (32 * k2 + 8 * g + 4 + tq) * PV + (16 * et + 4 * tp) * 2));
                __builtin_amdgcn_sched_barrier(0);
#pragma unroll
                for (int et = 0; et < 8; ++et) {
#pragma unroll
                    for (int k2 = 0; k2 < 2; ++k2) Sacc[et] = __builtin_amdgcn_mfma_f32_16x16x32_bf16(Ak[k2], Bvf[et][k2], Sacc[et], 0, 0, 0);
                    Sacc[et] = Sacc[et] * gs; }
            }
            __syncthreads();
        }
    }
}
HD void unpack8(const v4u w, float (&f)[8]) { f[0] = bflo(w.x); f[1] = bfhi(w.x); f[2] = bflo(w.y); f[3] = bfhi(w.y); f[4] = bflo(w.z); f[5] = bfhi(w.z); f[6] = bflo(w.w); f[7] = bfhi(w.w); }
HD v4u pack8f(const float (&f)[8]) { v4u w; w.x = pk2(f[0], f[1]); w.y = pk2(f[2], f[3]); w.z = pk2(f[4], f[5]); w.w = pk2(f[6], f[7]); return w; }
HD void unpack8_fp8(const v2u w, float (&f)[8]) {
    f[0] = __builtin_amdgcn_cvt_f32_fp8((int)w.x, 0); f[1] = __builtin_amdgcn_cvt_f32_fp8((int)w.x, 1); f[2] = __builtin_amdgcn_cvt_f32_fp8((int)w.x, 2); f[3] = __builtin_amdgcn_cvt_f32_fp8((int)w.x, 3);
    f[4] = __builtin_amdgcn_cvt_f32_fp8((int)w.y, 0); f[5] = __builtin_amdgcn_cvt_f32_fp8((int)w.y, 1); f[6] = __builtin_amdgcn_cvt_f32_fp8((int)w.y, 2); f[7] = __builtin_amdgcn_cvt_f32_fp8((int)w.y, 3);
}
HD float half_sum(float v) {
    v = dpp_add<0xB1>(v); v = dpp_add<0x4E>(v); v = dpp_add<0x141>(v); v = dpp_add<0x140>(v);
    const int iv = __builtin_bit_cast(int, v);
    const float lo = __builtin_bit_cast(float, __builtin_amdgcn_readlane(iv, 0)) + __builtin_bit_cast(float, __builtin_amdgcn_readlane(iv, 16));
    const float hi = __builtin_bit_cast(float, __builtin_amdgcn_readlane(iv, 32)) + __builtin_bit_cast(float, __builtin_amdgcn_readlane(iv, 48));
    const unsigned lane = __builtin_amdgcn_mbcnt_hi(~0u, __builtin_amdgcn_mbcnt_lo(~0u, 0u));
    return (lane < 32u) ? lo : hi;
}
HD void gla_gate(const Frame& F, ArgsP a, int j, int m_first, int m_end, int m_step) {
    const bf16* OFp = (const bf16*)(F.ws + WS_OF); const bf16* OBp = (const bf16*)(F.ws + WS_OB); const bf16* QK = (const bf16*)(F.ws + WS_QKVG); bf16* AB = (bf16*)(F.ws + WS_AB);
    float ng[8];
    { const float* np = a->in[IN_GNG] + (size_t)j * 256 + 8 * (F.lane & 31); const f32x4 n0 = *(const f32x4*)np, n1 = *(const f32x4*)(np + 4); ng[0] = n0[0]; ng[1] = n0[1]; ng[2] = n0[2]; ng[3] = n0[3]; ng[4] = n1[0]; ng[5] = n1[1]; ng[6] = n1[2]; ng[7] = n1[3]; }
#pragma unroll 2
    for (int m = m_first; m < m_end; m += m_step) {
        v4u fw[2], bw[2], gw_[2];
#pragma unroll
        for (int c = 0; c < 2; ++c) { const size_t off = (size_t)m * 1024 + 512 * c + 8 * F.lane; fw[c] = *(const v4u*)(OFp + off); bw[c] = *(const v4u*)(OBp + off); gw_[c] = *(const v4u*)(QK + (size_t)m * 3072 + 2048 + 512 * c + 8 * F.lane); }
#pragma unroll
        for (int c = 0; c < 2; ++c) {
            float f[8], b[8], g[8], r[8]; unpack8(fw[c], f); unpack8(bw[c], b); unpack8(gw_[c], g);
            float ss = 0.f;
#pragma unroll
            for (int i = 0; i < 8; ++i) { f[i] += b[i]; ss += f[i] * f[i]; }
            const float rs = 1.f / sqrtf(half_sum(ss) * (1.f / 256.f) + 1e-6f);
#pragma unroll
            for (int i = 0; i < 8; ++i) { const float sg = g[i] * __builtin_amdgcn_rcpf(1.f + __expf(-g[i])); r[i] = (f[i] * rs * ng[i]) * sg; }
            *(v4u*)(AB + (size_t)m * 1024 + 512 * c + 8 * F.lane) = pack8f(r);
        }
    }
}

HD void na_attn_naive(const Frame& F, ArgsP a) {
    const bf16* QH = (const bf16*)(F.ws + WS_QH); const bf16* KH = (const bf16*)(F.ws + WS_KH); const bf16* VH = (const bf16*)(F.ws + WS_VH); bf16* AB = (bf16*)(F.ws + WS_AB);
    const float* rpb = a->in[IN_NRPB];
    for (int item = F.gw; item < NB * 32 * 64; item += F.NGW) {
        const int r = item & 63, h = (item >> 6) & 31, b = item >> 11, c = F.lane;
        const size_t hb = (size_t)(b * 32 + h) * 4096;
        float q[32];
        { const v4u* qp = (const v4u*)(QH + (hb + r * 64 + c) * 32);
#pragma unroll
          for (int i = 0; i < 4; ++i) { const v4u w = qp[i]; q[8 * i] = bflo(w.x); q[8 * i + 1] = bfhi(w.x); q[8 * i + 2] = bflo(w.y); q[8 * i + 3] = bfhi(w.y); q[8 * i + 4] = bflo(w.z); q[8 * i + 5] = bfhi(w.z); q[8 * i + 6] = bflo(w.w); q[8 * i + 7] = bfhi(w.w); } }
        const int rs = min(max(r - 4, 0), 56), cs = min(max(c - 8, 0), 48);
        float mx = -3.0e38f, sum = 0.f, o[32];
#pragma unroll
        for (int i = 0; i < 32; ++i) o[i] = 0.f;
        for (int kr = 0; kr < 8; ++kr)
            for (int kc = 0; kc < 16; ++kc) {
                const int krow = rs + kr, kcol = cs + kc; const size_t kt = hb + krow * 64 + kcol;
                const v4u* kp = (const v4u*)(KH + kt * 32); float s = 0.f;
#pragma unroll
                for (int i = 0; i < 4; ++i) { const v4u w = kp[i];
                    s += q[8 * i] * bflo(w.x) + q[8 * i + 1] * bfhi(w.x) + q[8 * i + 2] * bflo(w.y) + q[8 * i + 3] * bfhi(w.y) + q[8 * i + 4] * bflo(w.z) + q[8 * i + 5] * bfhi(w.z) + q[8 * i + 6] * bflo(w.w) + q[8 * i + 7] * bfhi(w.w); }
                s += rpb[(h * 15 + (krow - r + 7)) * 31 + (kcol - c + 15)];
                const float mn = fmaxf(mx, s), sc = __expf(mx - mn), p = __expf(s - mn); mx = mn; sum = sum * sc + p;
                const v4u* vp = (const v4u*)(VH + kt * 32);
#pragma unroll
                for (int i = 0; i < 4; ++i) { const v4u w = vp[i];
                    o[8 * i] = o[8 * i] * sc + p * bflo(w.x); o[8 * i + 1] = o[8 * i + 1] * sc + p * bfhi(w.x); o[8 * i + 2] = o[8 * i + 2] * sc + p * bflo(w.y); o[8 * i + 3] = o[8 * i + 3] * sc + p * bfhi(w.y);
                    o[8 * i + 4] = o[8 * i + 4] * sc + p * bflo(w.z); o[8 * i + 5] = o[8 * i + 5] * sc + p * bfhi(w.z); o[8 * i + 6] = o[8 * i + 6] * sc + p * bflo(w.w); o[8 * i + 7] = o[8 * i + 7] * sc + p * bfhi(w.w); }
            }
        const float inv = 1.f / sum;
        v4u* op = (v4u*)(AB + ((size_t)b * 4096 + r * 64 + c) * 1024 + h * 32);
#pragma unroll
        for (int i = 0; i < 4; ++i) { v4u w; w.x = pk2(o[8 * i] * inv, o[8 * i + 1] * inv); w.y = pk2(o[8 * i + 2] * inv, o[8 * i + 3] * inv); w.z = pk2(o[8 * i + 4] * inv, o[8 * i + 5] * inv); w.w = pk2(o[8 * i + 6] * inv, o[8 * i + 7] * inv); op[i] = w; }
    }
}

HD void na_attn_mfma(const Frame& F, ArgsP a) {
    constexpr int OFF_RPB = 15 * 64 * 64;
    static_assert(OFF_RPB + 2048 <= RING_BYTES, "na lds");
    LAS unsigned char* const VL = F.lds; LAS float* const RP = (LAS float*)(F.lds + OFF_RPB);
    const bf16* QH = (const bf16*)(F.ws + WS_QH); const bf16* KH = (const bf16*)(F.ws + WS_KH); const bf16* VH = (const bf16*)(F.ws + WS_VH); bf16* AB = (bf16*)(F.ws + WS_AB);
    const float* rpb = a->in[IN_NRPB];
    const int tid = F.tid, lane = F.lane, w = F.wave, g = lane >> 4, l15 = lane & 15, tq = l15 >> 2, tp = l15 & 3;
    bf16x8 Kf[16], Bqn;
    auto ldk = [&](int item_, int cb_) {
        const int rg_ = item_ & 7, h_ = (item_ >> 3) & 31, b_ = item_ >> 8; const size_t hb_ = (size_t)(b_ * 32 + h_) * 4096;
        const int r_ = 8 * rg_ + w, rs_ = min(max(r_ - 4, 0), 56), bs_ = min(max(16 * cb_ - 8, 0), 32), qc_ = 16 * cb_ + l15;
        Bqn = *(const bf16x8*)(QH + (hb_ + r_ * 64 + qc_) * 32 + 8 * g);
#pragma unroll
        for (int t = 0; t < 16; ++t) { const int kr = t >> 1, kc0 = bs_ + 16 * (t & 1); Kf[t] = *(const bf16x8*)(KH + (hb_ + (rs_ + kr) * 64 + kc0 + l15) * 32 + 8 * g); }
    };
    { const int it0 = (blockIdx.x < NB * 32 * 8) ? (int)blockIdx.x : 0; ldk(it0, 0); }
    v2u pend[2]; pend[0] = (v2u){0u, 0u}; pend[1] = pend[0]; size_t pidx = 0; bool hasp = false;
    auto flush = [&]() {
#pragma unroll
        for (int dt = 0; dt < 2; ++dt) {
            if (FP8_NAOUT) *(unsigned*)((unsigned char*)AB + pidx + 16 * dt) = pend[dt].x;
            else *(v2u*)(AB + pidx + 16 * dt) = pend[dt]; }
    };
    for (int item = blockIdx.x; item < NB * 32 * 8; item += F.G) {
        const int rg = item & 7, h = (item >> 3) & 31, b = item >> 8, r0 = 8 * rg;
        const size_t hb = (size_t)(b * 32 + h) * 4096;
        const int klo = min(max(r0 - 4, 0), 56), khi = min(max(r0 + 3, 0), 56) + 7, nrows = khi - klo + 1;
        __syncthreads();
        { const v4u* src = (const v4u*)(VH + (hb + (size_t)klo * 64) * 32); const int npc = nrows * 256;
          v4u vv[8];
#pragma unroll
          for (int i = 0; i < 8; ++i) { const int p = tid + NT * i; vv[i] = src[p < npc ? p : npc - 1]; }
          const float rpv = rpb[h * 465 + (tid < 465 ? tid : 464)];
          __builtin_amdgcn_sched_barrier(0);
#pragma unroll
          for (int i = 0; i < 8; ++i) { const int p = tid + NT * i; if (p < npc) *(LAS v4u*)(VL + p * 16) = vv[i]; }
          if (tid < 465) RP[tid] = rpv; }
        __syncthreads();
        const int r = r0 + w, rs = min(max(r - 4, 0), 56);
#pragma unroll 1
        for (int cb = 0; cb < 4; ++cb) {
            const int bs = min(max(16 * cb - 8, 0), 32), qc = 16 * cb + l15, cs = min(max(qc - 8, 0), 48);
            f32x4 sc[16];
#pragma unroll
            for (int t = 0; t < 16; ++t) sc[t] = __builtin_amdgcn_mfma_f32_16x16x32_bf16(Kf[t], Bqn, (f32x4){0.f, 0.f, 0.f, 0.f}, 0, 0, 0);
            { int ni = item, nc = cb + 1; if (nc == 4) { nc = 0; ni = (item + F.G < NB * 32 * 8) ? item + F.G : item; } ldk(ni, nc); }
            if (hasp) flush();
            bool sel0[4]; int dix[4];
#pragma unroll
            for (int rr = 0; rr < 4; ++rr) { const int kcol0 = bs + 4 * g + rr; sel0[rr] = kcol0 >= cs; dix[rr] = (sel0[rr] ? kcol0 : kcol0 + 16) - qc + 15; }
            float pv[8][4]; float mx = -3.0e38f;
#pragma unroll
            for (int kr = 0; kr < 8; ++kr) { const LAS float* rp = RP + (rs + kr - r + 7) * 31;
#pragma unroll
                for (int rr = 0; rr < 4; ++rr) { const float v = (sel0[rr] ? sc[2 * kr][rr] : sc[2 * kr + 1][rr]) + rp[dix[rr]]; pv[kr][rr] = v; mx = fmaxf(mx, v); } }
            mx = fmaxf(mx, __shfl_xor(mx, 16)); mx = fmaxf(mx, __shfl_xor(mx, 32));
            float sum = 0.f;
#pragma unroll
            for (int kr = 0; kr < 8; ++kr)
#pragma unroll
                for (int rr = 0; rr < 4; ++rr) { const float p = __expf(pv[kr][rr] - mx); pv[kr][rr] = p; sum += p; }
            sum += __shfl_xor(sum, 16); sum += __shfl_xor(sum, 32);
            const float inv = 1.f / sum;
            bf16x8 Bp[8];
#pragma unroll
            for (int kr = 0; kr < 8; ++kr) { unsigned q[4];
#pragma unroll
                for (int rr = 0; rr < 4; rr += 2) { const unsigned w2_ = pk2(pv[kr][rr], pv[kr][rr + 1]); q[rr] = w2_ & 0xffffu; q[rr + 1] = w2_ >> 16; }
                unsigned short e0[4], e1[4];
#pragma unroll
                for (int rr = 0; rr < 4; ++rr) { e0[rr] = (unsigned short)(sel0[rr] ? q[rr] : 0u); e1[rr] = (unsigned short)(sel0[rr] ? 0u : q[rr]); }
                Bp[kr] = (bf16x8){(short)e0[0], (short)e0[1], (short)e0[2], (short)e0[3], (short)e1[0], (short)e1[1], (short)e1[2], (short)e1[3]}; }
#pragma unroll
            for (int dt = 0; dt < 2; ++dt) { f32x4 acc = (f32x4){0.f, 0.f, 0.f, 0.f};
#pragma unroll
                for (int kr = 0; kr < 8; ++kr) { const int rowb = (rs + kr - klo) * 64 + bs + 4 * g + tq;
                    const bf16x8 A = cat8(tr16(VL + rowb * 64 + (16 * dt + 4 * tp) * 2), tr16(VL + (rowb + 16) * 64 + (16 * dt + 4 * tp) * 2));
                    acc = __builtin_amdgcn_mfma_f32_16x16x32_bf16(A, Bp[kr], acc, 0, 0, 0); }
                if (FP8_NAOUT) { const float i16 = inv * 16.f; pend[dt].x = pk4_fp8(acc[0] * i16, acc[1] * i16, acc[2] * i16, acc[3] * i16); }
                else { pend[dt].x = pk2(acc[0] * inv, acc[1] * inv); pend[dt].y = pk2(acc[2] * inv, acc[3] * inv); } }
            pidx = ((size_t)b * 4096 + r * 64 + qc) * 1024 + h * 32 + 4 * g; hasp = true;
        }
    }
    if (hasp) flush();
}

HD void ln1_phase(const Frame& F, const float* xin, const bf16* xinb, const float* g, const float* bta, bf16* xob, unsigned char* xo8, int m_first, int m_end, int m_step) {
    const bf16* HP = (const bf16*)(F.ws + WS_HPRE);
    float gv[16], bv[16];
#pragma unroll
    for (int c = 0; c < 2; ++c)
#pragma unroll
        for (int q = 0; q < 2; ++q) { const f32x4 a4 = *(const f32x4*)(g + 512 * c + 8 * F.lane + 4 * q), b4 = *(const f32x4*)(bta + 512 * c + 8 * F.lane + 4 * q);
#pragma unroll
            for (int i = 0; i < 4; ++i) { gv[8 * c + 4 * q + i] = a4[i]; bv[8 * c + 4 * q + i] = b4[i]; } }
#pragma unroll 2
    for (int m = m_first; m < m_end; m += m_step) {
        float v[16]; float s = 0.f;
#pragma unroll
        for (int c = 0; c < 2; ++c) { const size_t off = (size_t)m * D + 512 * c + 8 * F.lane; float x[8], h[8];
            if (xin) { const f32x4 x0 = *(const f32x4*)(xin + off), x1 = *(const f32x4*)(xin + off + 4); x[0] = x0[0]; x[1] = x0[1]; x[2] = x0[2]; x[3] = x0[3]; x[4] = x1[0]; x[5] = x1[1]; x[6] = x1[2]; x[7] = x1[3]; }
            else unpack8(*(const v4u*)(xinb + off), x);
            unpack8(*(const v4u*)(HP + off), h);
#pragma unroll
            for (int i = 0; i < 8; ++i) { v[8 * c + i] = x[i] * DN_ALPHA + h[i]; s += v[8 * c + i]; } }
        const float mean = wave_sum(s) * (1.f / D); float s2 = 0.f;
#pragma unroll
        for (int i = 0; i < 16; ++i) { v[i] -= mean; s2 += v[i] * v[i]; }
        const float rstd = 1.f / sqrtf(wave_sum(s2) * (1.f / D) + LN_EPS);
#pragma unroll
        for (int c = 0; c < 2; ++c) { const size_t off = (size_t)m * D + 512 * c + 8 * F.lane; float y[8];
#pragma unroll
            for (int i = 0; i < 8; ++i) y[i] = v[8 * c + i] * rstd * gv[8 * c + i] + bv[8 * c + i];
            *(v4u*)(xob + off) = pack8f(y);
            v2u w8; w8.x = pk4_fp8(y[0] * 16.f, y[1] * 16.f, y[2] * 16.f, y[3] * 16.f); w8.y = pk4_fp8(y[4] * 16.f, y[5] * 16.f, y[6] * 16.f, y[7] * 16.f);
            *(v2u*)(xo8 + off) = w8; }
    }
}
HD void topk_rows(const Frame& F, const float* rb, int layer, int row0) {
    LAS int* hist = (LAS int*)F.lds; LAS int* base = hist + 32;
    const float* LG = (const float*)(F.ws + WS_LOGIT); int* tokl = (int*)(F.ws + WS_TOKL); int* sel = (int*)(F.ws + WS_SEL); float* gate = (float*)(F.ws + WS_GATE);
    unsigned* gcnt = F.ctl + CW_CNT + layer * 32;
    {
        __syncthreads();
        if (F.tid < 32) hist[F.tid] = 0;
        __syncthreads();
        const bool act = F.tid < 256; const int m = row0 + (act ? F.tid : 0);
        float lg[32];
        __builtin_amdgcn_fence(__ATOMIC_ACQUIRE, "agent");
        { f32x4 l4[8];
#pragma unroll
          for (int q4 = 0; q4 < 8; ++q4) l4[q4] = *(const f32x4*)(LG + (size_t)m * 32 + 4 * q4);
#pragma unroll
          for (int q4 = 0; q4 < 8; ++q4)
#pragma unroll
              for (int i = 0; i < 4; ++i) lg[4 * q4 + i] = l4[q4][i] + rb[4 * q4 + i]; }
        int ti[4]; float tv[4];
#pragma unroll
        for (int k = 0; k < 4; ++k) { float best = -3.0e38f; int bi = 0;
#pragma unroll
            for (int e = 0; e < 32; ++e) { const bool take = lg[e] > best; best = take ? lg[e] : best; bi = take ? e : bi; }
            ti[k] = bi; tv[k] = best;
#pragma unroll
            for (int e = 0; e < 32; ++e) lg[e] = (e == bi) ? -3.0e38f : lg[e]; }
        float ex[4], es = 0.f;
#pragma unroll
        for (int k = 0; k < 4; ++k) { ex[k] = expf(tv[k] - tv[0]); es += ex[k]; }
        int rk[4];
#pragma unroll
        for (int k = 0; k < 4; ++k) rk[k] = act ? __hip_atomic_fetch_add(&hist[ti[k]], 1, __ATOMIC_RELAXED, __HIP_MEMORY_SCOPE_WORKGROUP) : 0;
        __syncthreads();
        if (F.tid < 32) base[F.tid] = (int)atomicAdd(&gcnt[F.tid], (unsigned)hist[F.tid]);
        __syncthreads();
        if (act)
#pragma unroll
        for (int k = 0; k < 4; ++k) { const int slot = base[ti[k]] + rk[k]; tokl[(size_t)ti[k] * 65536 + slot] = m; sel[((size_t)m * 4 + k) * 2] = ti[k]; sel[((size_t)m * 4 + k) * 2 + 1] = slot; gate[(size_t)m * 4 + k] = ex[k] / es; }
    }
}
HD int moe_tables(const Frame& F, int layer) {
    LAS int* ecnt = (LAS int*)(F.lds + LDS_ECNT); LAS int* tbase = (LAS int*)(F.lds + LDS_TBASE); LAS unsigned short* texp = (LAS unsigned short*)(F.lds + LDS_TEXP);
    __syncthreads();
    if (F.tid < 32) ecnt[F.tid] = (int)__hip_atomic_load(F.ctl + CW_CNT + layer * 32 + F.tid, __ATOMIC_RELAXED, __HIP_MEMORY_SCOPE_AGENT);
    __syncthreads();
    if (F.tid == 0) { int acc = 0; for (int e = 0; e < 32; ++e) { tbase[e] = acc; acc += (ecnt[e] + 255) >> 8; } tbase[32] = acc; }
    __syncthreads();
    if (F.tid < 32) { const int t0 = tbase[F.tid], t1 = tbase[F.tid + 1]; for (int t = t0; t < t1 && t < MAXTILES; ++t) texp[t] = (unsigned short)F.tid; }
    __syncthreads();
    const int T = tbase[32]; return T < MAXTILES ? T : MAXTILES;
}
HD void moe_scatter(const Frame& F) {
    const LAS int* tbase = (const LAS int*)(F.lds + LDS_TBASE);
    const unsigned char* X8 = F.ws + WS_X8; unsigned char* XS = F.ws + WS_XS; const int* sel = (const int*)(F.ws + WS_SEL);
    for (int m = F.gw; m < M; m += F.NGW) {
        const v4u row = *((const v4u*)(X8 + (size_t)m * 1024) + F.lane);
        const i32x4 s0 = *(const i32x4*)(sel + (size_t)m * 8), s1 = *(const i32x4*)(sel + (size_t)m * 8 + 4);
        *((v4u*)(XS + ((size_t)tbase[s0[0]] * 256 + s0[1]) * 1024) + F.lane) = row;
        *((v4u*)(XS + ((size_t)tbase[s0[2]] * 256 + s0[3]) * 1024) + F.lane) = row;
        *((v4u*)(XS + ((size_t)tbase[s1[0]] * 256 + s1[1]) * 1024) + F.lane) = row;
        *((v4u*)(XS + ((size_t)tbase[s1[2]] * 256 + s1[3]) * 1024) + F.lane) = row;
    }
}
HD void ln2_phase(const Frame& F, const bf16* xinb, const float* g, const float* bta, float* xo, bf16* xob, unsigned char* xo8) {
    const LAS int* tbase = (const LAS int*)(F.lds + LDS_TBASE);
    const bf16* Y = (const bf16*)(F.ws + WS_YBUF); const int* sel = (const int*)(F.ws + WS_SEL); const float* gate = (const float*)(F.ws + WS_GATE);
    float gv[16], bv[16];
#pragma unroll
    for (int c = 0; c < 2; ++c)
#pragma unroll
        for (int q = 0; q < 2; ++q) { const f32x4 a4 = *(const f32x4*)(g + 512 * c + 8 * F.lane + 4 * q), b4 = *(const f32x4*)(bta + 512 * c + 8 * F.lane + 4 * q);
#pragma unroll
            for (int i = 0; i < 4; ++i) { gv[8 * c + 4 * q + i] = a4[i]; bv[8 * c + 4 * q + i] = b4[i]; } }
    for (int m = F.gw; m < M; m += F.NGW) {
        const i32x4 s0 = *(const i32x4*)(sel + (size_t)m * 8), s1 = *(const i32x4*)(sel + (size_t)m * 8 + 4); const f32x4 gt = *(const f32x4*)(gate + (size_t)m * 4);
        size_t rows[4]; rows[0] = (size_t)tbase[s0[0]] * 256 + s0[1]; rows[1] = (size_t)tbase[s0[2]] * 256 + s0[3]; rows[2] = (size_t)tbase[s1[0]] * 256 + s1[1]; rows[3] = (size_t)tbase[s1[2]] * 256 + s1[3];
        v4u xw[2]; v2u yw[4][2];
#pragma unroll
        for (int c = 0; c < 2; ++c) { xw[c] = *(const v4u*)(xinb + (size_t)m * D + 512 * c + 8 * F.lane);
#pragma unroll
            for (int k = 0; k < 4; ++k) yw[k][c] = *(const v2u*)((const unsigned char*)Y + rows[k] * 1024 + 512 * c + 8 * F.lane); }
        float v[16]; float s = 0.f;
#pragma unroll
        for (int c = 0; c < 2; ++c) { float x[8]; unpack8(xw[c], x);
#pragma unroll
            for (int i = 0; i < 8; ++i) v[8 * c + i] = x[i] * DN_ALPHA;
#pragma unroll
            for (int k = 0; k < 4; ++k) { float y[8]; unpack8_fp8(yw[k][c], y); const float gk = gt[k] * 0.03125f;
#pragma unroll
                for (int i = 0; i < 8; ++i) v[8 * c + i] += y[i] * gk; }
#pragma unroll
            for (int i = 0; i < 8; ++i) s += v[8 * c + i]; }
        const float mean = wave_sum(s) * (1.f / D); float s2 = 0.f;
#pragma unroll
        for (int i = 0; i < 16; ++i) { v[i] -= mean; s2 += v[i] * v[i]; }
        const float rstd = 1.f / sqrtf(wave_sum(s2) * (1.f / D) + LN_EPS);
#pragma unroll
        for (int c = 0; c < 2; ++c) { const size_t off = (size_t)m * D + 512 * c + 8 * F.lane; float y[8];
#pragma unroll
            for (int i = 0; i < 8; ++i) y[i] = v[8 * c + i] * rstd * gv[8 * c + i] + bv[8 * c + i];
            if (xo) { *(f32x4*)(xo + off) = (f32x4){y[0], y[1], y[2], y[3]}; *(f32x4*)(xo + off + 4) = (f32x4){y[4], y[5], y[6], y[7]}; }
            else { *(v4u*)(xob + off) = pack8f(y);
                if (xo8) { v2u w8; w8.x = pk4_fp8(y[0] * 16.f, y[1] * 16.f, y[2] * 16.f, y[3] * 16.f); w8.y = pk4_fp8(y[4] * 16.f, y[5] * 16.f, y[6] * 16.f, y[7] * 16.f); *(v2u*)(xo8 + off) = w8; } } }
    }
}

__global__ void __launch_bounds__(NT, 2) enc_fwd(Args args_by_value) {
    extern __shared__ __attribute__((aligned(16))) unsigned char lds_raw[];
    LAS unsigned char* const lds = (LAS unsigned char*)lds_raw;
    { const int t0 = threadIdx.x; for (int u = t0; u < 64; u += NT) ((LAS unsigned*)(lds + LDS_MISC))[u] = 0u;
      if ((t0 & 63) == 0) ((LAS int*)(lds + LDS_WTAB))[hw_slot()] = t0 >> 6; }
    __syncthreads();
    int lo, hi; { ArgsP ap = argp(); lo = ap->ph_lo; hi = ap->ph_hi; }
    const bool multi = (hi - lo) > 1;
    if (multi) (void)xcd_barrier_post((unsigned*)(argp()->ws + WS_CTL) + CW_BAR, (volatile LAS unsigned*)(lds + LDS_MISC) + 8);
#define IN(k) (lo <= (k) && (k) < hi)
#define SEAM(k) do { if (multi && (k) + 1 < hi) { XcdBarrier bar_; bar_.bar = (unsigned*)(argp()->ws + WS_CTL) + CW_BAR; bar_.x = xb_xcc_id(); bar_.st = (volatile LAS unsigned*)(lds + LDS_MISC) + 8; xcd_barrier(bar_); } } while (0)
#define FRAME() ArgsP ap = argp(); const Frame F = mkframe(ap, lds); unsigned char* const ws = F.ws; (void)ws

    if (IN(0)) { { FRAME(); if (PEN(0)) REP(0) p0_prologue(F, ap); } { FRAME(); if (PEN(17)) REP(17) p0_hyena_filters(F, ap); } SEAM(0); }

    for (int layer = 0; layer < DEPTH; ++layer) {
        const int pb = 1 + 16 * layer, mixer = layer % 3, jj = layer / 3;
        if (mixer == 0) {
            if (IN(pb + 0)) {
                if (PEN(1)) REP(1) { FRAME();
                    constexpr int RB = FP8_GLA ? 1024 : 2048;
                    g8::DenseSched S{(const bf16*)(ws + (FP8_GLA ? WS_X8 : WS_XAB)), (const bf16*)(ws + WS_WGIN + (size_t)jj * GLA_NPAD * RB), M / 256, GLA_NPAD / 256, F.G, (int)blockIdx.x, RB};
                    g8::EpiGlaIn E{(bf16*)(ws + WS_QKVG), (float*)(ws + WS_GLOW), 0.08838834764831845f, FP8_GLA ? 4.8828125e-4f : 1.f};
                    g8::gemm_phase<g8::EpiGlaIn, g8::DenseSched, false, FP8_GLA != 0>(F.lds, S, E); }
                if (PEN(16) && layer == 0) REP(16) { FRAME(); hyena_filter_fft(F); }
                SEAM(pb + 0);
            }
            if (IN(pb + 1)) { if (PEN(19)) REP(19) { FRAME(); gla_prep(F, ap, jj); } if (multi) SEAM(-1000);
                if (PEN(2)) REP(2) { FRAME(); if (GLA_NAIVE) gla_scan_naive(F, ap, jj); else gla_scan_mfma(F, ap, jj); } SEAM(pb + 1); }
        } else if (mixer == 1) {
            if (IN(pb + 0)) { if (PEN(4)) REP(4) { FRAME();
                constexpr int RB = FP8_HY ? 1024 : 2048;
                g8::DenseSched S{(const bf16*)(ws + WS_WHIN), (const bf16*)(ws + (FP8_HY ? WS_X8 : WS_XAB)), 3072 / 256, M / 256, F.G, (int)blockIdx.x, RB};
                g8::EpiHyIn E{(bf16*)(ws + WS_PT), ap->in[IN_HBIN], FP8_HY ? 4.8828125e-4f : 1.f};
                g8::gemm_phase<g8::EpiHyIn, g8::DenseSched, false, FP8_HY != 0>(F.lds, S, E); }
                SEAM(pb + 0);
            }
            if (IN(pb + 1)) { if (PEN(5)) REP(5) { FRAME(); hyena_core(F, ap); } SEAM(pb + 1); }
        } else {
            if (IN(pb + 0)) { if (PEN(7)) REP(7) { FRAME();
                constexpr int RB = FP8_NA ? 1024 : 2048;
                g8::DenseSched S{(const bf16*)(ws + (FP8_NA ? WS_X8 : WS_XAB)), (const bf16*)(ws + WS_WNIN), M / 256, 3072 / 256, F.G, (int)blockIdx.x, RB};
                g8::EpiNaIn E{(bf16*)(ws + WS_QH), (size_t)(WS_KH - WS_QH) / 2, ap->in[IN_NBIN], 0.17677669529663687f, FP8_NA ? 4.8828125e-4f : 1.f};
                g8::gemm_phase<g8::EpiNaIn, g8::DenseSched, false, FP8_NA != 0>(F.lds, S, E); }
                SEAM(pb + 0);
            }
            if (IN(pb + 1)) { if (PEN(8)) REP(8) { FRAME(); if (NA_NAIVE) na_attn_naive(F, ap); else na_attn_mfma(F, ap); } SEAM(pb + 1); }
        }
        if (IN(pb + 3)) { if (PEN(9)) REP(9) {
            for (int pm = blockIdx.x; pm < M / 256; pm += 256) {
                const int r0 = pm * 256;
                if (mixer == 0) { FRAME(); gla_gate(F, ap, jj, r0 + F.wave, r0 + 256, NWAVES); }
                else if (mixer == 1) { FRAME(); hyena_transpose(F, 64 * pm + F.wave, 64 * pm + 64, NWAVES); }
                VM_WAIT(); __syncthreads();
                { FRAME();
                  const bf16* wout = (mixer == 0) ? (const bf16*)(ws + WS_WGOUT) + (size_t)jj * 1024 * 1024 : (mixer == 1) ? (const bf16*)(ws + WS_WHOUT) : (const bf16*)(ws + WS_WNOUT);
                  const float* bout = (mixer == 0) ? nullptr : (mixer == 1) ? ap->in[IN_HBOUT] : ap->in[IN_NBOUT];
                  if (FP8_NAOUT && mixer == 2) {
                      g8::PanelSched S{(const bf16*)(ws + WS_AB), wout, pm, 4, 1024};
                      g8::EpiBf16 E{(bf16*)(ws + WS_HPRE), 1024, bout, 4, 2.44140625e-4f};
                      g8::gemm_phase<g8::EpiBf16, g8::PanelSched, false, true>(F.lds, S, E);
                  } else {
                  g8::PanelSched S{(const bf16*)(ws + WS_AB), wout, pm, 4};
                  g8::EpiBf16 E{(bf16*)(ws + WS_HPRE), 1024, bout, 0, 1.f};
                  g8::gemm_phase<g8::EpiBf16, g8::PanelSched, false>(F.lds, S, E); } }
                VM_WAIT(); __syncthreads();
                { FRAME();
                  const float* xin = (layer == 0) ? ap->in[IN_X] : nullptr;
                  ln1_phase(F, xin, (const bf16*)(ws + WS_XAB), ap->in[IN_LN1G] + layer * D, ap->in[IN_LN1B] + layer * D, (bf16*)(ws + WS_XBB), ws + WS_X8, r0 + F.wave, r0 + 256, NWAVES); }
                VM_WAIT(); __syncthreads();
                { FRAME();
                  g8::PanelSched S{(const bf16*)(ws + WS_XBB), (const bf16*)(ws + WS_WR) + (size_t)layer * 256 * 1024, pm, 1};
                  g8::EpiF32Cols32 E{(float*)(ws + WS_LOGIT)};
                  g8::gemm_phase<g8::EpiF32Cols32, g8::PanelSched, false>(F.lds, S, E);
                  VM_WAIT(); __syncthreads();
                  topk_rows(F, ap->in[IN_RB] + layer * 32, layer, r0); }
                __syncthreads();
            } }
            SEAM(pb + 3);
        }
        if (IN(pb + 8)) { if (PEN(13)) REP(13) { FRAME();
            const int T = moe_tables(F, layer);
            g8::MoeSched S{(const bf16*)(ws + WS_X8), (const bf16*)(ws + WS_WGU + (size_t)layer * 32 * 2048 * 1024), (size_t)2048 * 1024, (const int*)(ws + WS_TOKL),
                           (const LAS int*)(F.lds + LDS_ECNT), (const LAS int*)(F.lds + LDS_TBASE), (const LAS unsigned short*)(F.lds + LDS_TEXP), T, 8, F.G, (int)blockIdx.x, true, 1024};
            g8::EpiMoe1 E{(bf16*)(ws + WS_HBUF), ap->in[IN_BGU] + (size_t)layer * 32 * 2048};
            g8::gemm_phase<g8::EpiMoe1, g8::MoeSched, true, true>(F.lds, S, E); }
            SEAM(pb + 8);
        }
        if (IN(pb + 9)) { if (PEN(14)) REP(14) { FRAME();
            const int T = moe_tables(F, layer);
            g8::MoeSched S{(const bf16*)(ws + WS_HBUF), (const bf16*)(ws + WS_WDN + (size_t)layer * 32 * 1024 * 1024), (size_t)1024 * 1024, (const int*)(ws + WS_TOKL),
                           (const LAS int*)(F.lds + LDS_ECNT), (const LAS int*)(F.lds + LDS_TBASE), (const LAS unsigned short*)(F.lds + LDS_TEXP), T, 4, F.G, (int)blockIdx.x, false, 1024};
            g8::EpiMoe2 E{(bf16*)(ws + WS_YBUF), ap->in[IN_BDN] + (size_t)layer * 32 * 1024};
            g8::gemm_phase<g8::EpiMoe2, g8::MoeSched, false, true>(F.lds, S, E); }
            SEAM(pb + 9);
        }
        if (IN(pb + 10)) { const bool lastl = (layer == DEPTH - 1);
            if (PEN(15)) REP(15) { FRAME();
            (void)moe_tables(F, layer);
            ln2_phase(F, (const bf16*)(ws + WS_XBB), ap->in[IN_LN2G] + layer * D, ap->in[IN_LN2B] + layer * D, lastl ? ap->out : nullptr, lastl ? nullptr : (bf16*)(ws + WS_XAB), (((layer + 1) % 3 == 0) ? FP8_GLA : ((layer + 1) % 3 == 1) ? FP8_HY : FP8_NA) ? ws + WS_X8 : nullptr); }
            if (!lastl) SEAM(pb + 10);
        }
    }
#undef IN
#undef SEAM
#undef FRAME
}

extern "C" void kernel_launch(void* const* d_in, const int* in_sizes, int n_in, void* d_out, int out_size, void* d_ws, size_t ws_size, hipStream_t stream) {
    static int grid = 0;
    if (grid == 0) {
        if (n_in != 34 || out_size != M * D || ws_size < WS_NEED) { fprintf(stderr, "kernel_launch: unexpected shapes (n_in %d out %d ws %zu need %zu)\n", n_in, out_size, ws_size, (size_t)WS_NEED); grid = -1; return; }
        int dev = 0, cus = 0, per_cu = 0;
        if (hipGetDevice(&dev) != hipSuccess || hipDeviceGetAttribute(&cus, hipDeviceAttributeMultiprocessorCount, dev) != hipSuccess) { grid = -1; return; }
        if (hipFuncSetAttribute((const void*)enc_fwd, hipFuncAttributeMaxDynamicSharedMemorySize, LDS_BYTES) != hipSuccess) { fprintf(stderr, "kernel_launch: hipFuncSetAttribute failed\n"); grid = -1; return; }
        if (hipOccupancyMaxActiveBlocksPerMultiprocessor(&per_cu, (const void*)enc_fwd, NT, LDS_BYTES) != hipSuccess || per_cu < 1) fprintf(stderr, "kernel_launch: occupancy query reports %d\n", per_cu);
        (void)hipGetLastError();
        grid = 256;
        if (cus < 256) fprintf(stderr, "kernel_launch: %d CUs < 256: the persistent grid is not resident\n", cus);
    }
    if (grid < 0) return;
    (void)hipMemsetAsync((char*)d_ws + WS_CTL, 0, CTL_ZERO_BYTES, stream);
    Args a{};
    for (int i = 0; i < 34; ++i) a.in[i] = (const float*)d_in[i];
    a.out = (float*)d_out; a.ws = (unsigned char*)d_ws;
#if MK_ONE_LAUNCH
    a.ph_lo = 0; a.ph_hi = 1000;
    hipLaunchKernelGGL(enc_fwd, dim3(grid), dim3(NT), LDS_BYTES, stream, a);
#else
    int phases[64]; int np = 0;
    phases[np++] = 0;
    for (int l = 0; l < DEPTH; ++l) { const int pb = 1 + 16 * l, mixer = l % 3; for (int k = 0; k < 11; ++k) { if (k == 2 || k == 4 || k == 5 || k == 6 || k == 7) continue; phases[np++] = pb + k; } }
    for (int i = 0; i < np; ++i) { a.ph_lo = phases[i]; a.ph_hi = phases[i] + 1; hipLaunchKernelGGL(enc_fwd, dim3(grid), dim3(NT), LDS_BYTES, stream, a); }
#endif
}
```
